# Optimizing an MI355X kernel written in HIP

```python
import math
import jax
import jax.numpy as jnp
from jax import lax
import numpy as np

D_MODEL = 2048
BATCH = 1
SEQ = 8192
DEPTH = 4

GRID_W = 64
CTX_LEN = 256
DA_HEADS = 8
DA_HEAD_DIM = 64
DA_WIDTH = DA_HEADS * 2 * DA_HEAD_DIM
GQ_HEADS = 8
GQ_KV_HEADS = 2
GQ_GROUP = GQ_HEADS // GQ_KV_HEADS
GQ_HEAD_DIM = 128
GQ_WIDTH = GQ_HEADS * GQ_HEAD_DIM
GQ_KV_WIDTH = GQ_KV_HEADS * GQ_HEAD_DIM
S5_WIDTH = 1024
S5_GROUP = 16
S5_GROUPS = S5_WIDTH // S5_GROUP
S5_STATE = 64
S5_MAX_REAL = -1e-4
FFN_HIDDEN = -(-8 * D_MODEL // 768) * 256
N_BRANCH = 3
IN_SPLITS = (DA_WIDTH, 2 * DA_WIDTH, 3 * DA_WIDTH, 3 * DA_WIDTH + GQ_WIDTH, 3 * DA_WIDTH + GQ_WIDTH + GQ_KV_WIDTH, 3 * DA_WIDTH + GQ_WIDTH + 2 * GQ_KV_WIDTH, 3 * DA_WIDTH + GQ_WIDTH + 2 * GQ_KV_WIDTH + S5_WIDTH)
IN_WIDTH = 3 * DA_WIDTH + GQ_WIDTH + 2 * GQ_KV_WIDTH + S5_WIDTH + N_BRANCH * D_MODEL
Q_BLOCK = 128
ROPE_THETA = 10000.0
DEEPNORM_ALPHA = (2 * DEPTH) ** 0.25
DEEPNORM_BETA = (8 * DEPTH) ** -0.25
LN_EPS = 1e-6
RMS_EPS = 1e-6
DA_SUBLN_EPS = 1e-5

kernel_name = 'hybrid_diffattn_gqa_s5_prefix_dit'


def layer_norm(x, g, b):
    xf = x.astype(jnp.float32)
    mu = jnp.mean(xf, axis=-1, keepdims=True)
    var = jnp.mean(jnp.square(xf - mu), axis=-1, keepdims=True)
    y = (xf - mu) * lax.rsqrt(var + LN_EPS)
    return (y * g.astype(jnp.float32) + b.astype(jnp.float32)).astype(x.dtype)


def rms_norm(x, w, eps):
    xf = x.astype(jnp.float32)
    y = xf * lax.rsqrt(jnp.mean(jnp.square(xf), axis=-1, keepdims=True) + eps)
    return (y * w.astype(jnp.float32)).astype(x.dtype)


def axial_rope_tables(rows, dim):
    row = jnp.broadcast_to(jnp.arange(rows, dtype=jnp.float32)[:, None], (rows, GRID_W)).reshape(-1)
    col = jnp.broadcast_to(jnp.arange(GRID_W, dtype=jnp.float32)[None, :], (rows, GRID_W)).reshape(-1)
    axis_dim = dim // 2
    inv_freq = ROPE_THETA ** (-jnp.arange(0, axis_dim, 2, dtype=jnp.float32) / axis_dim)
    ang_r = row[:, None] * inv_freq[None, :]
    ang_c = col[:, None] * inv_freq[None, :]
    ang = jnp.concatenate([ang_r, ang_r, ang_c, ang_c], axis=-1)
    return jnp.cos(ang), jnp.sin(ang)


def apply_axial_rope(z, cos, sin):
    quarter = z.shape[-1] // 4
    z4 = z.reshape(z.shape[:-1] + (2, 2, quarter))
    rot = jnp.stack([-z4[..., 1, :], z4[..., 0, :]], axis=-2).reshape(z.shape)
    cos_b = cos[None, :, None, :]
    sin_b = sin[None, :, None, :]
    return (z.astype(jnp.float32) * cos_b + rot.astype(jnp.float32) * sin_b).astype(z.dtype)


def sweep_query_blocks(fn, qs):
    n = qs[0].shape[-2]
    nb = n // Q_BLOCK
    blocks = tuple(jnp.moveaxis(q.reshape(q.shape[:-2] + (nb, Q_BLOCK, q.shape[-1])), -3, 0) for q in qs)
    out = lax.map(fn, blocks)
    out = jnp.moveaxis(out, 0, -3)
    return out.reshape(out.shape[:-3] + (n, out.shape[-1]))


def diff_attn_core(q1, q2, k1, k2, v, lam):
    scale = DA_HEAD_DIM ** -0.5
    s1 = jnp.einsum('bhqd,bhsd->bhqs', q1, k1).astype(jnp.float32) * scale
    s2 = jnp.einsum('bhqd,bhsd->bhqs', q2, k2).astype(jnp.float32) * scale
    p = jax.nn.softmax(s1, axis=-1) - lam * jax.nn.softmax(s2, axis=-1)
    return jnp.einsum('bhqs,bhsd->bhqd', p.astype(v.dtype), v)


def gqa_core(q, k, v):
    s = jnp.einsum('bkgqd,bksd->bkgqs', q, k).astype(jnp.float32) * (GQ_HEAD_DIM ** -0.5)
    p = jax.nn.softmax(s, axis=-1)
    return jnp.einsum('bkgqs,bksd->bkgqd', p.astype(v.dtype), v)


def s5_discretize(a_re, a_im, log_dt, b_re, b_im):
    a_re = jnp.minimum(a_re, S5_MAX_REAL)
    dt = jnp.exp(log_dt)[:, None]
    mag = jnp.exp(a_re * dt)
    lr = mag * jnp.cos(a_im * dt)
    li = mag * jnp.sin(a_im * dt)
    den = jnp.square(a_re) + jnp.square(a_im)
    nr = lr - 1.0
    cr = (nr * a_re + li * a_im) / den
    ci = (li * a_re - nr * a_im) / den
    bbr = cr[..., None] * b_re - ci[..., None] * b_im
    bbi = cr[..., None] * b_im + ci[..., None] * b_re
    return lr, li, bbr, bbi


def complex_scan_op(e1, e2):
    a1r, a1i, b1r, b1i = e1
    a2r, a2i, b2r, b2i = e2
    return (a1r * a2r - a1i * a2i, a1r * a2i + a1i * a2r,
            a2r * b1r - a2i * b1i + b2r, a2r * b1i + a2i * b1r + b2i)


def s5_scan(u, lr, li, bbr, bbi, s0, reverse):
    br = jnp.einsum('blgh,gph->blgp', u, bbr)
    bi = jnp.einsum('blgh,gph->blgp', u, bbi)
    if s0 is not None:
        s0r, s0i = s0
        idx = u.shape[1] - 1 if reverse else 0
        br = br.at[:, idx].add(lr * s0r - li * s0i)
        bi = bi.at[:, idx].add(lr * s0i + li * s0r)
    ar = jnp.broadcast_to(lr, br.shape)
    ai = jnp.broadcast_to(li, bi.shape)
    _, _, xr, xi = lax.associative_scan(complex_scan_op, (ar, ai, br, bi), reverse=reverse, axis=1)
    return xr, xi


def s5_readout(xr, xi, c_re, c_im):
    return jnp.einsum('blgp,ghp->blgh', xr, c_re) - jnp.einsum('blgp,ghp->blgh', xi, c_im)


def s5_mixer(u, uc, p, need_ctx_out):
    b, n, _ = u.shape
    n_ctx = uc.shape[1]
    uf = u.astype(jnp.float32).reshape(b, n, S5_GROUPS, S5_GROUP)
    ucf = uc.astype(jnp.float32).reshape(b, n_ctx, S5_GROUPS, S5_GROUP)
    d_skip = p['s5_d'].astype(jnp.float32).reshape(S5_GROUPS, S5_GROUP)
    y = uf * d_skip
    yc = ucf * d_skip
    for direction in range(2):
        reverse = direction == 1
        lr, li, bbr, bbi = s5_discretize(p['s5_a_re'][direction].astype(jnp.float32), p['s5_a_im'][direction].astype(jnp.float32), p['s5_log_dt'][direction].astype(jnp.float32), p['s5_b_re'][direction].astype(jnp.float32), p['s5_b_im'][direction].astype(jnp.float32))
        c_re = p['s5_c_re'][direction].astype(jnp.float32)
        c_im = p['s5_c_im'][direction].astype(jnp.float32)
        cxr, cxi = s5_scan(ucf, lr, li, bbr, bbi, None, reverse)
        last = 0 if reverse else n_ctx - 1
        xr, xi = s5_scan(uf, lr, li, bbr, bbi, (cxr[:, last], cxi[:, last]), reverse)
        y = y + s5_readout(xr, xi, c_re, c_im)
        if need_ctx_out:
            yc = yc + s5_readout(cxr, cxi, c_re, c_im)
    y = y.reshape(b, n, S5_WIDTH).astype(u.dtype)
    yc = yc.reshape(b, n_ctx, S5_WIDTH).astype(uc.dtype) if need_ctx_out else None
    return y, yc


def s5_glu(y, p):
    a, g = jnp.split(jax.nn.gelu(y) @ p['w_glu'], 2, axis=-1)
    return a * jax.nn.sigmoid(g)


def swiglu(h, p):
    return (jax.nn.silu(h @ p['w_ffn_gate']) * (h @ p['w_ffn_up'])) @ p['w_ffn_down']


def token_mixer(h, hc, p, lam_init, rope, need_ctx_out):
    b, n, _ = h.shape
    n_ctx = hc.shape[1]
    cos_da, sin_da, cos_gq, sin_gq = rope
    qa, ka, va, qb, kb, vb, u, gt = jnp.split(h @ p['w_in'], IN_SPLITS, axis=-1)
    qac, kac, vac, qbc, kbc, vbc, uc, gtc = jnp.split(hc @ p['w_in'], IN_SPLITS, axis=-1)

    def heads_first(z, n_heads):
        return z.reshape(b, z.shape[1], n_heads, -1).transpose(0, 2, 1, 3)

    def da_qk(z, cos=None, sin=None):
        m = z.shape[1]
        z = z.reshape(b, m, 2 * DA_HEADS, DA_HEAD_DIM)
        if cos is not None:
            z = apply_axial_rope(z, cos, sin)
        z = z.reshape(b, m, DA_HEADS, 2, DA_HEAD_DIM).transpose(0, 3, 2, 1, 4)
        return z[:, 0], z[:, 1]

    q1, q2 = da_qk(qa, cos_da, sin_da)
    k1, k2 = da_qk(ka, cos_da, sin_da)
    q1c, q2c = da_qk(qac)
    k1c, k2c = da_qk(kac)
    v_a = heads_first(va, DA_HEADS)
    v_ac = heads_first(vac, DA_HEADS)
    k1_all = jnp.concatenate([k1, k1c], axis=2)
    k2_all = jnp.concatenate([k2, k2c], axis=2)
    va_all = jnp.concatenate([v_a, v_ac], axis=2)
    lam = (jnp.exp(jnp.sum(p['da_lam_q1'].astype(jnp.float32) * p['da_lam_k1'].astype(jnp.float32)))
           - jnp.exp(jnp.sum(p['da_lam_q2'].astype(jnp.float32) * p['da_lam_k2'].astype(jnp.float32))) + lam_init)

    def da_out(o):
        m = o.shape[2]
        o = rms_norm(o.transpose(0, 2, 1, 3), p['da_subln_w'], DA_SUBLN_EPS) * (1.0 - lam_init)
        return o.reshape(b, m, DA_WIDTH) @ p['w_pa']

    o_a = sweep_query_blocks(lambda qs: diff_attn_core(qs[0], qs[1], k1_all, k2_all, va_all, lam), (q1, q2))
    pa = da_out(o_a)

    def gq_heads(z, n_heads, norm_w, cos=None, sin=None):
        m = z.shape[1]
        z = rms_norm(z.reshape(b, m, n_heads, GQ_HEAD_DIM), norm_w, RMS_EPS)
        if cos is not None:
            z = apply_axial_rope(z, cos, sin)
        return z.transpose(0, 2, 1, 3)

    qg = gq_heads(qb, GQ_HEADS, p['gq_qnorm_w'], cos_gq, sin_gq).reshape(b, GQ_KV_HEADS, GQ_GROUP, n, GQ_HEAD_DIM)
    kg = gq_heads(kb, GQ_KV_HEADS, p['gq_knorm_w'], cos_gq, sin_gq)
    kgc = gq_heads(kbc, GQ_KV_HEADS, p['gq_knorm_w'])
    kg_all = jnp.concatenate([kg, kgc], axis=2)
    vg_c = heads_first(vbc, GQ_KV_HEADS)
    vg_all = jnp.concatenate([heads_first(vb, GQ_KV_HEADS), vg_c], axis=2)

    def gq_out(o):
        m = o.shape[3]
        return o.reshape(b, GQ_HEADS, m, GQ_HEAD_DIM).transpose(0, 2, 1, 3).reshape(b, m, GQ_WIDTH) @ p['w_pb']

    o_b = sweep_query_blocks(lambda qs: gqa_core(qs[0], kg_all, vg_all), (qg,))
    pb = gq_out(o_b)

    y_s5, yc_s5 = s5_mixer(u, uc, p, need_ctx_out)
    pc = s5_glu(y_s5, p)

    g = jax.nn.sigmoid(gt.reshape(b, n, N_BRANCH, D_MODEL))
    out = (g[:, :, 0] * pa + g[:, :, 1] * pb + g[:, :, 2] * pc) @ p['w_o']
    if not need_ctx_out:
        return out, None
    qgc = gq_heads(qbc, GQ_HEADS, p['gq_qnorm_w']).reshape(b, GQ_KV_HEADS, GQ_GROUP, n_ctx, GQ_HEAD_DIM)
    pa_c = da_out(diff_attn_core(q1c, q2c, k1c, k2c, v_ac, lam))
    pb_c = gq_out(gqa_core(qgc, kgc, vg_c))
    pc_c = s5_glu(yc_s5, p)
    gc = jax.nn.sigmoid(gtc.reshape(b, n_ctx, N_BRANCH, D_MODEL))
    out_c = (gc[:, :, 0] * pa_c + gc[:, :, 1] * pb_c + gc[:, :, 2] * pc_c) @ p['w_o']
    return out, out_c


def trunk_layer(x, ctx, c, c_ctx, p, layer_idx, need_ctx_out, rope):
    lam_init = 0.8 - 0.6 * math.exp(-0.3 * layer_idx)
    mod = jax.nn.silu(c) @ p['w_ada'] + p['b_ada']
    mod_c = jax.nn.silu(c_ctx) @ p['w_ada'] + p['b_ada']
    sh_m, sc_m, g_m, sh_f, sc_f, g_f = jnp.split(mod[:, None, :], 6, axis=-1)
    shc_m, scc_m, gc_m, shc_f, scc_f, gc_f = jnp.split(mod_c[None, None, :], 6, axis=-1)
    y, yc = token_mixer(x * (1.0 + sc_m) + sh_m, ctx * (1.0 + scc_m) + shc_m, p, lam_init, rope, need_ctx_out)
    x = layer_norm(DEEPNORM_ALPHA * x + g_m * y, p['ln_mix_g'], p['ln_mix_b'])
    x = layer_norm(DEEPNORM_ALPHA * x + g_f * swiglu(x * (1.0 + sc_f) + sh_f, p), p['ln_ffn_g'], p['ln_ffn_b'])
    if need_ctx_out:
        ctx = layer_norm(DEEPNORM_ALPHA * ctx + gc_m * yc, p['ln_mix_g'], p['ln_mix_b'])
        ctx = layer_norm(DEEPNORM_ALPHA * ctx + gc_f * swiglu(ctx * (1.0 + scc_f) + shc_f, p), p['ln_ffn_g'], p['ln_ffn_b'])
    return x, ctx


def setup_inputs(seed: int = 0) -> dict:
    key = jax.random.key(seed)
    ks = jax.random.split(key, 40)
    f32 = jnp.float32

    def nrm(k, shape, scale):
        return jax.random.normal(k, shape, f32) * scale

    L, D, F = DEPTH, D_MODEL, FFN_HIDDEN
    G, P, H = S5_GROUPS, S5_STATE, S5_GROUP
    a_im_base = jnp.pi * jnp.arange(P, dtype=f32)
    return {
        'x': nrm(ks[0], (BATCH, SEQ, D), 1.0),
        'c': nrm(ks[1], (BATCH, D), 1.0),
        'ctx': nrm(ks[2], (BATCH, CTX_LEN, D), 1.0),
        'c_ctx': nrm(ks[3], (D,), 1.0),
        'w_ada': nrm(ks[4], (L, D, 6 * D), 0.5 * D ** -0.5),
        'b_ada': nrm(ks[5], (L, 6 * D), 0.02),
        'w_in': nrm(ks[6], (L, D, IN_WIDTH), D ** -0.5),
        'da_lam_q1': nrm(ks[7], (L, DA_HEAD_DIM), 0.1),
        'da_lam_k1': nrm(ks[8], (L, DA_HEAD_DIM), 0.1),
        'da_lam_q2': nrm(ks[9], (L, DA_HEAD_DIM), 0.1),
        'da_lam_k2': nrm(ks[10], (L, DA_HEAD_DIM), 0.1),
        'da_subln_w': 1.0 + nrm(ks[11], (L, 2 * DA_HEAD_DIM), 0.02),
        'w_pa': nrm(ks[12], (L, DA_WIDTH, D), DA_WIDTH ** -0.5),
        'gq_qnorm_w': 1.0 + nrm(ks[13], (L, GQ_HEAD_DIM), 0.02),
        'gq_knorm_w': 1.0 + nrm(ks[14], (L, GQ_HEAD_DIM), 0.02),
        'w_pb': nrm(ks[15], (L, GQ_WIDTH, D), GQ_WIDTH ** -0.5),
        's5_a_re': -0.5 + nrm(ks[16], (L, 2, G, P), 0.01),
        's5_a_im': a_im_base + nrm(ks[17], (L, 2, G, P), 0.01),
        's5_log_dt': jax.random.uniform(ks[18], (L, 2, G), f32, math.log(1e-3), math.log(1e-1)),
        's5_b_re': nrm(ks[19], (L, 2, G, P, H), (2.0 * H) ** -0.5),
        's5_b_im': nrm(ks[20], (L, 2, G, P, H), (2.0 * H) ** -0.5),
        's5_c_re': nrm(ks[21], (L, 2, G, H, P), (2.0 * P) ** -0.5),
        's5_c_im': nrm(ks[22], (L, 2, G, H, P), (2.0 * P) ** -0.5),
        's5_d': nrm(ks[23], (L, S5_WIDTH), 1.0),
        'w_glu': nrm(ks[24], (L, S5_WIDTH, 2 * D), S5_WIDTH ** -0.5),
        'w_o': nrm(ks[25], (L, D, D), DEEPNORM_BETA * D ** -0.5),
        'ln_mix_g': 1.0 + nrm(ks[26], (L, D), 0.02),
        'ln_mix_b': nrm(ks[27], (L, D), 0.02),
        'w_ffn_gate': nrm(ks[28], (L, D, F), D ** -0.5),
        'w_ffn_up': nrm(ks[29], (L, D, F), D ** -0.5),
        'w_ffn_down': nrm(ks[30], (L, F, D), DEEPNORM_BETA * F ** -0.5),
        'ln_ffn_g': 1.0 + nrm(ks[31], (L, D), 0.02),
        'ln_ffn_b': nrm(ks[32], (L, D), 0.02),
    }


def reference(x, c, ctx, c_ctx, w_ada, b_ada, w_in, da_lam_q1, da_lam_k1, da_lam_q2, da_lam_k2, da_subln_w, w_pa, gq_qnorm_w, gq_knorm_w, w_pb, s5_a_re, s5_a_im, s5_log_dt, s5_b_re, s5_b_im, s5_c_re, s5_c_im, s5_d, w_glu, w_o, ln_mix_g, ln_mix_b, w_ffn_gate, w_ffn_up, w_ffn_down, ln_ffn_g, ln_ffn_b):
    n_tokens = x.shape[1]
    rows = n_tokens // GRID_W
    cos_da, sin_da = axial_rope_tables(rows, DA_HEAD_DIM)
    cos_gq, sin_gq = axial_rope_tables(rows, GQ_HEAD_DIM)
    rope = (cos_da, sin_da, cos_gq, sin_gq)
    for l in range(DEPTH):
        p = {
            'w_ada': w_ada[l], 'b_ada': b_ada[l], 'w_in': w_in[l],
            'da_lam_q1': da_lam_q1[l], 'da_lam_k1': da_lam_k1[l],
            'da_lam_q2': da_lam_q2[l], 'da_lam_k2': da_lam_k2[l],
            'da_subln_w': da_subln_w[l], 'w_pa': w_pa[l],
            'gq_qnorm_w': gq_qnorm_w[l], 'gq_knorm_w': gq_knorm_w[l], 'w_pb': w_pb[l],
            's5_a_re': s5_a_re[l], 's5_a_im': s5_a_im[l], 's5_log_dt': s5_log_dt[l],
            's5_b_re': s5_b_re[l], 's5_b_im': s5_b_im[l],
            's5_c_re': s5_c_re[l], 's5_c_im': s5_c_im[l], 's5_d': s5_d[l],
            'w_glu': w_glu[l], 'w_o': w_o[l],
            'ln_mix_g': ln_mix_g[l], 'ln_mix_b': ln_mix_b[l],
            'w_ffn_gate': w_ffn_gate[l], 'w_ffn_up': w_ffn_up[l], 'w_ffn_down': w_ffn_down[l],
            'ln_ffn_g': ln_ffn_g[l], 'ln_ffn_b': ln_ffn_b[l],
        }
        x, ctx = trunk_layer(x, ctx, c, c_ctx, p, l, l < DEPTH - 1, rope)
    return x
```

```cpp
#include <hip/hip_runtime.h>
#include <cstdio>
#include <cstdint>

#define LAS __attribute__((address_space(3)))
#define GAS __attribute__((address_space(1)))
typedef unsigned short bf16_t;
typedef short bf16x8 __attribute__((ext_vector_type(8)));
typedef short s16x4 __attribute__((ext_vector_type(4)));
typedef float f32x4 __attribute__((ext_vector_type(4)));
typedef float f32x2 __attribute__((ext_vector_type(2)));
typedef float f32x16 __attribute__((ext_vector_type(16)));
typedef unsigned u32x4 __attribute__((ext_vector_type(4)));
typedef unsigned u32x2 __attribute__((ext_vector_type(2)));

constexpr int NT = 8448, NLAT = 8192, NCTX = 256, DM = 2048, NIN = 11776, FF = 5632, NL = 4;
constexpr int C_QA = 0, C_KA = 1024, C_VA = 2048, C_QB = 3072, C_KB = 4096, C_VB = 4352, C_U = 4608, C_G = 5632;
constexpr float DN_ALPHA = 1.6817928305074290f;
constexpr int NWAVES = 8, NTHR = 512;
constexpr int MOD_SLABS = 32;

constexpr size_t al256(size_t x) { return (x + 255) & ~(size_t)255; }
constexpr size_t WS_CTL = 0, CTL_ZERO_BYTES = 1u << 20;
constexpr size_t WS_MODP = CTL_ZERO_BYTES;
constexpr size_t WS_MOD = WS_MODP + al256((size_t)MOD_SLABS * NL * 2 * 12288 * 4);
constexpr size_t WS_LAMV = WS_MOD + al256((size_t)NL * 2 * 12288 * 4);
constexpr size_t WS_ROPE_DA = WS_LAMV + 256;
constexpr size_t WS_ROPE_GQ = WS_ROPE_DA + 128 * 16 * 8;
constexpr size_t WS_LAM = WS_ROPE_GQ + 128 * 32 * 8;
constexpr size_t WS_BB = WS_LAM + (size_t)NL * 2 * 64 * 64 * 16;
constexpr size_t WS_CC = WS_BB + (size_t)NL * 2 * 64 * 128 * 16 * 2;
constexpr size_t WS_F = WS_CC + (size_t)NL * 64 * 16 * 256 * 2;
constexpr size_t WS_W = al256(WS_F + (size_t)2 * 66 * 64 * 64 * 8);
__host__ __device__ constexpr bool win_tile_fp8(int pt) { return !((pt >= 8 && pt < 12) || (pt >= 18 && pt < 22)); }
__host__ __device__ constexpr int win_tile_slot(int pt) { return pt < 8 ? pt : pt < 12 ? pt - 8 : pt < 18 ? pt - 4 : pt < 22 ? pt - 14 : pt - 8; }
__host__ __device__ constexpr int win_fp8_tile(int j) { return j < 8 ? j : j < 14 ? j + 4 : j + 8; }
__host__ __device__ constexpr int win_bf16_tile(int j) { return j < 4 ? j + 8 : j + 14; }
constexpr size_t W_IN = 0;
constexpr size_t W_PAB = W_IN + (size_t)2048 * DM * 2;
constexpr size_t W_GLU = W_PAB + (size_t)4096 * 1024 * 2;
constexpr size_t W_O = W_GLU + (size_t)4096 * 1024 * 2;
constexpr size_t W_GU = W_O + (size_t)DM * DM * 2;
constexpr size_t W_DN = W_GU + (size_t)2 * FF * DM * 2;
constexpr size_t W_IN8 = W_DN + (size_t)DM * FF * 2;
constexpr size_t W_LAYER = W_IN8 + (size_t)9728 * DM;
constexpr size_t WS_XRES = al256(WS_W + NL * W_LAYER);
constexpr size_t WS_H = WS_XRES + (size_t)NT * DM * 4;
constexpr size_t WS_Z = WS_H + (size_t)NT * DM * 2;
constexpr size_t WS_ODA = WS_Z + (size_t)NT * NIN * 2;
constexpr size_t WS_APB = WS_ODA + (size_t)NT * DM * 2;
constexpr size_t WS_AGLU = WS_APB + (size_t)2 * NT * 1024 * 2;
constexpr size_t WS_PG = WS_AGLU + (size_t)NT * 1024 * 2;
constexpr size_t WS_MRG = WS_PG + (size_t)2 * NT * DM * 2;
constexpr size_t WS_T = WS_MRG + (size_t)NT * DM * 2;
constexpr size_t WS_ACT = WS_T + (size_t)NT * DM * 4;
constexpr size_t WS_SLAB = WS_ACT + (size_t)NT * FF * 2;
constexpr int SPLIT_O = 16, SPLIT_D = 22;
constexpr size_t WS_POW = WS_SLAB + (size_t)SPLIT_D * NCTX * DM * 4;
constexpr size_t WS_BBF = WS_POW + (size_t)NL * 2 * 64 * 17 * 64 * 8;
constexpr size_t WS_KTAB = WS_BBF + (size_t)NL * 2 * 64 * 64 * 16 * 8;
constexpr size_t WS_ETAB = WS_KTAB + (size_t)NL * 64 * 2 * 16 * 256 * 4;
constexpr size_t WS_BTAB = WS_ETAB + (size_t)NL * 64 * 256 * 256 * 2;
constexpr size_t WS_AP = WS_BTAB + (size_t)NL * 64 * 256 * 512 * 2;
constexpr size_t WS_S = WS_AP + (size_t)64 * 768 * 512 * 2;
constexpr size_t WS_H8 = WS_S + (size_t)64 * 768 * 256 * 4;
constexpr size_t WS_QB8 = WS_H8 + (size_t)NT * DM;
constexpr size_t WS_KB8 = WS_QB8 + (size_t)NT * 1024;
constexpr size_t WS_QKA8 = WS_KB8 + (size_t)NT * 256;
constexpr size_t WS_VB8T = WS_QKA8 + (size_t)NT * 2048;
constexpr size_t WS_VA8T = WS_VB8T + (size_t)2 * 132 * 128 * 64;
constexpr size_t WS_STATS = WS_VA8T + (size_t)8 * 132 * 128 * 64;
constexpr size_t WS_IDAFF = WS_STATS + (size_t)NLAT * 8;
constexpr size_t WS_END = WS_IDAFF + (size_t)2 * DM * 4;

constexpr int CW_TMO = 0, CW_BAR = 4096;

__device__ __forceinline__ unsigned f2bf(float f) { unsigned u = __builtin_bit_cast(unsigned, f); return (u + 0x7fffu + ((u >> 16) & 1u)) >> 16; }
__device__ __forceinline__ unsigned pk2(float lo, float hi) { return f2bf(lo) | (f2bf(hi) << 16); }
typedef float f32x2_ __attribute__((ext_vector_type(2))); typedef __bf16 bf16x2_ __attribute__((ext_vector_type(2)));
__device__ __forceinline__ unsigned cvt_pk_bf16(float lo, float hi) { const f32x2_ v = {lo, hi}; return __builtin_bit_cast(unsigned, __builtin_convertvector(v, bf16x2_)); }
__device__ __forceinline__ float bflo(unsigned w) { return __builtin_bit_cast(float, w << 16); }
__device__ __forceinline__ float bfhi(unsigned w) { return __builtin_bit_cast(float, w & 0xffff0000u); }
__device__ __forceinline__ void unpack8(u32x4 w, float (&f)[8]) { f[0] = bflo(w.x); f[1] = bfhi(w.x); f[2] = bflo(w.y); f[3] = bfhi(w.y); f[4] = bflo(w.z); f[5] = bfhi(w.z); f[6] = bflo(w.w); f[7] = bfhi(w.w); }
__device__ __forceinline__ u32x4 pack8(const float (&f)[8]) { u32x4 w; w.x = cvt_pk_bf16(f[0], f[1]); w.y = cvt_pk_bf16(f[2], f[3]); w.z = cvt_pk_bf16(f[4], f[5]); w.w = cvt_pk_bf16(f[6], f[7]); return w; }
__device__ __forceinline__ unsigned pk4_fp8(float a, float b, float c, float d) { int w = __builtin_amdgcn_cvt_pk_fp8_f32(a, b, 0, false); w = __builtin_amdgcn_cvt_pk_fp8_f32(c, d, w, true); return (unsigned)w; }
__device__ __forceinline__ float sigmoidf_(float x) { return __builtin_amdgcn_rcpf(1.f + __builtin_amdgcn_exp2f(-1.4426950408889634f * x)); }
__device__ __forceinline__ float siluf_(float x) { return x * sigmoidf_(x); }
__device__ __forceinline__ float gelu_tanh(float x) { const float z = 0.7978845608028654f * (x + 0.044715f * x * x * x); return x * sigmoidf_(2.f * z); }
__device__ __forceinline__ float wave_sum(float v) {
#pragma unroll
    for (int o = 1; o < 64; o <<= 1) v += __shfl_xor(v, o);
    return v;
}
__device__ __forceinline__ int opaque_tid() { int t = threadIdx.x; asm volatile("" : "+v"(t)); return t; }
#define LDS_WAIT() asm volatile("s_waitcnt lgkmcnt(0)" ::: "memory")
#define VM_WAIT() asm volatile("s_waitcnt vmcnt(0)" ::: "memory")

__device__ __forceinline__ void dsincos(double x, double& s, double& c) {
    const double inv2pi = 0.15915494309189533577, twopi = 6.283185307179586476925;
    double r = x * inv2pi; r = r - __builtin_rint(r); r *= twopi;
    double sg = 1.0;
    if (r > 1.5707963267948966) { r = 3.141592653589793 - r; sg = -1.0; } else if (r < -1.5707963267948966) { r = -3.141592653589793 - r; sg = -1.0; }
    const double r2 = r * r;
    double ss = 1.0, cc = 1.0, ts = 1.0, tc = 1.0;
#pragma unroll
    for (int k = 1; k <= 12; ++k) { tc *= -r2 / (double)((2 * k - 1) * (2 * k)); ts *= -r2 / (double)((2 * k) * (2 * k + 1)); cc += tc; ss += ts; }
    s = ss * r; c = sg * cc;
}
__device__ __forceinline__ double dexp(double x) {
    const double n = __builtin_rint(x * 1.4426950408889634);
    const double r = x - n * 0.6931471805599453094;
    double t = 1.0, sum = 1.0;
#pragma unroll
    for (int k = 1; k <= 14; ++k) { t *= r / (double)k; sum += t; }
    return __builtin_ldexp(sum, (int)n);
}

namespace pg8 {
constexpr int BM = 256, BK = 64, HALF = 128, HTB = HALF * BK * 2, STAGE_BYTES = 8 * HTB, NXCD = 8, WGM = 8;
__host__ __device__ __forceinline__ int lds_byte(int r, int c) { const int st = (r >> 4) * 2 + (c >> 5), rr = r & 15, cc = c & 31, ob = rr * 64 + cc * 2; return st * 1024 + (ob ^ (((ob >> 9) & 1) << 5)); }
__host__ __device__ __forceinline__ void stage_rc(int b, int& R, int& C) { const int st = b / 1024, sb = b % 1024, swz = sb ^ (((sb >> 9) & 1) << 5); R = (st >> 1) * 16 + swz / 64; C = (st & 1) * 32 + (swz % 64) / 2; }
__host__ __device__ __forceinline__ int perm32(int rho) { const int n = rho >> 4, i = rho & 15; return 8 * (i >> 2) + 4 * n + (i & 3); }
struct Unit { int pm, pn, kt0, nt; };
struct Gemm { const bf16_t* A; const bf16_t* Bt; int M, N, K, lda, ldb; };
struct StaticOrder {
    int nM, nN, nwg, G, c;
    __host__ __device__ void init(int M, int N, int G_, int c_) { nM = M / BM; nN = N / BM; nwg = nM * nN; G = G_; c = c_; }
    __host__ __device__ bool next(int i, Unit& u) const { const long L = (long)i * G + c; if (L >= nwg) return false; unit((int)L, u); return true; }
    __host__ __device__ void unit(int L, Unit& u) const {
        int wgid = L; { const int q = nwg / NXCD, r = nwg % NXCD, xcd = wgid % NXCD, off = wgid / NXCD; wgid = (xcd < r ? xcd * (q + 1) : r * (q + 1) + (xcd - r) * q) + off; }
        const int nig = WGM * nN, gid = wgid / nig, fm = gid * WGM, gsz = (nM - fm) < WGM ? (nM - fm) : WGM;
        u.pm = fm + ((wgid % nig) % gsz); u.pn = (wgid % nig) / gsz; u.kt0 = 0; u.nt = 0;
    }
    __device__ __forceinline__ void a_ready(const Unit&) const {}
    __device__ __forceinline__ void done(const Unit&) const {}
};
struct WinOrder {
    StaticOrder b;
    __host__ __device__ void init(int M, int N, int G_, int c_) { b.init(M, N, G_, c_); }
    __host__ __device__ bool next(int i, Unit& u) const {
        if (b.G != 256) return b.next(i, u);
        const int c = b.c; int L;
        if (i < 3) L = i * 256 + c;
        else if (i == 3) { if (c >= 240 && c < 248) return false; L = 768 + c; }
        else if (i == 4) { if (c < 230) L = 1024 + c; else if (c < 238) L = 768 + c + 10; else return false; }
        else return false;
        b.unit(L, u); return true;
    }
    __device__ __forceinline__ void a_ready(const Unit&) const {}
    __device__ __forceinline__ void done(const Unit&) const {}
};
struct PairOrder {
    int nM, nwg, G, c;
    __host__ __device__ void init(int nM_, int G_, int c_) { nM = nM_; nwg = 2 * nM_ * 8; G = G_; c = c_; }
    __host__ __device__ bool next(int i, Unit& u) const {
        const long L = (long)i * G + c; if (L >= nwg) return false;
        const int per = nM * 8, which = (int)L / per, r = (int)L % per;
        u.pm = 33 * which + (r % nM); u.pn = 8 * which + (r / nM); u.kt0 = 0; u.nt = 0; return true;
    }
    __device__ __forceinline__ void a_ready(const Unit&) const {}
    __device__ __forceinline__ void done(const Unit&) const {}
};

struct ResSplitOrder {
    StaticOrder lat; int G, c, S, ntS; bool ctx;
    __host__ __device__ void init(int N, int G_, int c_, bool ctx_, int S_, int ntS_) { lat.init(8192, N, G_, c_); G = G_; c = c_; ctx = ctx_; S = S_; ntS = ntS_; }
    __host__ __device__ bool next(int i, Unit& u) const {
        const long L = (long)i * G + c;
        if (L < lat.nwg) return lat.next(i, u);
        const int j = (int)(L - lat.nwg); if (!ctx || j >= 8 * S) return false;
        u.pm = 32; u.pn = j & 7; u.kt0 = (j >> 3) * ntS; u.nt = ntS; return true;
    }
    __device__ __forceinline__ void a_ready(const Unit&) const {}
    __device__ __forceinline__ void done(const Unit&) const {}
};
struct S5Order {
    int nmt, G, c;
    __host__ __device__ void init(int nmt_, int G_, int c_) { nmt = nmt_; G = G_; c = c_; }
    __host__ __device__ bool next(int i, Unit& u) const {
        const long L = (long)i * G + c; if (L >= 64 * nmt) return false;
        const int g = (int)L / nmt, mt = (int)L % nmt; u.pm = 3 * g + mt; u.pn = g; u.kt0 = 0; u.nt = 0; return true;
    }
    __device__ __forceinline__ void a_ready(const Unit&) const {}
    __device__ __forceinline__ void done(const Unit&) const {}
};
template <class Epi, class Sched, bool ALIGN_EPI = false, bool SP2 = false, bool FP8 = false>
__device__ __forceinline__ void gemm_phase(LAS unsigned char* lds, const Gemm g, const Sched& S, const Epi& E) {
    const int tid = opaque_tid(), wid = __builtin_amdgcn_readfirstlane(tid >> 6), lane = tid & 63, wr = wid >> 2, wc = wid & 3, fr = lane & 15, fq = lane >> 4;
    const int K = g.K, nt = K / BK, lda = g.lda ? g.lda : K, ldb = g.ldb ? g.ldb : K;
    unsigned voffA[2], voffB[2];
#pragma unroll
    for (int i = 0; i < 2; ++i) { int R, C; stage_rc(tid * 16 + i * 8192, R, C); const int Rb = Epi::PERM ? ((R & ~31) + perm32(R & 31)) : R;
        voffA[i] = (unsigned)(R * lda + C) * 2u; voffB[i] = (unsigned)(Rb * ldb + C) * 2u; }
    const size_t kstep = (size_t)(BK * 2);
    const size_t hstepA = (size_t)HALF * lda * 2, hstepB = (size_t)HALF * ldb * 2;
    const size_t tstepA = 2 * hstepA, tstepB = 2 * hstepB;
    const unsigned ldsw = (unsigned)wid * 1024u;
    const int aoff = lds_byte(wr * 64 + fr, fq * 8), boff = lds_byte(wc * 32 + fr, fq * 8);
#define PG8_SA(b, h) (((b) * 2 + (h)) * HTB)
#define PG8_SB(b, h) ((4 + (b) * 2 + (h)) * HTB)
#define PG8_STAGE(bufoff, gbase, voff) do { _Pragma("unroll") for (int _i = 0; _i < 2; ++_i) \
        __builtin_amdgcn_global_load_lds((const unsigned*)((const char*)(gbase) + (voff)[_i]), (LAS unsigned*)(lds + (bufoff) + ldsw + _i * 8192), 16, 0, 0); } while (0)
    typedef int v8i_ __attribute__((ext_vector_type(8))); typedef int v4i_ __attribute__((ext_vector_type(4)));
#define PG8_LDA(dst, b, h) do { _Pragma("unroll") for (int m = 0; m < 4; ++m) { const v4i_ lo_ = *(const LAS v4i_*)(lds + PG8_SA(b, h) + aoff + m * 2048), hi_ = *(const LAS v4i_*)(lds + PG8_SA(b, h) + aoff + m * 2048 + 1024); \
        dst[m] = __builtin_shufflevector(lo_, hi_, 0, 1, 2, 3, 4, 5, 6, 7); } } while (0)
#define PG8_LDB(dst, b, h) do { _Pragma("unroll") for (int n = 0; n < 2; ++n) { const v4i_ lo_ = *(const LAS v4i_*)(lds + PG8_SB(b, h) + boff + n * 2048), hi_ = *(const LAS v4i_*)(lds + PG8_SB(b, h) + boff + n * 2048 + 1024); \
        dst[n] = __builtin_shufflevector(lo_, hi_, 0, 1, 2, 3, 4, 5, 6, 7); } } while (0)
#define PG8_HALF(v, k) __builtin_bit_cast(bf16x8, (k) == 0 ? __builtin_shufflevector(v, v, 0, 1, 2, 3) : __builtin_shufflevector(v, v, 4, 5, 6, 7))
#define PG8_MMA(ai, bj, At, Bt) do { __builtin_amdgcn_s_setprio(1); _Pragma("unroll") for (int m = 0; m < 4; ++m) _Pragma("unroll") for (int n = 0; n < 2; ++n) { \
        if constexpr (FP8) asm volatile("v_mfma_scale_f32_16x16x128_f8f6f4 %0, %1, %2, %0, %3, %3 op_sel_hi:[0,0,0]" : "+v"(acc[ai][bj][m][n]) : "v"(Bt[n]), "v"(At[m]), "v"(one_scale));   \
        else { acc[ai][bj][m][n] = __builtin_amdgcn_mfma_f32_16x16x32_bf16(PG8_HALF(Bt[n], 0), PG8_HALF(At[m], 0), acc[ai][bj][m][n], 0, 0, 0); \
               acc[ai][bj][m][n] = __builtin_amdgcn_mfma_f32_16x16x32_bf16(PG8_HALF(Bt[n], 1), PG8_HALF(At[m], 1), acc[ai][bj][m][n], 0, 0, 0); } } \
        __builtin_amdgcn_s_setprio(0); } while (0)
#define PG8_WAIT_V(n) asm volatile("s_waitcnt vmcnt(" #n ")" ::: "memory")
#define PG8_WAIT_L(n) asm volatile("s_waitcnt lgkmcnt(" #n ")" ::: "memory")
#define PG8_BAR __builtin_amdgcn_s_barrier()
#define PG8_SCHED __builtin_amdgcn_sched_barrier(0)
    Unit cur, nxt; int ui = 0;
    if (!S.next(0, cur)) return;
    f32x4 acc[2][2][4][2];
#pragma unroll
    for (int a = 0; a < 2; ++a)
#pragma unroll
        for (int b = 0; b < 2; ++b)
#pragma unroll
            for (int m = 0; m < 4; ++m)
#pragma unroll
                for (int n = 0; n < 2; ++n) acc[a][b][m][n] = (f32x4){0.f, 0.f, 0.f, 0.f};
    v8i_ At[4], B0[2], B1[2]; const int one_scale = 0x7f7f7f7f; (void)one_scale;
    const char* cA = (const char*)g.A + (size_t)cur.pm * tstepA + (size_t)cur.kt0 * kstep; const char* cB = (const char*)g.Bt + (size_t)cur.pn * tstepB + (size_t)cur.kt0 * kstep;
    S.a_ready(cur);
    if constexpr (SP2) {
        PG8_STAGE(PG8_SB(0, 0), cB, voffB); PG8_STAGE(PG8_SB(0, 1), cB + hstepB, voffB); PG8_STAGE(PG8_SA(0, 0), cA, voffA); PG8_STAGE(PG8_SA(0, 1), cA + hstepA, voffA);
        if (wr == 1) PG8_BAR;
        PG8_WAIT_V(2); PG8_BAR;
        PG8_STAGE(PG8_SB(1, 0), cB + kstep, voffB); PG8_STAGE(PG8_SA(1, 0), cA + kstep, voffA); PG8_STAGE(PG8_SB(1, 1), cB + hstepB + kstep, voffB);
        PG8_WAIT_V(6); PG8_BAR;
    } else {
        PG8_STAGE(PG8_SB(0, 0), cB, voffB); PG8_STAGE(PG8_SA(0, 0), cA, voffA); PG8_STAGE(PG8_SB(0, 1), cB + hstepB, voffB); PG8_STAGE(PG8_SA(0, 1), cA + hstepA, voffA);
        if (wr == 1) PG8_BAR;
        PG8_WAIT_V(4); PG8_BAR;
        PG8_STAGE(PG8_SB(1, 0), cB + kstep, voffB); PG8_STAGE(PG8_SA(1, 0), cA + kstep, voffA); PG8_STAGE(PG8_SB(1, 1), cB + hstepB + kstep, voffB);
        PG8_WAIT_V(6); PG8_BAR;
    }
    for (;;) {
        const bool has_next = S.next(ui + 1, nxt);
        const char* nA = has_next ? (const char*)g.A + (size_t)nxt.pm * tstepA + (size_t)nxt.kt0 * kstep : cA; const char* nB = has_next ? (const char*)g.Bt + (size_t)nxt.pn * tstepB + (size_t)nxt.kt0 * kstep : cB;
        const int ntu = cur.nt ? cur.nt : nt;
        for (int t = 0; t < ntu; t += 2) {
            const bool last = (t == ntu - 2);
            const char* a1 = cA + (size_t)(t + 1) * kstep;
            const char* a2 = last ? nA : cA + (size_t)(t + 2) * kstep; const char* b2 = last ? nB : cB + (size_t)(t + 2) * kstep;
            const char* a3 = a2 + kstep; const char* b3 = b2 + kstep;
            if (last && has_next) S.a_ready(nxt);
            if constexpr (SP2) {
            PG8_LDB(B0, 0, 0); PG8_LDB(B1, 0, 1); PG8_SCHED; PG8_LDA(At, 0, 0); PG8_STAGE(PG8_SA(1, 1), a1 + hstepA, voffA);
            PG8_WAIT_V(8); PG8_WAIT_L(0); PG8_BAR; PG8_MMA(0, 0, At, B0); PG8_MMA(0, 1, At, B1); PG8_BAR; PG8_SCHED;
            PG8_LDA(At, 0, 1); PG8_STAGE(PG8_SB(0, 0), b2, voffB); PG8_STAGE(PG8_SB(0, 1), b2 + hstepB, voffB); PG8_STAGE(PG8_SA(0, 0), a2, voffA);
            PG8_WAIT_V(8); PG8_WAIT_L(0); PG8_BAR; PG8_MMA(1, 0, At, B0); PG8_MMA(1, 1, At, B1); PG8_BAR; PG8_SCHED;
            PG8_LDB(B0, 1, 0); PG8_LDB(B1, 1, 1); PG8_SCHED; PG8_LDA(At, 1, 0); PG8_STAGE(PG8_SA(0, 1), a2 + hstepA, voffA);
            PG8_WAIT_V(8); PG8_WAIT_L(0); PG8_BAR; PG8_MMA(0, 0, At, B0); PG8_MMA(0, 1, At, B1); PG8_BAR; PG8_SCHED;
            PG8_LDA(At, 1, 1); PG8_STAGE(PG8_SB(1, 0), b3, voffB); PG8_STAGE(PG8_SB(1, 1), b3 + hstepB, voffB); PG8_STAGE(PG8_SA(1, 0), a3, voffA);
            PG8_WAIT_V(8); PG8_WAIT_L(0); PG8_BAR; PG8_MMA(1, 0, At, B0); PG8_MMA(1, 1, At, B1); PG8_BAR; PG8_SCHED;
            } else {
            PG8_LDB(B0, 0, 0); PG8_SCHED; PG8_LDA(At, 0, 0); PG8_STAGE(PG8_SA(1, 1), a1 + hstepA, voffA);
            PG8_WAIT_L(8); PG8_BAR; PG8_WAIT_L(0); PG8_MMA(0, 0, At, B0); PG8_BAR; PG8_SCHED;
            PG8_LDB(B1, 0, 1); PG8_STAGE(PG8_SB(0, 0), b2, voffB);
            PG8_BAR; PG8_WAIT_L(0); PG8_MMA(0, 1, At, B1); PG8_BAR;
            PG8_LDA(At, 0, 1); PG8_STAGE(PG8_SA(0, 0), a2, voffA);
            PG8_BAR; PG8_WAIT_L(0); PG8_MMA(1, 0, At, B0); PG8_BAR; PG8_SCHED;
            PG8_STAGE(PG8_SB(0, 1), b2 + hstepB, voffB);
            PG8_WAIT_V(6); PG8_BAR; PG8_MMA(1, 1, At, B1); PG8_BAR;
            PG8_LDB(B0, 1, 0); PG8_SCHED; PG8_LDA(At, 1, 0); PG8_STAGE(PG8_SA(0, 1), a2 + hstepA, voffA);
            PG8_WAIT_L(8); PG8_BAR; PG8_WAIT_L(0); PG8_MMA(0, 0, At, B0); PG8_BAR; PG8_SCHED;
            PG8_LDB(B1, 1, 1); PG8_STAGE(PG8_SB(1, 0), b3, voffB);
            PG8_BAR; PG8_WAIT_L(0); PG8_MMA(0, 1, At, B1); PG8_BAR;
            PG8_LDA(At, 1, 1); PG8_STAGE(PG8_SA(1, 0), a3, voffA);
            PG8_BAR; PG8_WAIT_L(0); PG8_MMA(1, 0, At, B0); PG8_BAR; PG8_SCHED;
            PG8_STAGE(PG8_SB(1, 1), b3 + hstepB, voffB);
            PG8_WAIT_V(6); PG8_BAR; PG8_MMA(1, 1, At, B1); PG8_BAR;
            }
        }
        if constexpr (FP8) asm volatile("s_nop 15\n\ts_nop 15" ::: "memory");
        if constexpr (ALIGN_EPI) { if (wr == 0) PG8_BAR; }
        E(acc, cur, wr, wc, fr, fq); S.done(cur);
        if (!has_next) break;
#pragma unroll
        for (int a = 0; a < 2; ++a)
#pragma unroll
            for (int b = 0; b < 2; ++b)
#pragma unroll
                for (int m = 0; m < 4; ++m)
#pragma unroll
                    for (int n = 0; n < 2; ++n) acc[a][b][m][n] = (f32x4){0.f, 0.f, 0.f, 0.f};
        cur = nxt; cA = nA; cB = nB; ++ui;
        if constexpr (ALIGN_EPI) { if (wr == 1) PG8_BAR; }
    }
    PG8_WAIT_V(0);
    if constexpr (!ALIGN_EPI) { if (wr == 0) PG8_BAR; }
    PG8_BAR;
#undef PG8_SA
#undef PG8_SB
#undef PG8_STAGE
#undef PG8_LDA
#undef PG8_LDB
#undef PG8_MMA
#undef PG8_WAIT_V
#undef PG8_WAIT_L
#undef PG8_BAR
#undef PG8_SCHED
}

typedef f32x4 Acc[2][2][4][2];
struct EpiIn {
    static constexpr bool PERM = true;
    bf16_t* Z; bf16_t* AP; int f8; float scale;
    __device__ __forceinline__ void operator()(const Acc& acc, const Unit& u, int wr, int wc, int fr, int fq) const {
        const int pt = f8 ? win_fp8_tile(u.pn) : win_bf16_tile(u.pn), row0 = u.pm * BM + wr * 64 + fr, col0 = pt * BM + wc * 32 + 8 * fq; const bool sg = pt >= 22, s5 = pt >= 18 && pt < 22;
#pragma unroll
        for (int ai = 0; ai < 2; ++ai)
#pragma unroll
            for (int m = 0; m < 4; ++m) { const int row = row0 + ai * HALF + m * 16; bf16_t* rowp = Z + (size_t)row * NIN + col0;
#pragma unroll
                for (int bj = 0; bj < 2; ++bj) { f32x4 v0 = acc[ai][bj][m][0], v1 = acc[ai][bj][m][1];
                    if (sg) {
#pragma unroll
                        for (int j = 0; j < 4; ++j) { v0[j] = sigmoidf_(v0[j] * scale); v1[j] = sigmoidf_(v1[j] * scale); } }
                    else { v0 *= scale; v1 *= scale; }
                    u32x4 w; w.x = cvt_pk_bf16(v0[0], v0[1]); w.y = cvt_pk_bf16(v0[2], v0[3]); w.z = cvt_pk_bf16(v1[0], v1[1]); w.w = cvt_pk_bf16(v1[2], v1[3]);
                    if (s5) { const int cu = col0 + bj * HALF - C_U, g = cu >> 4, h0 = cu & 15;
                        *(u32x4*)(AP + ((size_t)(g * 768 + (row >> 4)) * 512 + (row & 15) * 16 + h0)) = w; }
                    else *(u32x4*)(rowp + bj * HALF) = w; } }
    }
};
struct EpiS {
    static constexpr bool PERM = true;
    float* S;
    __device__ __forceinline__ void operator()(const Acc& acc, const Unit& u, int wr, int wc, int fr, int fq) const {
        const int row0 = u.pm * BM + wr * 64 + fr, col0 = wc * 32 + 8 * fq;
#pragma unroll
        for (int ai = 0; ai < 2; ++ai)
#pragma unroll
            for (int m = 0; m < 4; ++m) { float* p = S + (size_t)(row0 + ai * HALF + m * 16) * 256 + col0;
#pragma unroll
                for (int bj = 0; bj < 2; ++bj) { *(f32x4*)(p + bj * HALF) = acc[ai][bj][m][0]; *(f32x4*)(p + bj * HALF + 4) = acc[ai][bj][m][1]; } }
    }
};
struct EpiY {
    static constexpr bool PERM = true;
    bf16_t* AG; int nchunk;
    __device__ __forceinline__ void operator()(const Acc& acc, const Unit& u, int wr, int wc, int fr, int fq) const {
        const int g = u.pn, c0 = (u.pm - 3 * g) * BM + wr * 64 + fr, n0 = wc * 32 + 8 * fq;
#pragma unroll
        for (int ai = 0; ai < 2; ++ai)
#pragma unroll
            for (int m = 0; m < 4; ++m) { const int c = c0 + ai * HALF + m * 16;
                if (c < nchunk) {
#pragma unroll
                    for (int bj = 0; bj < 2; ++bj) { const int n = n0 + bj * HALF, tt = n >> 4, h0 = n & 15; const f32x4 v0 = acc[ai][bj][m][0], v1 = acc[ai][bj][m][1];
                        u32x4 w; w.x = cvt_pk_bf16(gelu_tanh(v0[0]), gelu_tanh(v0[1])); w.y = cvt_pk_bf16(gelu_tanh(v0[2]), gelu_tanh(v0[3]));
                        w.z = cvt_pk_bf16(gelu_tanh(v1[0]), gelu_tanh(v1[1])); w.w = cvt_pk_bf16(gelu_tanh(v1[2]), gelu_tanh(v1[3]));
                        *(u32x4*)(AG + (size_t)(16 * c + tt) * 1024 + g * 16 + h0) = w; } } }
    }
};
struct EpiGate {
    static constexpr bool PERM = true;
    const bf16_t* Z; bf16_t* PG;
    __device__ __forceinline__ void operator()(const Acc& acc, const Unit& u, int wr, int wc, int fr, int fq) const {
        const int which = u.pm >= 33 ? 1 : 0, pm = u.pm - 33 * which, pn = u.pn - 8 * which;
        const int row0 = pm * BM + wr * 64 + fr, col0 = pn * BM + wc * 32 + 8 * fq;
        const bf16_t* gz = Z + C_G + which * DM + col0; bf16_t* out = PG + (size_t)which * NT * DM + col0;
#pragma unroll
        for (int ai = 0; ai < 2; ++ai)
#pragma unroll
            for (int m = 0; m < 4; ++m) { const size_t row = (size_t)(row0 + ai * HALF + m * 16);
#pragma unroll
                for (int bj = 0; bj < 2; ++bj) { float gt[8]; unpack8(*(const u32x4*)(gz + row * NIN + bj * HALF), gt);
                    const f32x4 v0 = acc[ai][bj][m][0], v1 = acc[ai][bj][m][1];
                    u32x4 w; w.x = cvt_pk_bf16(v0[0] * gt[0], v0[1] * gt[1]); w.y = cvt_pk_bf16(v0[2] * gt[2], v0[3] * gt[3]); w.z = cvt_pk_bf16(v1[0] * gt[4], v1[1] * gt[5]); w.w = cvt_pk_bf16(v1[2] * gt[6], v1[3] * gt[7]);
                    *(u32x4*)(out + row * DM + bj * HALF) = w; } }
    }
};
struct EpiGlu {
    static constexpr bool PERM = true;
    const bf16_t* Z; const bf16_t* PG; bf16_t* MRG;
    __device__ __forceinline__ void operator()(const Acc& acc, const Unit& u, int wr, int wc, int fr, int fq) const {
        const int row0 = u.pm * BM + wr * 64 + fr, mc0 = u.pn * HALF + wc * 32 + 8 * fq;
#pragma unroll
        for (int ai = 0; ai < 2; ++ai)
#pragma unroll
            for (int m = 0; m < 4; ++m) { const size_t row = (size_t)(row0 + ai * HALF + m * 16);
                float g2[8], pa[8], pb[8], o[8];
                unpack8(*(const u32x4*)(Z + row * NIN + C_G + 2 * DM + mc0), g2);
                unpack8(*(const u32x4*)(PG + row * DM + mc0), pa);
                unpack8(*(const u32x4*)(PG + (size_t)NT * DM + row * DM + mc0), pb);
                const f32x4 a0 = acc[ai][0][m][0], a1 = acc[ai][0][m][1], q0 = acc[ai][1][m][0], q1 = acc[ai][1][m][1];
#pragma unroll
                for (int j = 0; j < 4; ++j) { o[j] = pa[j] + pb[j] + g2[j] * a0[j] * sigmoidf_(q0[j]); o[4 + j] = pa[4 + j] + pb[4 + j] + g2[4 + j] * a1[j] * sigmoidf_(q1[j]); }
                *(u32x4*)(MRG + row * DM + mc0) = pack8(o); }
    }
};
struct EpiRes {
    static constexpr bool PERM = true;
    const float* ST; const float* lg; const float* lb; float* T; const float* gv_lat; const float* gv_ctx; float* SLAB;
    __device__ __forceinline__ void operator()(const Acc& acc, const Unit& u, int wr, int wc, int fr, int fq) const {
        const int row0 = u.pm * BM + wr * 64 + fr, col0 = u.pn * BM + wc * 32 + 8 * fq;
        if (u.nt != 0) {
            float* sl = SLAB + ((size_t)(u.kt0 / u.nt) * NCTX + (row0 - NLAT)) * DM + col0;
#pragma unroll
            for (int ai = 0; ai < 2; ++ai)
#pragma unroll
                for (int m = 0; m < 4; ++m) { const size_t off = (size_t)(ai * HALF + m * 16) * DM;
#pragma unroll
                    for (int bj = 0; bj < 2; ++bj) { *(f32x4*)(sl + off + bj * HALF) = acc[ai][bj][m][0]; *(f32x4*)(sl + off + bj * HALF + 4) = acc[ai][bj][m][1]; } }
            return;
        }
        const float* gv = (u.pm == 32 ? gv_ctx : gv_lat) + col0;
#pragma unroll
        for (int bj = 0; bj < 2; ++bj) {
            const f32x4 g0 = *(const f32x4*)(gv + bj * HALF), g1 = *(const f32x4*)(gv + bj * HALF + 4);
            const f32x4 a0 = *(const f32x4*)(lg + col0 + bj * HALF) * DN_ALPHA, a1 = *(const f32x4*)(lg + col0 + bj * HALF + 4) * DN_ALPHA;
            const f32x4 b0 = *(const f32x4*)(lb + col0 + bj * HALF) * DN_ALPHA, b1 = *(const f32x4*)(lb + col0 + bj * HALF + 4) * DN_ALPHA;
#pragma unroll
            for (int ai = 0; ai < 2; ++ai)
#pragma unroll
                for (int m = 0; m < 4; ++m) { const int row = row0 + ai * HALF + m * 16; const size_t off = (size_t)row * DM + col0 + bj * HALF;
                    const f32x2 st = *(const f32x2*)(ST + 2 * row);
                    const f32x4 x0 = *(const f32x4*)(T + off), x1 = *(const f32x4*)(T + off + 4);
                    *(f32x4*)(T + off) = ((x0 - st[0]) * st[1]) * a0 + b0 + g0 * acc[ai][bj][m][0];
                    *(f32x4*)(T + off + 4) = ((x1 - st[0]) * st[1]) * a1 + b1 + g1 * acc[ai][bj][m][1]; } }
    }
};
struct EpiSwi {
    static constexpr bool PERM = true;
    bf16_t* ACT;
    __device__ __forceinline__ void operator()(const Acc& acc, const Unit& u, int wr, int wc, int fr, int fq) const {
        const int row0 = u.pm * BM + wr * 64 + fr, c0 = u.pn * HALF + wc * 32 + 8 * fq;
#pragma unroll
        for (int ai = 0; ai < 2; ++ai)
#pragma unroll
            for (int m = 0; m < 4; ++m) { const size_t row = (size_t)(row0 + ai * HALF + m * 16);
                const f32x4 a0 = acc[ai][0][m][0], a1 = acc[ai][0][m][1], q0 = acc[ai][1][m][0], q1 = acc[ai][1][m][1]; float o[8];
#pragma unroll
                for (int j = 0; j < 4; ++j) { o[j] = siluf_(a0[j]) * q0[j]; o[4 + j] = siluf_(a1[j]) * q1[j]; }
                *(u32x4*)(ACT + row * FF + c0) = pack8(o); }
    }
};
}

namespace att {
constexpr int NW = 8, QBLK = 32, KVBLK = 64;
constexpr int LDQK = NIN;
constexpr size_t SHM_V = KVBLK * 128 * 2, SHM_K = KVBLK * 128 * 2, SHM_ATTN = 2 * SHM_V + 2 * SHM_K + NW * 64 * 4;
#define KSWZ(row, colB) ((row) * 256 + ((colB) ^ (((row) & 7) << 4)))
#define SBAR() __builtin_amdgcn_sched_barrier(0)
__device__ __forceinline__ int crow(int r, int hi) { return (r & 3) + 8 * (r >> 2) + 4 * hi; }
__device__ __forceinline__ unsigned cvtpk(float lo, float hi) { return cvt_pk_bf16(lo, hi); }

__device__ __forceinline__ float max3f(float a, float b, float c) { return __builtin_fmaxf(__builtin_fmaxf(a, b), c); }
template <bool FIRST>
__device__ __forceinline__ void partialSM(f32x16& p0, f32x16& p1, float& m_reg, f32x16& nb, float& alpha, const float thr) {
  float pmax;
  { float a0 = max3f(p0[0], p0[1], p0[2]), a1 = max3f(p0[3], p0[4], p0[5]), a2 = max3f(p0[6], p0[7], p0[8]), a3 = max3f(p0[9], p0[10], p0[11]);
    float a4 = max3f(p0[12], p0[13], p0[14]), a5 = max3f(p0[15], p1[0], p1[1]), a6 = max3f(p1[2], p1[3], p1[4]), a7 = max3f(p1[5], p1[6], p1[7]);
    float a8 = max3f(p1[8], p1[9], p1[10]), a9 = max3f(p1[11], p1[12], p1[13]);
    a0 = max3f(a0, a1, a2); a3 = max3f(a3, a4, a5); a6 = max3f(a6, a7, a8); a9 = max3f(a9, p1[14], p1[15]);
    a0 = max3f(a0, a3, a6); pmax = fmaxf(a0, a9); }
  { auto rr = __builtin_amdgcn_permlane32_swap(__float_as_uint(pmax), __float_as_uint(pmax), false, false);
    pmax = fmaxf(__uint_as_float(rr[0]), __uint_as_float(rr[1])); }
  if (!FIRST && __builtin_expect(__all(pmax <= thr), 1)) { alpha = 1.f; }
  else { const float d = FIRST ? pmax : fmaxf(pmax, 0.f); alpha = FIRST ? 1.f : __builtin_amdgcn_exp2f(-d); m_reg += d;
#pragma unroll
    for (int r = 0; r < 16; ++r) { p0[r] -= d; p1[r] -= d; nb[r] = -m_reg; }
    asm volatile("" : "+v"(nb)); }
#pragma unroll
  for (int r = 0; r < 16; ++r) p0[r] = __builtin_amdgcn_exp2f(p0[r]);
}
template <bool PACK = true>
__device__ __forceinline__ void finishSM(f32x16& p0, f32x16& p1, float alpha, float& l_reg, bf16x8& pa0, bf16x8& pa1, bf16x8& pa2, bf16x8& pa3) {
#pragma unroll
  for (int r = 0; r < 16; ++r) p1[r] = __builtin_amdgcn_exp2f(p1[r]);
  float ps = 0;
#pragma unroll
  for (int r = 0; r < 16; ++r) ps += p0[r];
#pragma unroll
  for (int r = 0; r < 16; ++r) ps += p1[r];
  { auto rr = __builtin_amdgcn_permlane32_swap(__float_as_uint(ps), __float_as_uint(ps), false, false);
    ps = __uint_as_float(rr[0]) + __uint_as_float(rr[1]); }
  l_reg = l_reg * alpha + ps;
#define PK4(P, BASE, OUT) do { u32x4 w = {cvtpk(P[BASE + 0], P[BASE + 1]), cvtpk(P[BASE + 2], P[BASE + 3]), cvtpk(P[BASE + 4], P[BASE + 5]), cvtpk(P[BASE + 6], P[BASE + 7])}; \
    OUT = *reinterpret_cast<bf16x8*>(&w); } while (0)
  if constexpr (PACK) { PK4(p0, 0, pa0); PK4(p0, 8, pa1); PK4(p1, 0, pa2); PK4(p1, 8, pa3); }
#undef PK4
}
__device__ __forceinline__ float rowmax32(const f32x16& p0, const f32x16& p1) {
  float a0 = max3f(p0[0], p0[1], p0[2]), a1 = max3f(p0[3], p0[4], p0[5]), a2 = max3f(p0[6], p0[7], p0[8]), a3 = max3f(p0[9], p0[10], p0[11]);
  float a4 = max3f(p0[12], p0[13], p0[14]), a5 = max3f(p0[15], p1[0], p1[1]), a6 = max3f(p1[2], p1[3], p1[4]), a7 = max3f(p1[5], p1[6], p1[7]);
  float a8 = max3f(p1[8], p1[9], p1[10]), a9 = max3f(p1[11], p1[12], p1[13]);
  a0 = max3f(a0, a1, a2); a3 = max3f(a3, a4, a5); a6 = max3f(a6, a7, a8); a9 = max3f(a9, p1[14], p1[15]);
  a0 = max3f(a0, a3, a6); float pmax = fmaxf(a0, a9);
  auto rr = __builtin_amdgcn_permlane32_swap(__float_as_uint(pmax), __float_as_uint(pmax), false, false);
  return fmaxf(__uint_as_float(rr[0]), __uint_as_float(rr[1]));
}
__device__ __forceinline__ void packP(const f32x16& p0, const f32x16& p1, bf16x8& pa0, bf16x8& pa1, bf16x8& pa2, bf16x8& pa3) {
#define PK4(P, BASE, OUT) do { u32x4 w = {cvtpk(P[BASE + 0], P[BASE + 1]), cvtpk(P[BASE + 2], P[BASE + 3]), cvtpk(P[BASE + 4], P[BASE + 5]), cvtpk(P[BASE + 6], P[BASE + 7])}; \
    OUT = *reinterpret_cast<bf16x8*>(&w); } while (0)
  PK4(p0, 0, pa0); PK4(p0, 8, pa1); PK4(p1, 0, pa2); PK4(p1, 8, pa3);
#undef PK4
}
constexpr float PS_BIG = 4096.f;
__device__ __forceinline__ void halfexp(f32x16& p0) {
#pragma unroll
  for (int r = 0; r < 16; ++r) p0[r] = __builtin_amdgcn_exp2f(p0[r]);
}
template <bool PACK = true>
__device__ __forceinline__ void finishFast(f32x16& p0, f32x16& p1, float& l_reg, float& psmax, bf16x8& pa0, bf16x8& pa1, bf16x8& pa2, bf16x8& pa3) {
  float dummy = 0.f; finishSM<PACK>(p0, p1, 0.f, dummy, pa0, pa1, pa2, pa3);
  l_reg += dummy; psmax = fmaxf(psmax, dummy);
}
typedef int v8i_att __attribute__((ext_vector_type(8)));
typedef int v4i_att __attribute__((ext_vector_type(4)));
__device__ __forceinline__ void packP8(const f32x16& p0, const f32x16& p1, v8i_att& p8) {
#pragma unroll
  for (int w = 0; w < 4; ++w) { p8[w] = (int)pk4_fp8(p0[4 * w], p0[4 * w + 1], p0[4 * w + 2], p0[4 * w + 3]); p8[4 + w] = (int)pk4_fp8(p1[4 * w], p1[4 * w + 1], p1[4 * w + 2], p1[4 * w + 3]); }
}
template <int D0> __device__ __forceinline__ void pv8_one(f32x16& od, const char* Vs, const v8i_att& p8, int r32, int hi) {
  const char* p = Vs + (D0 * 32 + r32) * 80 + 32 * hi;
  const v4i_att a = *reinterpret_cast<const v4i_att*>(p), b = *reinterpret_cast<const v4i_att*>(p + 16);
  od = __builtin_amdgcn_mfma_scale_f32_32x32x64_f8f6f4(p8, __builtin_shufflevector(a, b, 0, 1, 2, 3, 4, 5, 6, 7), od, 0, 0, 0, 0x7f7f7f7f, 0, 0x7f7f7f7f);
}
__device__ __forceinline__ void pv8(f32x16* o, const char* Vs, const v8i_att& p8, int r32, int hi) {
  pv8_one<0>(o[0], Vs, p8, r32, hi); pv8_one<1>(o[1], Vs, p8, r32, hi); pv8_one<2>(o[2], Vs, p8, r32, hi); pv8_one<3>(o[3], Vs, p8, r32, hi);
}
template <bool FULL>
__device__ __forceinline__ void qkt(f32x16& p0, f32x16& p1, const char* Ks, const bf16x8* qr, int r32, int hi, int kd0) {
  p0 = f32x16{}; p1 = f32x16{};
#pragma unroll
  for (int d0 = 0; d0 < (FULL ? 8 : 4); ++d0) { int cb = ((kd0 + d0) * 16 + hi * 8) * 2;
    bf16x8 b0 = *reinterpret_cast<const bf16x8*>(Ks + KSWZ(r32, cb));
    bf16x8 b1 = *reinterpret_cast<const bf16x8*>(Ks + KSWZ(32 + r32, cb));
    p0 = __builtin_amdgcn_mfma_f32_32x32x16_bf16(b0, qr[d0], p0, 0, 0, 0);
    p1 = __builtin_amdgcn_mfma_f32_32x32x16_bf16(b1, qr[d0], p1, 0, 0, 0); }
}
constexpr int QSC8 = 0x7c7c7c7c;
__device__ __forceinline__ void qkt8(f32x16& p0, f32x16& p1, const f32x16& nb, const char* Ks, const v8i_att* q8, int r32, int hi) {
#pragma unroll
  for (int s_ = 0; s_ < 2; ++s_) { const char* k0p = Ks + r32 * 144 + 64 * s_ + 32 * hi; const char* k1p = k0p + 32 * 144;
    const v4i_att a0 = *reinterpret_cast<const v4i_att*>(k0p), a1 = *reinterpret_cast<const v4i_att*>(k0p + 16), b0 = *reinterpret_cast<const v4i_att*>(k1p), b1 = *reinterpret_cast<const v4i_att*>(k1p + 16);
    p0 = __builtin_amdgcn_mfma_scale_f32_32x32x64_f8f6f4(__builtin_shufflevector(a0, a1, 0, 1, 2, 3, 4, 5, 6, 7), q8[s_], s_ == 0 ? nb : p0, 0, 0, 0, 0x7f7f7f7f, 0, QSC8);
    p1 = __builtin_amdgcn_mfma_scale_f32_32x32x64_f8f6f4(__builtin_shufflevector(b0, b1, 0, 1, 2, 3, 4, 5, 6, 7), q8[s_], s_ == 0 ? nb : p1, 0, 0, 0, 0x7f7f7f7f, 0, QSC8); }
}
__device__ __forceinline__ void qkt8d(f32x16& p0, f32x16& p1, const f32x16& nb, const char* Ks, const v8i_att& q8, int r32, int hi) {
  const char* k0p = Ks + r32 * 80 + 32 * hi; const char* k1p = k0p + 32 * 80;
  const v4i_att a0 = *reinterpret_cast<const v4i_att*>(k0p), a1 = *reinterpret_cast<const v4i_att*>(k0p + 16), b0 = *reinterpret_cast<const v4i_att*>(k1p), b1 = *reinterpret_cast<const v4i_att*>(k1p + 16);
  p0 = __builtin_amdgcn_mfma_scale_f32_32x32x64_f8f6f4(__builtin_shufflevector(a0, a1, 0, 1, 2, 3, 4, 5, 6, 7), q8, nb, 0, 0, 0, 0x7f7f7f7f, 0, QSC8);
  p1 = __builtin_amdgcn_mfma_scale_f32_32x32x64_f8f6f4(__builtin_shufflevector(b0, b1, 0, 1, 2, 3, 4, 5, 6, 7), q8, nb, 0, 0, 0, 0x7f7f7f7f, 0, QSC8);
}
__device__ __forceinline__ int v_st(int k, int c) { const int kk = k; return ((kk >> 3) * 4 + (c >> 5)) * 512 + ((kk & 7) * 32 + (c & 31)) * 2; }
__device__ __forceinline__ int v_rd_base(int lane) { return ((lane & 3) << 3) | (((lane >> 2) & 3) << 6) | (((lane >> 4) & 1) << 5) | (((lane >> 5) & 1) << 8); }
constexpr int v_rd_off(int d0, int ks, int half) { return d0 * 512 + ks * 4096 + half * 2048; }
template <int OFF> __device__ __forceinline__ s16x4 tr_read(int vb) {
  s16x4 r; asm volatile("ds_read_b64_tr_b16 %0, %1 offset:%2" : "=&v"(r) : "v"(vb), "i"(OFF) : "memory"); return r;
}
template <int D0> __device__ __forceinline__ void pv_one(f32x16& od, int vb, bf16x8 pa0, bf16x8 pa1, bf16x8 pa2, bf16x8 pa3) {
  const s16x4 l0 = tr_read<v_rd_off(D0, 0, 0)>(vb), h0 = tr_read<v_rd_off(D0, 0, 1)>(vb), l1 = tr_read<v_rd_off(D0, 1, 0)>(vb), h1 = tr_read<v_rd_off(D0, 1, 1)>(vb);
  const s16x4 l2 = tr_read<v_rd_off(D0, 2, 0)>(vb), h2 = tr_read<v_rd_off(D0, 2, 1)>(vb), l3 = tr_read<v_rd_off(D0, 3, 0)>(vb), h3 = tr_read<v_rd_off(D0, 3, 1)>(vb);
  asm volatile("s_waitcnt lgkmcnt(0)" ::: "memory"); SBAR();
#define PK(L, H) (bf16x8){L[0], L[1], L[2], L[3], H[0], H[1], H[2], H[3]}
  od = __builtin_amdgcn_mfma_f32_32x32x16_bf16(pa0, PK(l0, h0), od, 0, 0, 0);
  od = __builtin_amdgcn_mfma_f32_32x32x16_bf16(pa1, PK(l1, h1), od, 0, 0, 0);
  od = __builtin_amdgcn_mfma_f32_32x32x16_bf16(pa2, PK(l2, h2), od, 0, 0, 0);
  od = __builtin_amdgcn_mfma_f32_32x32x16_bf16(pa3, PK(l3, h3), od, 0, 0, 0);
#undef PK
}
__device__ __forceinline__ void pv_d0(f32x16* o, int vb, bf16x8 pa0, bf16x8 pa1, bf16x8 pa2, bf16x8 pa3) {
  pv_one<0>(o[0], vb, pa0, pa1, pa2, pa3); pv_one<1>(o[1], vb, pa0, pa1, pa2, pa3); pv_one<2>(o[2], vb, pa0, pa1, pa2, pa3); pv_one<3>(o[3], vb, pa0, pa1, pa2, pa3);
}


template <bool FULL, bool FAST>
__device__ __forceinline__ bool attn_dense_body(const bf16_t* __restrict__ Qb, const bf16_t* __restrict__ Kh, const bf16_t* __restrict__ Vh,
                                                bf16_t* __restrict__ Ob, const int ldo, const int seq, const int kd0, const float C, const float thr_s, char* lds) {
  const int tid = opaque_tid(), wid = tid >> 6, lane = tid & 63, r32 = lane & 31, hi = lane >> 5;
  char* V_lds = lds; char* K_lds = lds + 2 * SHM_V;
  float* ws = (float*)(lds + 2 * SHM_V + 2 * SHM_K) + wid * 64; float* li_l = ws; float* al_l = ws + 32;
  float m_reg = 0.f, l_reg = 0, psmax = 0.f; f32x16 o[4] = {}; f32x16 nb = {}; v8i_att q8[2]; (void)psmax;
  if constexpr (FULL) {
    const char* Q8w = (const char*)Qb + (long)(wid * QBLK + r32) * 1024 + 32 * hi;
#pragma unroll
    for (int s_ = 0; s_ < 2; ++s_) { const v4i_att x0 = *reinterpret_cast<const v4i_att*>(Q8w + 64 * s_), x1 = *reinterpret_cast<const v4i_att*>(Q8w + 64 * s_ + 16); q8[s_] = __builtin_shufflevector(x0, x1, 0, 1, 2, 3, 4, 5, 6, 7); }
  } else {
    const char* Q8w = (const char*)Qb + (long)(wid * QBLK + r32) * 2048 + 32 * hi;
    const v4i_att x0 = *reinterpret_cast<const v4i_att*>(Q8w), x1 = *reinterpret_cast<const v4i_att*>(Q8w + 16); q8[0] = __builtin_shufflevector(x0, x1, 0, 1, 2, 3, 4, 5, 6, 7);
  }
  const int sr = tid >> 4, sc = (tid & 15) * 8, vst0 = v_st(sr, sc), vst1 = v_st(32 + sr, sc);
  const int vb0 = (int)(uintptr_t)V_lds + v_rd_base(lane);
  constexpr int SDEPTH = 1;
  struct { bf16x8 vs0, vs1, ks0; } sr_[SDEPTH]; u32x2 kd8 = {0u, 0u}; v8i_att p8 = {}; (void)p8;
  const unsigned goff0 = (unsigned)(sr * LDQK + sc) * 2u, goff1 = goff0 + 32u * LDQK * 2u;
  const unsigned goffk = (unsigned)((tid >> 3) * LDQK + (tid & 7) * 8) * 2u;
#define SLOAD(i, k0) do { sr_[i].vs0 = *reinterpret_cast<const bf16x8*>((const char*)Vh + (size_t)((k0) >> 6) * 8192 + tid * 16); \
    if constexpr (FULL) sr_[i].ks0 = *reinterpret_cast<const bf16x8*>((const char*)Kh + (size_t)((k0) + (tid >> 3)) * 256 + (tid & 7) * 16); \
    else kd8 = *reinterpret_cast<const u32x2*>((const char*)Kh + (size_t)((k0) + (tid >> 3)) * 2048 + (tid & 7) * 8); } while (0)
#define SWRITE(b, i) do { *(bf16x8*)(V_lds + (b) * SHM_V + (tid >> 2) * 80 + (tid & 3) * 16) = sr_[i].vs0; \
    if constexpr (FULL) *(bf16x8*)(K_lds + (b) * SHM_K + (tid >> 3) * 144 + (tid & 7) * 16) = sr_[i].ks0; \
    else *(u32x2*)(K_lds + (b) * SHM_K + (tid >> 3) * 80 + (tid & 7) * 8) = kd8; } while (0)
#define PV(b) do { pv8(o, V_lds + (b) * SHM_V, p8, r32, hi); } while (0)
#define QKT(P0, P1, KS) do { if constexpr (FULL) qkt8(P0, P1, nb, KS, q8, r32, hi); else qkt8d(P0, P1, nb, KS, q8[0], r32, hi); } while (0)
#define SWAIT() do { if constexpr (SDEPTH == 2) asm volatile("s_waitcnt vmcnt(4)" ::: "memory"); else asm volatile("s_waitcnt vmcnt(0)" ::: "memory"); } while (0)
#define RESC(a) do { if constexpr (!FAST) if (__any((a) < 1.f)) { if (hi == 0) al_l[r32] = (a); asm volatile("s_waitcnt lgkmcnt(0)" ::: "memory"); \
    _Pragma("unroll") for (int d = 0; d < 4; ++d) _Pragma("unroll") for (int r = 0; r < 16; ++r) o[d][r] *= al_l[crow(r, hi)]; } } while (0)
#define PSM(P0, P1, AL) do { if constexpr (FAST) halfexp(P0); else partialSM<false>(P0, P1, m_reg, nb, AL, thr_s); } while (0)
#define FSM(P0, P1, AL) do { if constexpr (FAST) finishFast<false>(P0, P1, l_reg, psmax, pa0, pa1, pa2, pa3); else finishSM<false>(P0, P1, AL, l_reg, pa0, pa1, pa2, pa3); \
    packP8(P0, P1, p8); } while (0)
  f32x16 pA0, pA1, pB0, pB1; float alA = 1.f, alB = 1.f; bf16x8 pa0, pa1, pa2, pa3; const int NT_ = seq / KVBLK; (void)C;
  constexpr int SE = 0, SO = SDEPTH - 1;
  if constexpr (FAST) {
    float psA = 0.f, psB = 0.f;
#define SOFTQ(N0, N1, PSN, q) do { _Pragma("unroll") for (int r = 0; r < 8; ++r) { if constexpr ((q) < 2) { N0[8 * (q) + r] = __builtin_amdgcn_exp2f(N0[8 * (q) + r]); PSN += N0[8 * (q) + r]; } \
      else { N1[8 * ((q) - 2) + r] = __builtin_amdgcn_exp2f(N1[8 * ((q) - 2) + r]); PSN += N1[8 * ((q) - 2) + r]; } } } while (0)
#define PVQ(b, D) do { pv8_one<D>(o[D], V_lds + (b) * SHM_V, p8, r32, hi); } while (0)
#define PVS(b, N0, N1, PSN) do { PSN = 0.f; PVQ(b, 0); SOFTQ(N0, N1, PSN, 0); PVQ(b, 1); SOFTQ(N0, N1, PSN, 1); PVQ(b, 2); SOFTQ(N0, N1, PSN, 2); PVQ(b, 3); SOFTQ(N0, N1, PSN, 3); } while (0)
#define FIN(P0, P1, PS) do { { auto rr_ = __builtin_amdgcn_permlane32_swap(__float_as_uint(PS), __float_as_uint(PS), false, false); PS = __uint_as_float(rr_[0]) + __uint_as_float(rr_[1]); } \
      l_reg += PS; psmax = fmaxf(psmax, PS); packP8(P0, P1, p8); } while (0)
    constexpr int FS_K = 8192, FS_STAGE = 16384;
    const int wv_ = __builtin_amdgcn_readfirstlane(wid);
    const unsigned gV = (unsigned)((tid >> 2) * 64 + (((tid & 3) ^ ((tid >> 4) & 3)) * 16));
    const unsigned gK = FULL ? (unsigned)((tid >> 3) * 256 + (((tid & 7) ^ ((tid >> 4) & 7)) * 16))
                             : (unsigned)((tid >> 2) * 2048 + (((tid & 3) ^ ((tid >> 4) & 3)) * 16));
    const int swv = (r32 >> 2) & 3, vA = r32 * 64 + ((2 * hi) ^ swv) * 16, vB = r32 * 64 + ((2 * hi + 1) ^ swv) * 16;
    const int swk = FULL ? (r32 >> 1) & 7 : (r32 >> 2) & 3;
    const int kA0 = FULL ? r32 * 128 + ((2 * hi) ^ swk) * 16 : r32 * 64 + ((2 * hi) ^ swk) * 16, kB0 = FULL ? r32 * 128 + ((2 * hi + 1) ^ swk) * 16 : r32 * 64 + ((2 * hi + 1) ^ swk) * 16;
    const int kA1 = r32 * 128 + ((4 + 2 * hi) ^ swk) * 16, kB1 = r32 * 128 + ((5 + 2 * hi) ^ swk) * 16;
#define DMA(st, k0) do { __builtin_amdgcn_global_load_lds((const unsigned*)((const char*)Vh + (size_t)((k0) >> 6) * 8192 + gV), (LAS unsigned*)((LAS char*)(uintptr_t)(unsigned)(uintptr_t)lds + (st) + wv_ * 1024), 16, 0, 0); \
      if constexpr (FULL) __builtin_amdgcn_global_load_lds((const unsigned*)((const char*)Kh + (size_t)(k0) * 256 + gK), (LAS unsigned*)((LAS char*)(uintptr_t)(unsigned)(uintptr_t)lds + (st) + FS_K + wv_ * 1024), 16, 0, 0); \
      else if (wv_ < 4) __builtin_amdgcn_global_load_lds((const unsigned*)((const char*)Kh + (size_t)(k0) * 2048 + gK), (LAS unsigned*)((LAS char*)(uintptr_t)(unsigned)(uintptr_t)lds + (st) + FS_K + wv_ * 1024), 16, 0, 0); } while (0)
#define LDV4(off) (*reinterpret_cast<const v4i_att*>(lds + (off)))
#define QKTS(P0, P1, st) do { const int kb_ = (st) + FS_K; \
      if constexpr (FULL) { const v4i_att a0 = LDV4(kb_ + kA0), a1 = LDV4(kb_ + kB0), b0 = LDV4(kb_ + 4096 + kA0), b1 = LDV4(kb_ + 4096 + kB0); \
        const v4i_att c0 = LDV4(kb_ + kA1), c1 = LDV4(kb_ + kB1), d0 = LDV4(kb_ + 4096 + kA1), d1 = LDV4(kb_ + 4096 + kB1); \
        P0 = __builtin_amdgcn_mfma_scale_f32_32x32x64_f8f6f4(__builtin_shufflevector(a0, a1, 0, 1, 2, 3, 4, 5, 6, 7), q8[0], nb, 0, 0, 0, 0x7f7f7f7f, 0, QSC8); \
        P1 = __builtin_amdgcn_mfma_scale_f32_32x32x64_f8f6f4(__builtin_shufflevector(b0, b1, 0, 1, 2, 3, 4, 5, 6, 7), q8[0], nb, 0, 0, 0, 0x7f7f7f7f, 0, QSC8); \
        P0 = __builtin_amdgcn_mfma_scale_f32_32x32x64_f8f6f4(__builtin_shufflevector(c0, c1, 0, 1, 2, 3, 4, 5, 6, 7), q8[1], P0, 0, 0, 0, 0x7f7f7f7f, 0, QSC8); \
        P1 = __builtin_amdgcn_mfma_scale_f32_32x32x64_f8f6f4(__builtin_shufflevector(d0, d1, 0, 1, 2, 3, 4, 5, 6, 7), q8[1], P1, 0, 0, 0, 0x7f7f7f7f, 0, QSC8); } \
      else { const v4i_att a0 = LDV4(kb_ + kA0), a1 = LDV4(kb_ + kB0), b0 = LDV4(kb_ + 2048 + kA0), b1 = LDV4(kb_ + 2048 + kB0); \
        P0 = __builtin_amdgcn_mfma_scale_f32_32x32x64_f8f6f4(__builtin_shufflevector(a0, a1, 0, 1, 2, 3, 4, 5, 6, 7), q8[0], nb, 0, 0, 0, 0x7f7f7f7f, 0, QSC8); \
        P1 = __builtin_amdgcn_mfma_scale_f32_32x32x64_f8f6f4(__builtin_shufflevector(b0, b1, 0, 1, 2, 3, 4, 5, 6, 7), q8[0], nb, 0, 0, 0, 0x7f7f7f7f, 0, QSC8); } } while (0)
#undef PVQ
#define PVQ(st, D) do { const v4i_att a_ = LDV4((st) + (D) * 2048 + vA), b_ = LDV4((st) + (D) * 2048 + vB); \
      o[D] = __builtin_amdgcn_mfma_scale_f32_32x32x64_f8f6f4(p8, __builtin_shufflevector(a_, b_, 0, 1, 2, 3, 4, 5, 6, 7), o[D], 0, 0, 0, 0x7f7f7f7f, 0, 0x7f7f7f7f); } while (0)
#define STEP_END() do { asm volatile("s_waitcnt vmcnt(0)" ::: "memory"); __syncthreads(); { const int t_ = oC; oC = oN; oN = oW; oW = t_; } } while (0)
    int oC = 0, oN = FS_STAGE, oW = 2 * FS_STAGE;
    DMA(0, 0); DMA(FS_STAGE, KVBLK); asm volatile("s_waitcnt vmcnt(0)" ::: "memory"); __syncthreads();
    QKTS(pA0, pA1, oC);
    { const float d = rowmax32(pA0, pA1); m_reg = d;
#pragma unroll
      for (int r = 0; r < 16; ++r) { pA0[r] = __builtin_amdgcn_exp2f(pA0[r] - d); pA1[r] = __builtin_amdgcn_exp2f(pA1[r] - d); nb[r] = -d; }
      asm volatile("" : "+v"(nb));
#pragma unroll
      for (int r = 0; r < 16; ++r) psA += pA0[r] + pA1[r]; }
    for (int j = 0; j + 2 < NT_; j += 2) {
      DMA(oW, (j + 2) * KVBLK); SBAR(); QKTS(pB0, pB1, oN);
      FIN(pA0, pA1, psA); SBAR();
      PVS(oC, pB0, pB1, psB);
      STEP_END();
      DMA(oW, (j + 3) * KVBLK); SBAR(); QKTS(pA0, pA1, oN);
      FIN(pB0, pB1, psB); SBAR();
      PVS(oC, pA0, pA1, psA);
      STEP_END();
    }
    SBAR(); QKTS(pB0, pB1, oN);
    FIN(pA0, pA1, psA); SBAR();
    PVS(oC, pB0, pB1, psB);
    FIN(pB0, pB1, psB); SBAR();
    PVQ(oN, 0); PVQ(oN, 1); PVQ(oN, 2); PVQ(oN, 3);
#undef DMA
#undef LDV4
#undef QKTS
#undef STEP_END
#undef SOFTQ
#undef PVQ
#undef PVS
#undef FIN
  } else {
  SLOAD(SE, 0); asm volatile("s_waitcnt vmcnt(0)" ::: "memory"); SWRITE(0, SE); __syncthreads();
  QKT(pA0, pA1, K_lds); partialSM<true>(pA0, pA1, m_reg, nb, alA, thr_s);
  SLOAD(SO, KVBLK); if constexpr (SDEPTH == 2) { if (2 < NT_) SLOAD(SE, 2 * KVBLK); }
  SWAIT(); SWRITE(1, SO); __syncthreads();
  for (int j = 1; j + 1 < NT_; j += 2) {
    SBAR(); QKT(pB0, pB1, K_lds + SHM_K);
    FSM(pA0, pA1, alA); SBAR();
    SLOAD(SO, (j + SDEPTH) * KVBLK); SBAR();
    PV(0); PSM(pB0, pB1, alB);
    __syncthreads(); SWAIT(); SWRITE(0, SE);
    RESC(alB); __syncthreads();
    SBAR(); QKT(pA0, pA1, K_lds);
    FSM(pB0, pB1, alB); SBAR();
    if (SDEPTH == 1 || j + 3 < NT_) SLOAD(SE, (j + 1 + SDEPTH) * KVBLK); SBAR();
    PV(1); PSM(pA0, pA1, alA);
    __syncthreads(); SWAIT(); SWRITE(1, SO);
    RESC(alA); __syncthreads();
  }
  SBAR(); QKT(pB0, pB1, K_lds + SHM_K);
  FSM(pA0, pA1, alA); SBAR();
  PV(0); PSM(pB0, pB1, alB);
  __syncthreads(); RESC(alB);
  FSM(pB0, pB1, alB); SBAR();
  PV(1);
  }
  if constexpr (FAST) {
    int* badf = (int*)(lds + SHM_ATTN); const bool wbad = !__all(psmax <= 256.f);
    if (lane == 0) badf[wid] = wbad ? 1 : 0;
    __syncthreads();
    int anyb = 0;
#pragma unroll
    for (int w = 0; w < NW; ++w) anyb |= badf[w];
    if (__builtin_amdgcn_readfirstlane(anyb)) return true;
  }
  if (hi == 0) li_l[r32] = l_reg; asm volatile("s_waitcnt lgkmcnt(0)" ::: "memory");
  float rli[16];
#pragma unroll
  for (int r = 0; r < 16; ++r) rli[r] = __builtin_amdgcn_rcpf(li_l[crow(r, hi)]);
  bf16_t* Ow = Ob + (long)(wid * QBLK) * ldo;
#pragma unroll
  for (int r = 0; r < 16; ++r) { int orow = crow(r, hi);
#pragma unroll
    for (int d0 = 0; d0 < 4; ++d0) Ow[(long)orow * ldo + d0 * 32 + r32] = (bf16_t)f2bf(o[d0][r] * rli[r]); }
#undef SLOAD
#undef SWRITE
#undef SWAIT
#undef QKT
#undef RESC
#undef PSM
#undef FSM
#undef PV
  return false;
}
}

#define XB_TMO      128
#define XB_XCNT(j)  (256  + 64 * (j))
#define XB_XSUB(j)  (1280 + 64 * (j))
#define XB_XGEN(j)  (2304 + 64 * (j))
#define XB_TOP      3328
#define XB_TOPGEN   3392
#define XCD_BAR_WORDS 3456
#define XB_SPIN_CAP (1u << 21)
__device__ __forceinline__ unsigned xb_ld(unsigned* p)              { return __hip_atomic_load(p, __ATOMIC_RELAXED, __HIP_MEMORY_SCOPE_AGENT); }
__device__ __forceinline__ unsigned xb_add(unsigned* p, unsigned v) { return __hip_atomic_fetch_add(p, v, __ATOMIC_RELAXED, __HIP_MEMORY_SCOPE_AGENT); }
__device__ __forceinline__ unsigned xb_xcc_id() { return (unsigned)__builtin_amdgcn_s_getreg((3 << 11) | 20) & 0xFu; }
#define XB_SPIN(cond, bar) do { unsigned _sp = 0; while (cond) { __builtin_amdgcn_s_sleep(1); \
    if ((++_sp & 255u) == 0u) { if (xb_ld(&(bar)[XB_TMO])) break; if (_sp > XB_SPIN_CAP) { atomicAdd(&(bar)[XB_TMO], 1u); break; } } } } while (0)
struct XcdBarrier { unsigned* bar; unsigned x; volatile LAS unsigned* st; };
__device__ __forceinline__ XcdBarrier xcd_barrier_post(unsigned* bar, volatile LAS unsigned* st) {
    XcdBarrier b; b.bar = bar; b.x = (unsigned)__builtin_amdgcn_readfirstlane((int)xb_xcc_id()); b.st = st;
    if (threadIdx.x == 0) (void)xb_add(&bar[XB_XCNT(b.x)], 1u);
    return b;
}
__device__ __forceinline__ void xcd_barrier_complete(unsigned* bar, unsigned x, unsigned& nloc, unsigned& nx) {
    const unsigned G = gridDim.x * gridDim.y * gridDim.z;
    unsigned sum, cnt, mine, sp = 0u;
    for (;;) {
        sum = 0u; cnt = 0u; mine = 0u;
#pragma unroll
        for (unsigned j = 0; j < 16; ++j) { const unsigned c = xb_ld(&bar[XB_XCNT(j)]); sum += c; cnt += (c > 0u) ? 1u : 0u; mine = (j == x) ? c : mine; }
        if (sum == G) break;
        __builtin_amdgcn_s_sleep(1);
        if ((++sp & 255u) == 0u) { if (xb_ld(&bar[XB_TMO])) break; if (sp > XB_SPIN_CAP) { atomicAdd(&bar[XB_TMO], 1u); break; } }
    }
    nloc = mine > 0u ? mine : 1u; nx = cnt > 0u ? cnt : 1u;
}
__device__ __forceinline__ void xcd_barrier(const XcdBarrier& b) {
    asm volatile("s_waitcnt vmcnt(0)" ::: "memory");
    __syncthreads();
    if (threadIdx.x == 0) {
        unsigned* bar = b.bar;
        __builtin_amdgcn_s_waitcnt(0);
        unsigned nloc = b.st[0], nx = b.st[1];
        if (nloc == 0u) { xcd_barrier_complete(bar, b.x, nloc, nx); b.st[0] = nloc; b.st[1] = nx; }
        const unsigned old = xb_add(&bar[XB_XSUB(b.x)], 1u);
        const unsigned gen = old / nloc;
        if (old + 1u == (gen + 1u) * nloc) {
            __builtin_amdgcn_fence(__ATOMIC_RELEASE, "agent");
            asm volatile("s_waitcnt vmcnt(0)" ::: "memory");
            const unsigned og = xb_add(&bar[XB_TOP], 1u);
            const unsigned tg = og / nx;
            if (og + 1u == (tg + 1u) * nx) xb_add(&bar[XB_TOPGEN], 1u);
            else XB_SPIN(xb_ld(&bar[XB_TOPGEN]) == tg, bar);
            __builtin_amdgcn_fence(__ATOMIC_ACQUIRE, "agent");
            xb_add(&bar[XB_XGEN(b.x)], 1u);
            asm volatile("s_waitcnt vmcnt(0)" ::: "memory");
        } else {
            XB_SPIN(xb_ld(&bar[XB_XGEN(b.x)]) == gen, bar);
            __builtin_amdgcn_fence(__ATOMIC_ACQUIRE, "agent");
            asm volatile("s_waitcnt vmcnt(0)" ::: "memory");
        }
    }
    __syncthreads();
}

constexpr int RING_BYTES = 131072, MISC_OFF = RING_BYTES + 320, LDS_BYTES = 147456;

struct Args { const float* in[33]; float* out; unsigned char* ws; };
enum { I_X = 0, I_C, I_CTX, I_CCTX, I_WADA, I_BADA, I_WIN, I_LQ1, I_LK1, I_LQ2, I_LK2, I_SUBLN, I_WPA, I_QNORM, I_KNORM, I_WPB, I_ARE, I_AIM, I_LOGDT, I_BRE, I_BIM, I_CRE, I_CIM,
       I_S5D, I_WGLU, I_WO, I_LNMG, I_LNMB, I_WG, I_WU, I_WD, I_LNFG, I_LNFB };

typedef const float* cfp_t;
struct InTab {
    __device__ __forceinline__ cfp_t operator[](int i) const {
        const __attribute__((address_space(4))) unsigned char* k = (const __attribute__((address_space(4))) unsigned char*)__builtin_amdgcn_kernarg_segment_ptr();
        asm volatile("" : "+s"(k));
        return (cfp_t)(const GAS float*)(*(const __attribute__((address_space(4))) cfp_t*)(k + 8 * i));
    }
};
struct Frame {
    LAS unsigned char* lds; int tid, lane, wave, vcu, G, gw, NGW;
    InTab in; GAS float* out; GAS unsigned char* ws;
};

__device__ __forceinline__ void transpose_item(const float* W, int K, int N, bf16_t* WT, int k0, int n0, int out_row0, LAS float* scr, int lane, bool fp8 = false) {
    const float* src = W + (size_t)k0 * N + n0 + lane;
#pragma unroll
    for (int h = 0; h < 2; ++h) { float v[32];
#pragma unroll
        for (int i = 0; i < 32; ++i) v[i] = src[(size_t)(32 * h + i) * N];
#pragma unroll
        for (int i = 0; i < 32; ++i) scr[(32 * h + i) * 64 + (lane ^ (8 * ((32 * h + i) >> 3)))] = v[i]; }
    LDS_WAIT(); asm volatile("" ::: "memory");
    const int c = lane & 7;
#pragma unroll
    for (int j = 0; j < 8; ++j) { const int n = (lane >> 3) + 8 * j; const LAS float* s = scr + (8 * c) * 64 + (n ^ (8 * c));
        if (fp8) { u32x2 o8; o8.x = pk4_fp8(64.f * s[0 * 64], 64.f * s[1 * 64], 64.f * s[2 * 64], 64.f * s[3 * 64]); o8.y = pk4_fp8(64.f * s[4 * 64], 64.f * s[5 * 64], 64.f * s[6 * 64], 64.f * s[7 * 64]);
            *(u32x2*)((unsigned char*)WT + (size_t)(out_row0 + n) * K + k0 + 8 * c) = o8; }
        else { u32x4 o; o.x = pk2(s[0 * 64], s[1 * 64]); o.y = pk2(s[2 * 64], s[3 * 64]); o.z = pk2(s[4 * 64], s[5 * 64]); o.w = pk2(s[6 * 64], s[7 * 64]);
        *(u32x4*)(WT + (size_t)(out_row0 + n) * K + k0 + 8 * c) = o; } }
    LDS_WAIT(); asm volatile("" ::: "memory");
}
constexpr int IT_IN = (DM / 64) * (NIN / 64), IT_PA = (1024 / 64) * (DM / 64), IT_PB = IT_PA, IT_GLU = (1024 / 64) * (4096 / 64), IT_O = (DM / 64) * (DM / 64),
              IT_G = (DM / 64) * (FF / 64), IT_U = IT_G, IT_D = (FF / 64) * (DM / 64);
constexpr int IT_LAYER = IT_IN + IT_PA + IT_PB + IT_GLU + IT_O + IT_G + IT_U + IT_D;

__device__ __forceinline__ void convert_item(Frame& F, int it, LAS float* scr) {
    const int l = it / IT_LAYER; int r = it % IT_LAYER;
    GAS unsigned char* wl = F.ws + WS_W + (size_t)l * W_LAYER;
    const float* W; int K, N; bf16_t* WT; int mode;
    int rowoff = 0;
    if (r < IT_IN) { W = F.in[I_WIN] + (size_t)l * DM * NIN; K = DM; N = NIN; WT = (bf16_t*)(wl + W_IN); mode = 0; }
    else if ((r -= IT_IN) < IT_PA) { W = F.in[I_WPA] + (size_t)l * 1024 * DM; K = 1024; N = DM; WT = (bf16_t*)(wl + W_PAB); mode = 0; }
    else if ((r -= IT_PA) < IT_PB) { W = F.in[I_WPB] + (size_t)l * 1024 * DM; K = 1024; N = DM; WT = (bf16_t*)(wl + W_PAB); mode = 0; rowoff = 2048; }
    else if ((r -= IT_PB) < IT_GLU) { W = F.in[I_WGLU] + (size_t)l * 1024 * 4096; K = 1024; N = 4096; WT = (bf16_t*)(wl + W_GLU); mode = 1; }
    else if ((r -= IT_GLU) < IT_O) { W = F.in[I_WO] + (size_t)l * DM * DM; K = DM; N = DM; WT = (bf16_t*)(wl + W_O); mode = 0; }
    else if ((r -= IT_O) < IT_G) { W = F.in[I_WG] + (size_t)l * DM * FF; K = DM; N = FF; WT = (bf16_t*)(wl + W_GU); mode = 2; }
    else if ((r -= IT_G) < IT_U) { W = F.in[I_WU] + (size_t)l * DM * FF; K = DM; N = FF; WT = (bf16_t*)(wl + W_GU); mode = 3; }
    else { r -= IT_U; W = F.in[I_WD] + (size_t)l * FF * DM; K = FF; N = DM; WT = (bf16_t*)(wl + W_DN); mode = 0; }
    const int nblk = N / 64, kb = r / nblk, nb = r % nblk, k0 = 64 * kb, n0 = 64 * nb;
    int orow; bool fp8 = false;
    if (mode == 0 && N == NIN) { const int pt = n0 >> 8; orow = win_tile_slot(pt) * 256 + (n0 & 255);
        if (win_tile_fp8(pt)) { fp8 = true; WT = (bf16_t*)(wl + W_IN8); } }
    else if (mode == 0) orow = rowoff + n0;
    else if (mode == 1) orow = 256 * ((n0 % 2048) / 128) + 128 * (n0 / 2048) + (n0 % 128);
    else orow = 256 * (n0 / 128) + (mode == 3 ? 128 : 0) + (n0 % 128);
    transpose_item(W, K, N, WT, k0, n0, orow, scr, F.lane, fp8);
}

__device__ __forceinline__ void mod_item(Frame& F, int it) {
    const int cb = it % 48, slab = (it / 48) % MOD_SLABS, l = it / (48 * MOD_SLABS);
    const int col = cb * 256 + 4 * F.lane, k0 = slab * 64;
    const float* W = F.in[I_WADA] + ((size_t)l * DM + k0) * 12288 + col;
    const float* c = F.in[I_C] + k0; const float* cc = F.in[I_CCTX] + k0;
    f32x4 a0 = {0.f, 0.f, 0.f, 0.f}, a1 = a0;
#pragma unroll 8
    for (int k = 0; k < 64; ++k) { const f32x4 w = *(const f32x4*)(W + (size_t)k * 12288); const float s0 = siluf_(c[k]), s1 = siluf_(cc[k]); a0 += w * s0; a1 += w * s1; }
    float* P = (float*)(F.ws + WS_MODP) + (((size_t)slab * NL + l) * 2) * 12288 + col;
    *(f32x4*)P = a0; *(f32x4*)(P + 12288) = a1;
}

__device__ __forceinline__ void s5_param_item(Frame& F, int it) {
    const int p = it & 63, g = (it >> 6) & 63, dir = (it >> 12) & 1, l = it >> 13;
    const int gi = (l * 2 + dir) * 64 + g;
    double are = (double)F.in[I_ARE][gi * 64 + p]; if (are > -1e-4) are = (double)(-1e-4f);
    const double aim = (double)F.in[I_AIM][gi * 64 + p];
    const double dt = dexp((double)F.in[I_LOGDT][gi]);
    double s, c; dsincos(aim * dt, s, c);
    const double mag = dexp(are * dt), lr = mag * c, li = mag * s;
    const double den = are * are + aim * aim, nr = lr - 1.0;
    const double cr = (nr * are + li * aim) / den, ci = (li * are - nr * aim) / den;
    const float* bre = F.in[I_BRE] + ((size_t)gi * 64 + p) * 16; const float* bim = F.in[I_BIM] + ((size_t)gi * 64 + p) * 16;
    f32x2* BBF = (f32x2*)(F.ws + WS_BBF) + ((size_t)gi * 64 + p) * 16;
#pragma unroll
    for (int h = 0; h < 16; ++h) { const double br = bre[h], bi = bim[h];
        BBF[h] = (f32x2){(float)(cr * br - ci * bi), (float)(cr * bi + ci * br)}; }
    { f32x2* POW = (f32x2*)(F.ws + WS_POW) + (size_t)gi * 17 * 64 + p; double pr = 1.0, pi = 0.0;
      for (int k = 0; k <= 16; ++k) { POW[k * 64] = (f32x2){(float)pr, (float)pi}; const double nr = pr * lr - pi * li, ni = pr * li + pi * lr; pr = nr; pi = ni; } }
}

__device__ __forceinline__ void modulate_row(int lane, const float* xrow, float* xres, bf16_t* hrow, unsigned char* h8row, const float* sh, const float* sc) {
#pragma unroll
    for (int j = 0; j < 8; ++j) { const int c = 4 * lane + 256 * j; const f32x4 v = *(const f32x4*)(xrow + c), a = *(const f32x4*)(sc + c), b = *(const f32x4*)(sh + c);
        if (xres) *(f32x4*)(xres + c) = v;
        const f32x4 y = v * (a + 1.f) + b; u32x2 w; w.x = cvt_pk_bf16(y[0], y[1]); w.y = cvt_pk_bf16(y[2], y[3]); *(u32x2*)(hrow + c) = w;
        *(unsigned*)(h8row + c) = pk4_fp8(y[0], y[1], y[2], y[3]); }
}
__device__ __forceinline__ void ln_finish(int lane, f32x4 (&v)[8], float* xrow, bf16_t* hrow, const float* g, const float* b, const float* sh, const float* sc, unsigned char* h8row = nullptr, float* stats = nullptr) {
    float s = 0.f;
#pragma unroll
    for (int j = 0; j < 8; ++j) s += (v[j][0] + v[j][1]) + (v[j][2] + v[j][3]);
    const float mean = wave_sum(s) * (1.f / DM); float s2 = 0.f;
#pragma unroll
    for (int j = 0; j < 8; ++j) { v[j] = v[j] - mean; s2 += (v[j][0] * v[j][0] + v[j][1] * v[j][1]) + (v[j][2] * v[j][2] + v[j][3] * v[j][3]); }
    const float rstd = 1.f / sqrtf(wave_sum(s2) * (1.f / DM) + 1e-6f);
    if (stats && lane == 0) { f32x2 st = {mean, rstd}; *(f32x2*)stats = st; }
#pragma unroll
    for (int j = 0; j < 8; ++j) { const int c = 4 * lane + 256 * j; const f32x4 y = v[j] * rstd * *(const f32x4*)(g + c) + *(const f32x4*)(b + c);
        if (xrow) *(f32x4*)(xrow + c) = y;
        if (hrow) { const f32x4 z = y * (*(const f32x4*)(sc + c) + 1.f) + *(const f32x4*)(sh + c); u32x2 w; w.x = cvt_pk_bf16(z[0], z[1]); w.y = cvt_pk_bf16(z[2], z[3]); *(u32x2*)(hrow + c) = w;
            if (h8row) *(unsigned*)(h8row + c) = pk4_fp8(z[0], z[1], z[2], z[3]); } }
}
__device__ __forceinline__ void ln_row(int lane, const float* trow, float* xrow, bf16_t* hrow, const float* g, const float* b, const float* sh, const float* sc, unsigned char* h8row = nullptr, float* stats = nullptr) {
    f32x4 v[8];
#pragma unroll
    for (int j = 0; j < 8; ++j) v[j] = *(const f32x4*)(trow + 4 * lane + 256 * j);
    ln_finish(lane, v, xrow, hrow, g, b, sh, sc, h8row, stats);
}
__device__ __forceinline__ void ln_ctx_row(Frame& F, int r, const float* slab, int nslab, const float* gvec, const float* g, const float* b, const float* sh, const float* sc, bool h8) {
    const int lane = F.lane; LAS float* xb = (LAS float*)F.lds;
    f32x4 a[8];
#pragma unroll
    for (int j = 0; j < 8; ++j) a[j] = (f32x4){0.f, 0.f, 0.f, 0.f};
    for (int q = F.wave; q < nslab; q += NWAVES) { const float* sp = slab + ((size_t)q * NCTX + r) * DM + 4 * lane;
#pragma unroll
        for (int j = 0; j < 8; ++j) a[j] += *(const f32x4*)(sp + 256 * j); }
#pragma unroll
    for (int j = 0; j < 8; ++j) *(LAS f32x4*)(xb + F.wave * DM + 4 * lane + 256 * j) = a[j];
    __syncthreads();
    if (F.wave == 0) {
        float* xrow = (float*)(F.ws + WS_XRES) + (size_t)(NLAT + r) * DM; f32x4 v[8];
#pragma unroll
        for (int j = 0; j < 8; ++j) { const int c = 4 * lane + 256 * j; f32x4 t = *(const LAS f32x4*)(xb + c);
#pragma unroll
            for (int w = 1; w < NWAVES; ++w) t += *(const LAS f32x4*)(xb + w * DM + c);
            v[j] = *(const f32x4*)(xrow + c) * DN_ALPHA + *(const f32x4*)(gvec + c) * t; }
        ln_finish(lane, v, xrow, (bf16_t*)(F.ws + WS_H) + (size_t)(NLAT + r) * DM, g, b, sh, sc, h8 ? (unsigned char*)(F.ws + WS_H8) + (size_t)(NLAT + r) * DM : (unsigned char*)nullptr);
    }
    __syncthreads();
}

__device__ __forceinline__ void prep_row(Frame& F, int l, int t) {
    bf16_t* z = (bf16_t*)(F.ws + WS_Z) + (size_t)t * NIN;
    const bool lat = t < NLAT; const int prow = t >> 6, pcol = t & 63, lane = F.lane;
    const f32x2* RD = (const f32x2*)(F.ws + WS_ROPE_DA); const f32x2* RG = (const f32x2*)(F.ws + WS_ROPE_GQ);
    {
#pragma unroll
        for (int rep = 0; rep < 2; ++rep) { const int task = lane + 64 * rep, b = task >> 1, a = task & 1;
            const bf16_t* p = z + b * 32 + 8 * a; const int pos = (b & 1) ? pcol : prow;
            float x1[8], x2[8]; unpack8(*(const u32x4*)p, x1); unpack8(*(const u32x4*)(p + 16), x2);
            float o1[8], o2[8];
            if (lat) { const f32x2* cs = RD + pos * 16 + 8 * a;
#pragma unroll
                for (int j = 0; j < 8; ++j) { const f32x2 q = cs[j]; o1[j] = x1[j] * q[0] - x2[j] * q[1]; o2[j] = x2[j] * q[0] + x1[j] * q[1]; } }
            else {
#pragma unroll
                for (int j = 0; j < 8; ++j) { o1[j] = x1[j]; o2[j] = x2[j]; } }
            if (b < 32) {
#pragma unroll
                for (int j = 0; j < 8; ++j) { o1[j] *= 0.125f * 1.4426950408889634f * 8.f; o2[j] *= 0.125f * 1.4426950408889634f * 8.f; } }
            unsigned char* d8 = (unsigned char*)(F.ws + WS_QKA8) + (size_t)t * 2048 + b * 32 + 8 * a;
            u32x2 w1, w2; w1.x = pk4_fp8(o1[0], o1[1], o1[2], o1[3]); w1.y = pk4_fp8(o1[4], o1[5], o1[6], o1[7]); w2.x = pk4_fp8(o2[0], o2[1], o2[2], o2[3]); w2.y = pk4_fp8(o2[4], o2[5], o2[6], o2[7]);
            *(u32x2*)d8 = w1; *(u32x2*)(d8 + 16) = w2; }
    }
#pragma unroll
    for (int pass = 0; pass < 2; ++pass) {
        const int seg = lane >> 3, sub = lane & 7, axis = sub >> 2, a = sub & 3;
        const bool active = pass == 0 || seg < 2;
        bf16_t* p = z + (pass == 0 ? C_QB : C_KB) + (active ? seg : 0) * 128 + axis * 64 + 8 * a;
        const float* nw = F.in[pass == 0 ? I_QNORM : I_KNORM] + l * 128 + axis * 64 + 8 * a;
        float x1[8], x2[8]; unpack8(*(const u32x4*)p, x1); unpack8(*(const u32x4*)(p + 32), x2);
        float ss = 0.f;
#pragma unroll
        for (int j = 0; j < 8; ++j) ss += x1[j] * x1[j] + x2[j] * x2[j];
        ss += __shfl_xor(ss, 1); ss += __shfl_xor(ss, 2); ss += __shfl_xor(ss, 4);
        const float r = 1.f / sqrtf(ss * (1.f / 128.f) + 1e-6f);
        float o1[8], o2[8];
#pragma unroll
        for (int j = 0; j < 8; ++j) { x1[j] = x1[j] * r * nw[j]; x2[j] = x2[j] * r * nw[32 + j]; }
        if (lat) { const int pos = axis ? pcol : prow; const f32x2* cs = RG + pos * 32 + 8 * a;
#pragma unroll
            for (int j = 0; j < 8; ++j) { const f32x2 q = cs[j]; o1[j] = x1[j] * q[0] - x2[j] * q[1]; o2[j] = x2[j] * q[0] + x1[j] * q[1]; } }
        else {
#pragma unroll
            for (int j = 0; j < 8; ++j) { o1[j] = x1[j]; o2[j] = x2[j]; } }
        if (pass == 0) {
#pragma unroll
            for (int j = 0; j < 8; ++j) { o1[j] *= 0.088388347648318440f * 1.4426950408889634f * 8.f; o2[j] *= 0.088388347648318440f * 1.4426950408889634f * 8.f; } }
        if (active) { unsigned char* d8 = (pass == 0 ? (unsigned char*)(F.ws + WS_QB8) + (size_t)t * 1024 : (unsigned char*)(F.ws + WS_KB8) + (size_t)t * 256) + seg * 128 + axis * 64 + 8 * a;
            u32x2 w1, w2; w1.x = pk4_fp8(o1[0], o1[1], o1[2], o1[3]); w1.y = pk4_fp8(o1[4], o1[5], o1[6], o1[7]); w2.x = pk4_fp8(o2[0], o2[1], o2[2], o2[3]); w2.y = pk4_fp8(o2[4], o2[5], o2[6], o2[7]);
            *(u32x2*)d8 = w1; *(u32x2*)(d8 + 32) = w2; }
    }
}

__device__ __forceinline__ void vt8_task(Frame& F, int task, LAS unsigned char* scr) {
    const int dvq = task & 3, tile = (task >> 2) % 132, hh = task / (4 * 132), lane = F.lane; const bool da = hh >= 2; const int kvh = da ? hh - 2 : hh;
    const bf16_t* p = (const bf16_t*)(F.ws + WS_Z) + (size_t)(tile * 64 + lane) * NIN + (da ? C_VA : C_VB) + kvh * 128 + dvq * 32;
    const int kk = lane & 31, slot = ((kk >> 2) & 1) * 32 + (lane >> 5) * 16 + (kk & 3) + 4 * (kk >> 3);
#pragma unroll
    for (int q = 0; q < 4; ++q) { float x[8]; unpack8(*(const u32x4*)(p + 8 * q), x);
        const unsigned w0 = pk4_fp8(x[0], x[1], x[2], x[3]), w1 = pk4_fp8(x[4], x[5], x[6], x[7]);
#pragma unroll
        for (int j = 0; j < 4; ++j) { scr[(8 * q + j) * 80 + slot] = (unsigned char)(w0 >> (8 * j)); scr[(8 * q + 4 + j) * 80 + slot] = (unsigned char)(w1 >> (8 * j)); } }
    LDS_WAIT(); asm volatile("" ::: "memory");
    unsigned char* dst = (unsigned char*)(F.ws + (da ? WS_VA8T : WS_VB8T)) + ((size_t)(kvh * 132 + tile) * 128 + dvq * 32) * 64;
#pragma unroll
    for (int rep = 0; rep < 2; ++rep) { const int piece = lane + 64 * rep, row = piece >> 2, part = piece & 3;
        *(u32x4*)(dst + row * 64 + part * 16) = *(const LAS u32x4*)(scr + row * 80 + part * 16); }
    LDS_WAIT(); asm volatile("" ::: "memory");
}

__device__ __forceinline__ void da_combine_row(Frame& F, int l, int t, float lam, float one_m_li) {
    const int lane = F.lane, h = lane >> 3, d0 = (lane & 7) * 16;
    const bf16_t* o1p = (const bf16_t*)(F.ws + WS_ODA) + (size_t)t * DM + (2 * h) * 128 + d0; const bf16_t* o2p = o1p + 128;
    const float* w = F.in[I_SUBLN] + l * 128 + d0;
    float a[16], b[16]; unpack8(*(const u32x4*)o1p, *(float(*)[8])a); unpack8(*(const u32x4*)(o1p + 8), *(float(*)[8])(a + 8));
    unpack8(*(const u32x4*)o2p, *(float(*)[8])b); unpack8(*(const u32x4*)(o2p + 8), *(float(*)[8])(b + 8));
    float ss = 0.f;
#pragma unroll
    for (int j = 0; j < 16; ++j) { a[j] = a[j] - lam * b[j]; ss += a[j] * a[j]; }
    ss += __shfl_xor(ss, 1); ss += __shfl_xor(ss, 2); ss += __shfl_xor(ss, 4);
    const float r = one_m_li / sqrtf(ss * (1.f / 128.f) + 1e-5f);
#pragma unroll
    for (int j = 0; j < 16; ++j) a[j] = a[j] * r * w[j];
    bf16_t* out = (bf16_t*)(F.ws + WS_APB) + (size_t)t * 1024 + h * 128 + d0;
    *(u32x4*)out = pack8(*(float(*)[8])a); *(u32x4*)(out + 8) = pack8(*(float(*)[8])(a + 8));
}


__device__ __forceinline__ void s5_ktab_item(Frame& F, int idx) {
    const int hp = idx & 15, h = (idx >> 4) & 15, dir = (idx >> 8) & 1, g = (idx >> 9) & 63, l = idx >> 15;
    const int gi = (l * 2 + dir) * 64 + g;
    const float* cre = F.in[I_CRE] + ((size_t)gi * 16 + h) * 64; const float* cim = F.in[I_CIM] + ((size_t)gi * 16 + h) * 64;
    const f32x2* L1 = (const f32x2*)(F.ws + WS_POW) + ((size_t)gi * 17 + 1) * 64; const f32x2* BBF = (const f32x2*)(F.ws + WS_BBF) + (size_t)gi * 64 * 16 + hp;
    float acc[16];
#pragma unroll
    for (int k = 0; k < 16; ++k) acc[k] = 0.f;
#pragma unroll 4
    for (int p = 0; p < 64; ++p) { const float cr = cre[p], ci = cim[p]; const f32x2 L = L1[p], B = BBF[p * 16];
        float wr = cr * B[0] - ci * B[1], wi = cr * B[1] + ci * B[0];
#pragma unroll
        for (int k = 0; k < 16; ++k) { acc[k] += wr; const float nr = wr * L[0] - wi * L[1], ni = wr * L[1] + wi * L[0]; wr = nr; wi = ni; } }
    float* KT = (float*)(F.ws + WS_KTAB) + (size_t)((l * 64 + g) * 2 + dir) * 16 * 256 + h * 16 + hp;
#pragma unroll
    for (int k = 0; k < 16; ++k) KT[k * 256] = acc[k];
}
template <int NB>
__device__ __forceinline__ void s5_etab_items(Frame& F, int idx0, int stride, int nitems) {
    f32x2 L[NB], B[NB][8]; int im_[NB]; size_t dst[NB]; bool ok[NB];
#pragma unroll
    for (int b = 0; b < NB; ++b) { const int idx = idx0 + b * stride; ok[b] = idx < nitems; const int id = ok[b] ? idx : 0;
        const int k0 = (id & 31) * 8, n = (id >> 5) & 255, g = (id >> 13) & 63, l = id >> 19;
        const int dir = n >> 7, p = n & 63, tt = k0 >> 4, h0 = k0 & 15, e = dir == 0 ? 15 - tt : tt, gi = (l * 2 + dir) * 64 + g; im_[b] = (n >> 6) & 1;
        L[b] = ((const f32x2*)(F.ws + WS_POW))[((size_t)gi * 17 + e) * 64 + p]; const f32x2* BBF = (const f32x2*)(F.ws + WS_BBF) + ((size_t)gi * 64 + p) * 16 + h0;
#pragma unroll
        for (int j = 0; j < 8; ++j) B[b][j] = BBF[j];
        dst[b] = ((size_t)(l * 64 + g) * 256 + n) * 256 + k0; }
#pragma unroll
    for (int b = 0; b < NB; ++b) { float o[8];
#pragma unroll
        for (int j = 0; j < 8; ++j) o[j] = im_[b] ? L[b][0] * B[b][j][1] + L[b][1] * B[b][j][0] : L[b][0] * B[b][j][0] - L[b][1] * B[b][j][1];
        if (ok[b]) *(u32x4*)((bf16_t*)(F.ws + WS_ETAB) + dst[b]) = pack8(o); }
}
template <int NB>
__device__ __forceinline__ void s5_gtab_items(Frame& F, int idx0, int stride, int nitems) {
    f32x2 L[NB][8]; float cr[NB][8], ci[NB][8]; int im_[NB]; size_t dst[NB]; bool ok[NB];
#pragma unroll
    for (int b = 0; b < NB; ++b) { const int idx = idx0 + b * stride; ok[b] = idx < nitems; const int id = ok[b] ? idx : 0;
        const int k8 = id & 31, n = (id >> 5) & 255, g = (id >> 13) & 63, l = id >> 19;
        const int dir = k8 >> 4, comp0 = (k8 & 15) * 8, p0 = comp0 & 63, tt = n >> 4, h = n & 15, e = dir == 0 ? tt + 1 : 16 - tt, gi = (l * 2 + dir) * 64 + g; im_[b] = comp0 >> 6;
        const f32x2* POW = (const f32x2*)(F.ws + WS_POW) + ((size_t)gi * 17 + e) * 64 + p0;
        const float* cre = F.in[I_CRE] + ((size_t)gi * 16 + h) * 64 + p0; const float* cim = F.in[I_CIM] + ((size_t)gi * 16 + h) * 64 + p0;
#pragma unroll
        for (int j = 0; j < 8; ++j) { L[b][j] = POW[j]; cr[b][j] = cre[j]; ci[b][j] = cim[j]; }
        dst[b] = ((size_t)(l * 64 + g) * 256 + n) * 512 + 256 + 8 * k8; }
#pragma unroll
    for (int b = 0; b < NB; ++b) { float o[8];
#pragma unroll
        for (int j = 0; j < 8; ++j) o[j] = im_[b] ? -(cr[b][j] * L[b][j][1] + ci[b][j] * L[b][j][0]) : cr[b][j] * L[b][j][0] - ci[b][j] * L[b][j][1];
        if (ok[b]) *(u32x4*)((bf16_t*)(F.ws + WS_BTAB) + dst[b]) = pack8(o); }
}
template <int NB>
__device__ __forceinline__ void s5_ttab_items(Frame& F, int idx0, int stride, int nitems) {
    float o[NB][8]; size_t dst[NB]; bool ok[NB];
#pragma unroll
    for (int b = 0; b < NB; ++b) { const int idx = idx0 + b * stride; ok[b] = idx < nitems; const int id = ok[b] ? idx : 0;
        const int k0 = (id & 31) * 8, n = (id >> 5) & 255, g = (id >> 13) & 63, l = id >> 19;
        const int tp = k0 >> 4, hp0 = k0 & 15, tt = n >> 4, h = n & 15;
        const float* KT = (const float*)(F.ws + WS_KTAB) + (size_t)(l * 64 + g) * 2 * 16 * 256;
        const bool f = tp <= tt, r = tp >= tt;
        const float* kf = KT + (size_t)(f ? tt - tp : 0) * 256 + h * 16 + hp0; const float* kr = KT + (size_t)(16 + (r ? tp - tt : 0)) * 256 + h * 16 + hp0;
        const float dsk = F.in[I_S5D][l * 1024 + g * 16 + h];
#pragma unroll
        for (int j = 0; j < 8; ++j) o[b][j] = (f ? kf[j] : 0.f) + (r ? kr[j] : 0.f);
        if (tp == tt && (h >> 3) == (hp0 >> 3)) o[b][h & 7] += dsk;
        dst[b] = ((size_t)(l * 64 + g) * 256 + n) * 512 + k0; }
#pragma unroll
    for (int b = 0; b < NB; ++b) if (ok[b]) *(u32x4*)((bf16_t*)(F.ws + WS_BTAB) + dst[b]) = pack8(o[b]);
}
template <int PASS>
__device__ __forceinline__ void s5_scan_task(Frame& F, int l, int task) {
    const int run = task % 33, gd = task / 33, dir = gd & 1, g = gd >> 1, p = F.lane, gi = (l * 2 + dir) * 64 + g;
    const f32x2 L16 = ((const f32x2*)(F.ws + WS_POW))[((size_t)gi * 17 + 16) * 64 + p];
    const float* S = (const float*)(F.ws + WS_S) + (size_t)g * 768 * 256 + dir * 128 + p;
    f32x2* GF = (f32x2*)(F.ws + WS_F) + ((size_t)gd * 33) * 64 + p;
    float sr[16], si[16];
#pragma unroll
    for (int q = 0; q < 16; ++q) { const int s_ = run * 16 + q, c = dir == 0 ? (s_ < 16 ? 512 + s_ : s_ - 16) : 527 - s_; sr[q] = S[(size_t)c * 256]; si[q] = S[(size_t)c * 256 + 64]; }
    float xr = 0.f, xi = 0.f;
    if (PASS == 2) {
        float ar = L16[0], ai = L16[1];
#pragma unroll
        for (int q = 0; q < 4; ++q) { const float nr = ar * ar - ai * ai, ni = 2.f * ar * ai; ar = nr; ai = ni; }
        for (int r = 0; r < run; ++r) { const f32x2 f = GF[(size_t)r * 64]; const float nr = ar * xr - ai * xi + f[0], ni = ar * xi + ai * xr + f[1]; xr = nr; xi = ni; }
    }
    bf16_t* X = (bf16_t*)(F.ws + WS_AP) + (size_t)g * 768 * 512 + 256 + dir * 128 + p;
#pragma unroll
    for (int q = 0; q < 16; ++q) { const int s_ = run * 16 + q, c = dir == 0 ? (s_ < 16 ? 512 + s_ : s_ - 16) : 527 - s_;
        if (PASS == 2) { X[(size_t)c * 512] = (bf16_t)f2bf(xr); X[(size_t)c * 512 + 64] = (bf16_t)f2bf(xi); }
        const float nr = L16[0] * xr - L16[1] * xi + sr[q], ni = L16[0] * xi + L16[1] * xr + si[q]; xr = nr; xi = ni; }
    if (PASS == 1) GF[(size_t)run * 64] = (f32x2){xr, xi};
}

__global__ void __launch_bounds__(NTHR, 2) hyb_fwd(Args args) {
    extern __shared__ __attribute__((aligned(16))) unsigned char lds_raw[];
    Frame F;
    F.lds = (LAS unsigned char*)lds_raw;
    F.tid = threadIdx.x; F.lane = F.tid & 63; F.wave = __builtin_amdgcn_readfirstlane(F.tid >> 6);
    F.G = gridDim.x; { const int bx = blockIdx.x; F.vcu = (F.G % 8 == 0) ? (bx % 8) * (F.G / 8) + bx / 8 : bx; }
    F.gw = F.vcu * NWAVES + F.wave; F.NGW = F.G * NWAVES;
    F.out = (GAS float*)args.out; F.ws = (GAS unsigned char*)args.ws;
    volatile LAS unsigned* MISC = (volatile LAS unsigned*)(F.lds + MISC_OFF);
    for (int u = F.tid; u < (LDS_BYTES - RING_BYTES) / 4; u += NTHR) ((LAS unsigned*)(F.lds + RING_BYTES))[u] = 0u;
    __syncthreads();
    unsigned* ctl = (unsigned*)(F.ws + WS_CTL);
    XcdBarrier bar = xcd_barrier_post(ctl + CW_BAR, MISC + 8);
#define GRID_BAR() do { asm volatile("" : "+s"(bar.bar), "+s"(bar.x)); xcd_barrier(bar); F.tid = opaque_tid(); F.lane = F.tid & 63; asm volatile("" : "+s"(F.ws)); } while (0)
    LAS float* wscr = (LAS float*)(F.lds + F.wave * 16384);

    {
        for (int it = F.gw; it < NL * MOD_SLABS * 48; it += F.NGW) mod_item(F, it);
        for (int it = F.gw * 64 + F.lane; it < NL * 2 * 64 * 64; it += F.NGW * 64) s5_param_item(F, it);
        for (int it = F.gw * 64 + F.lane; it < 128 * 16 + 128 * 32; it += F.NGW * 64) {
            const bool da = it < 128 * 16; const int r = da ? it : it - 128 * 16, nf = da ? 16 : 32, pos = r / nf, i = r % nf;
            const float invf = (float)dexp(-(double)(2 * i) / (double)(2 * nf) * 9.210340371976184);
            const float ang = (float)pos * invf; double s, c; dsincos((double)ang, s, c);
            ((f32x2*)(F.ws + (da ? WS_ROPE_DA : WS_ROPE_GQ)))[r] = (f32x2){(float)c, (float)s};
        }
        if (F.gw < NL) { const int l = F.gw;
            const float a = wave_sum(F.in[I_LQ1][l * 64 + F.lane] * F.in[I_LK1][l * 64 + F.lane]), b = wave_sum(F.in[I_LQ2][l * 64 + F.lane] * F.in[I_LK2][l * 64 + F.lane]);
            const float lam_init = 0.8f - 0.6f * (float)dexp(-0.3 * (double)l);
            if (F.lane == 0) ((float*)(F.ws + WS_LAMV))[l] = (float)(dexp((double)a) - dexp((double)b)) + lam_init; }
    }
    GRID_BAR();
    for (int it = F.gw * 64 + F.lane; it < NL * 2 * 12288; it += F.NGW * 64) { const int j = it % 12288, ls = it / 12288, l = ls >> 1;
        float s = F.in[I_BADA][l * 12288 + j]; const float* P = (const float*)(F.ws + WS_MODP) + (size_t)ls * 12288 + j;
        for (int sl = 0; sl < MOD_SLABS; ++sl) s += P[(size_t)sl * NL * 2 * 12288];
        ((float*)(F.ws + WS_MOD))[it] = s; }
#pragma nounroll
    for (int pass_ = 0; pass_ < 2; ++pass_) {
        if ((pass_ == 0) == ((F.wave & 1) != 0)) {
            for (int it = F.gw * 64 + F.lane; it < NL * 64 * 2 * 256; it += F.NGW * 64) s5_ktab_item(F, it);
            for (int it = F.gw * 64 + F.lane; it < NL * 64 * 256 * 32; it += 4 * F.NGW * 64) { s5_etab_items<4>(F, it, F.NGW * 64, NL * 64 * 256 * 32); s5_gtab_items<4>(F, it, F.NGW * 64, NL * 64 * 256 * 32); }
        } else {
            for (int it = F.gw; it < NL * IT_LAYER; it += F.NGW) convert_item(F, it, wscr);
        }
    }
    GRID_BAR();
    for (int c = F.gw * 64 + F.lane; c < 2 * DM; c += F.NGW * 64) ((float*)(F.ws + WS_IDAFF))[c] = c < DM ? 1.f : 0.f;
#pragma nounroll
    for (int pass_ = 0; pass_ < 2; ++pass_) {
        if ((pass_ == 0) == ((F.wave & 1) != 0)) {
            for (int it = F.gw * 64 + F.lane; it < NL * 64 * 256 * 32; it += 4 * F.NGW * 64) s5_ttab_items<4>(F, it, F.NGW * 64, NL * 64 * 256 * 32);
        } else {
        for (int t = F.gw; t < NT; t += F.NGW) { const bool lat = t < NLAT; const float* md = (const float*)(F.ws + WS_MOD) + (lat ? 0 : 12288);
            const float* xr = lat ? F.in[I_X] + (size_t)t * DM : F.in[I_CTX] + (size_t)(t - NLAT) * DM;
            modulate_row(F.lane, xr, (lat ? (float*)(F.ws + WS_T) : (float*)(F.ws + WS_XRES)) + (size_t)t * DM, (bf16_t*)(F.ws + WS_H) + (size_t)t * DM, (unsigned char*)(F.ws + WS_H8) + (size_t)t * DM, md, md + DM);
            if (lat && F.lane == 0) { f32x2 st = {0.f, 1.f}; *(f32x2*)((float*)(F.ws + WS_STATS) + 2 * t) = st; } }
        }
    }
    GRID_BAR();

    for (int l = 0; l < NL; ++l) {
        GAS unsigned char* wl = F.ws + WS_W + (size_t)l * W_LAYER;
        const bool last = (l == NL - 1);
        const int Mrows = last ? NLAT : NT;
        const float* modl = (const float*)(F.ws + WS_MOD) + (size_t)l * 2 * 12288;
        { int k8_ = DM / 2; asm volatile("" : "+s"(k8_));
          pg8::Gemm g{(const bf16_t*)(F.ws + WS_H8), (const bf16_t*)(wl + W_IN8), NT, 9728, k8_, DM / 2, DM / 2}; pg8::WinOrder S; S.init(NT, 9728, F.G, (int)blockIdx.x);
          pg8::EpiIn E{(bf16_t*)(F.ws + WS_Z), (bf16_t*)(F.ws + WS_AP), 1, 1.f / 64.f};
          pg8::gemm_phase<pg8::EpiIn, pg8::WinOrder, true, true, true>(F.lds, g, S, E); }
        { pg8::Gemm g{(const bf16_t*)(F.ws + WS_H), (const bf16_t*)(wl + W_IN), NT, 2048, DM}; pg8::StaticOrder S; S.init(NT, 2048, F.G, ((int)blockIdx.x + 16) % F.G);
          pg8::EpiIn E{(bf16_t*)(F.ws + WS_Z), (bf16_t*)(F.ws + WS_AP), 0, 1.f};
          pg8::gemm_phase<pg8::EpiIn, pg8::StaticOrder, true, true, false>(F.lds, g, S, E); }
        GRID_BAR();
        for (int t = F.gw; t < NT; t += F.NGW) prep_row(F, l, t);
        for (int t = F.gw; t < 10 * 132 * 4; t += F.NGW) vt8_task(F, t, F.lds + F.wave * 16384);
        { __syncthreads(); int ks_ = 256; asm volatile("" : "+s"(ks_));
          pg8::Gemm g{(const bf16_t*)(F.ws + WS_AP), (const bf16_t*)(F.ws + WS_ETAB) + (size_t)l * 64 * 256 * 256, 64 * 768, 64 * 256, ks_, 512, 256}; pg8::S5Order S; S.init(3, F.G, (int)blockIdx.x);
          pg8::EpiS E{(float*)(F.ws + WS_S)};
          pg8::gemm_phase<pg8::EpiS, pg8::S5Order, true, true>(F.lds, g, S, E); }
        GRID_BAR();
        for (int t = F.gw; t < 128 * 33; t += F.NGW) s5_scan_task<1>(F, l, t);
        {
            const bf16_t* Z = (const bf16_t*)(F.ws + WS_Z);
#define GQ_UNIT(FAST_) att::attn_dense_body<true, FAST_>((const bf16_t*)((const unsigned char*)(F.ws + WS_QB8) + qrow * 1024 + h * 128), (const bf16_t*)((const unsigned char*)(F.ws + WS_KB8) + krow * 256 + (h >> 2) * 128), \
                (const bf16_t*)((const unsigned char*)(F.ws + WS_VB8T) + ((size_t)(h >> 2) * 132 + (krow >> 6)) * 8192), (bf16_t*)(F.ws + WS_APB) + ((size_t)NT + qrow) * 1024 + h * 128, 1024, seq, 0, 1.f, 8.f, (char*)lds_raw)
#define DA_UNIT(FAST_) att::attn_dense_body<false, FAST_>((const bf16_t*)((const unsigned char*)(F.ws + WS_QKA8) + qrow * 2048 + hs * 64), (const bf16_t*)((const unsigned char*)(F.ws + WS_QKA8) + krow * 2048 + 1024 + hs * 64), \
                (const bf16_t*)((const unsigned char*)(F.ws + WS_VA8T) + ((size_t)(hs >> 1) * 132 + (krow >> 6)) * 8192), (bf16_t*)(F.ws + WS_ODA) + qrow * DM + hs * 128, DM, seq, 0, 1.f, 8.f, (char*)lds_raw)
            unsigned redo = 0u, bit = 1u;
            for (int u = (int)blockIdx.x; u < 256 + (last ? 0 : 24); u += F.G, bit <<= 1) { if (u >= 256 && u < 272) continue;
                const bool cx = u >= 256; const int h = cx ? u - 272 : u >> 5, seq = cx ? NCTX : NT; const size_t qrow = cx ? (size_t)NLAT : (size_t)(u & 31) * 256, krow = cx ? (size_t)NLAT : 0;
                if (GQ_UNIT(true)) redo |= bit;
                __syncthreads();
            }
            bit = 1u << 8;
            for (int u = (int)blockIdx.x; u < 512 + (last ? 0 : 16); u += F.G, bit <<= 1) {
                const bool cx = u >= 512; const int hs = cx ? u - 512 : u >> 5, seq = cx ? NCTX : NT; const size_t qrow = cx ? (size_t)NLAT : (size_t)(u & 31) * 256, krow = cx ? (size_t)NLAT : 0;
                if (DA_UNIT(true)) redo |= bit;
                __syncthreads();
            }
            if (redo & 0xffu) { bit = 1u;
                for (int u = (int)blockIdx.x; u < 256 + (last ? 0 : 24); u += F.G, bit <<= 1) { if (!(redo & bit)) continue;
                    const bool cx = u >= 256; const int h = cx ? u - 272 : u >> 5, seq = cx ? NCTX : NT; const size_t qrow = cx ? (size_t)NLAT : (size_t)(u & 31) * 256, krow = cx ? (size_t)NLAT : 0;
                    GQ_UNIT(false); __syncthreads(); } }
            if (redo >> 8) { bit = 1u << 8;
                for (int u = (int)blockIdx.x; u < 512 + (last ? 0 : 16); u += F.G, bit <<= 1) { if (!(redo & bit)) continue;
                    const bool cx = u >= 512; const int hs = cx ? u - 512 : u >> 5, seq = cx ? NCTX : NT; const size_t qrow = cx ? (size_t)NLAT : (size_t)(u & 31) * 256, krow = cx ? (size_t)NLAT : 0;
                    DA_UNIT(false); __syncthreads(); } }
#undef GQ_UNIT
#undef DA_UNIT
        }
        GRID_BAR();
        { const float lam = ((const float*)(F.ws + WS_LAMV))[l]; const float lam_init = 0.8f - 0.6f * __expf(-0.3f * (float)l);
          for (int t = F.gw; t < 128 * 33; t += F.NGW) s5_scan_task<2>(F, l, t);
          for (int t = F.gw; t < Mrows; t += F.NGW) da_combine_row(F, l, t, lam, 1.f - lam_init); }
        GRID_BAR();
        {
          int ky_ = 512; asm volatile("" : "+s"(ky_));
          pg8::Gemm g{(const bf16_t*)(F.ws + WS_AP), (const bf16_t*)(F.ws + WS_BTAB) + (size_t)l * 64 * 256 * 512, 64 * 768, 64 * 256, ky_, 512, 512}; pg8::S5Order S; S.init(last ? 2 : 3, F.G, (int)blockIdx.x);
          pg8::EpiY E{(bf16_t*)(F.ws + WS_AGLU), last ? 512 : 528};
          pg8::gemm_phase<pg8::EpiY, pg8::S5Order, true, true>(F.lds, g, S, E); }
        GRID_BAR();
        { pg8::Gemm g{(const bf16_t*)(F.ws + WS_APB), (const bf16_t*)(wl + W_PAB), 2 * NT, 4096, 1024}; pg8::PairOrder S; S.init(Mrows / 256, F.G, (int)blockIdx.x);
          pg8::EpiGate E{(const bf16_t*)(F.ws + WS_Z), (bf16_t*)(F.ws + WS_PG)};
          pg8::gemm_phase<pg8::EpiGate, pg8::PairOrder, true, true>(F.lds, g, S, E); }
        GRID_BAR();
        { pg8::Gemm g{(const bf16_t*)(F.ws + WS_AGLU), (const bf16_t*)(wl + W_GLU), Mrows, 4096, 1024}; pg8::StaticOrder S; S.init(Mrows, 4096, F.G, (int)blockIdx.x);
          pg8::EpiGlu E{(const bf16_t*)(F.ws + WS_Z), (const bf16_t*)(F.ws + WS_PG), (bf16_t*)(F.ws + WS_MRG)};
          pg8::gemm_phase<pg8::EpiGlu, pg8::StaticOrder, true, true>(F.lds, g, S, E); }
        GRID_BAR();
        { pg8::Gemm g{(const bf16_t*)(F.ws + WS_MRG), (const bf16_t*)(wl + W_O), Mrows, DM, DM}; pg8::ResSplitOrder S; S.init(DM, F.G, (int)blockIdx.x, !last, SPLIT_O, (DM / 64) / SPLIT_O);
          const float* pg_ = l == 0 ? (const float*)(F.ws + WS_IDAFF) : F.in[I_LNFG] + (l - 1) * DM; const float* pb_ = l == 0 ? (const float*)(F.ws + WS_IDAFF) + DM : F.in[I_LNFB] + (l - 1) * DM;
          pg8::EpiRes E{(const float*)(F.ws + WS_STATS), pg_, pb_, (float*)(F.ws + WS_T), modl + 2 * DM, modl + 12288 + 2 * DM, (float*)(F.ws + WS_SLAB)};
          pg8::gemm_phase<pg8::EpiRes, pg8::ResSplitOrder, true, true>(F.lds, g, S, E); }
        GRID_BAR();
        {
        for (int t = F.gw; t < NLAT; t += F.NGW)
            ln_row(F.lane, (const float*)(F.ws + WS_T) + (size_t)t * DM, (float*)nullptr, (bf16_t*)(F.ws + WS_H) + (size_t)t * DM,
                   F.in[I_LNMG] + l * DM, F.in[I_LNMB] + l * DM, modl + 3 * DM, modl + 4 * DM, (unsigned char*)nullptr, (float*)(F.ws + WS_STATS) + 2 * t);
        if (!last) for (int r = (int)blockIdx.x; r < NCTX; r += F.G) { const float* md = modl + 12288;
            ln_ctx_row(F, r, (const float*)(F.ws + WS_SLAB), SPLIT_O, md + 2 * DM, F.in[I_LNMG] + l * DM, F.in[I_LNMB] + l * DM, md + 3 * DM, md + 4 * DM, false); }
        }
        GRID_BAR();
        { pg8::Gemm g{(const bf16_t*)(F.ws + WS_H), (const bf16_t*)(wl + W_GU), Mrows, 2 * FF, DM}; pg8::StaticOrder S; S.init(Mrows, 2 * FF, F.G, (int)blockIdx.x);
          pg8::EpiSwi E{(bf16_t*)(F.ws + WS_ACT)};
          pg8::gemm_phase<pg8::EpiSwi, pg8::StaticOrder, true, true>(F.lds, g, S, E); }
        GRID_BAR();
        { pg8::Gemm g{(const bf16_t*)(F.ws + WS_ACT), (const bf16_t*)(wl + W_DN), Mrows, DM, FF}; pg8::ResSplitOrder S; S.init(DM, F.G, (int)blockIdx.x, !last, SPLIT_D, (FF / 64) / SPLIT_D);
          pg8::EpiRes E{(const float*)(F.ws + WS_STATS), F.in[I_LNMG] + l * DM, F.in[I_LNMB] + l * DM, (float*)(F.ws + WS_T), modl + 5 * DM, modl + 12288 + 5 * DM, (float*)(F.ws + WS_SLAB)};
          pg8::gemm_phase<pg8::EpiRes, pg8::ResSplitOrder, true, true>(F.lds, g, S, E); }
        GRID_BAR();
        {
        for (int t = F.gw; t < NLAT; t += F.NGW) { const float* mdn = modl + 2 * 12288;
            float* dst = last ? (float*)(F.out + (size_t)t * DM) : (float*)nullptr;
            ln_row(F.lane, (const float*)(F.ws + WS_T) + (size_t)t * DM, dst, last ? (bf16_t*)nullptr : (bf16_t*)(F.ws + WS_H) + (size_t)t * DM,
                   F.in[I_LNFG] + l * DM, F.in[I_LNFB] + l * DM, mdn, mdn + DM, last ? (unsigned char*)nullptr : (unsigned char*)(F.ws + WS_H8) + (size_t)t * DM, (float*)(F.ws + WS_STATS) + 2 * t); }
        if (!last) for (int r = (int)blockIdx.x; r < NCTX; r += F.G) { const float* mdn = modl + 3 * 12288;
            ln_ctx_row(F, r, (const float*)(F.ws + WS_SLAB), SPLIT_D, modl + 12288 + 5 * DM, F.in[I_LNFG] + l * DM, F.in[I_LNFB] + l * DM, mdn, mdn + DM, true); }
        }
        if (!last) GRID_BAR();
    }
}

extern "C" void kernel_launch(void* const* d_in, const int* in_sizes, int n_in, void* d_out, int out_size, void* d_ws, size_t ws_size, hipStream_t stream) {
    static int grid = 0;
    if (grid == 0) {
        if (n_in != 33 || out_size != NLAT * DM || ws_size < WS_END) { fprintf(stderr, "kernel_launch: built for 33 inputs, out %d, ws >= %zu; got n_in %d out %d ws %zu\n", NLAT * DM, (size_t)WS_END, n_in, out_size, ws_size); grid = -1; return; }
        int dev = 0, cus = 0;
        if (hipGetDevice(&dev) != hipSuccess || hipDeviceGetAttribute(&cus, hipDeviceAttributeMultiprocessorCount, dev) != hipSuccess) { grid = -1; return; }
        if (hipFuncSetAttribute((const void*)hyb_fwd, hipFuncAttributeMaxDynamicSharedMemorySize, LDS_BYTES) != hipSuccess) { fprintf(stderr, "kernel_launch: hipFuncSetAttribute failed\n"); grid = -1; return; }
        int per_cu = 0;
        if (hipOccupancyMaxActiveBlocksPerMultiprocessor(&per_cu, (const void*)hyb_fwd, NTHR, LDS_BYTES) != hipSuccess || per_cu < 1) { fprintf(stderr, "kernel_launch: occupancy query says %d\n", per_cu); }
        (void)hipGetLastError();
        grid = cus;
    }
    if (grid < 0) return;
    (void)hipMemsetAsync((char*)d_ws + WS_CTL, 0, CTL_ZERO_BYTES, stream);
    Args a{};
    for (int i = 0; i < 33; ++i) a.in[i] = (const float*)d_in[i];
    a.out = (float*)d_out; a.ws = (unsigned char*)d_ws;
    hipLaunchKernelGGL(hyb_fwd, dim3(grid), dim3(NTHR), LDS_BYTES, stream, a);
}
```

```cpp
#include <hip/hip_runtime.h>
#include <cstdio>
#include <cstdint>

#define LAS __attribute__((address_space(3)))
#define GAS __attribute__((address_space(1)))
typedef unsigned short bf16_t;
typedef short bf16x8 __attribute__((ext_vector_type(8)));
typedef short s16x4 __attribute__((ext_vector_type(4)));
typedef float f32x4 __attribute__((ext_vector_type(4)));
typedef float f32x2 __attribute__((ext_vector_type(2)));
typedef float f32x16 __attribute__((ext_vector_type(16)));
typedef unsigned u32x4 __attribute__((ext_vector_type(4)));
typedef unsigned u32x2 __attribute__((ext_vector_type(2)));

constexpr int NT = 8448, NLAT = 8192, NCTX = 256, DM = 2048, NIN = 11776, FF = 5632, NL = 4;
constexpr int C_QA = 0, C_KA = 1024, C_VA = 2048, C_QB = 3072, C_KB = 4096, C_VB = 4352, C_U = 4608, C_G = 5632;
constexpr float DN_ALPHA = 1.6817928305074290f;
constexpr int NWAVES = 8, NTHR = 512;
constexpr int MOD_SLABS = 32;

constexpr size_t al256(size_t x) { return (x + 255) & ~(size_t)255; }
constexpr size_t WS_CTL = 0, CTL_ZERO_BYTES = 1u << 20;
constexpr size_t WS_MODP = CTL_ZERO_BYTES;
constexpr size_t WS_MOD = WS_MODP + al256((size_t)MOD_SLABS * NL * 2 * 12288 * 4);
constexpr size_t WS_LAMV = WS_MOD + al256((size_t)NL * 2 * 12288 * 4);
constexpr size_t WS_ROPE_DA = WS_LAMV + 256;
constexpr size_t WS_ROPE_GQ = WS_ROPE_DA + 128 * 16 * 8;
constexpr size_t WS_LAM = WS_ROPE_GQ + 128 * 32 * 8;
constexpr size_t WS_BB = WS_LAM + (size_t)NL * 2 * 64 * 64 * 16;
constexpr size_t WS_CC = WS_BB + (size_t)NL * 2 * 64 * 128 * 16 * 2;
constexpr size_t WS_F = WS_CC + (size_t)NL * 64 * 16 * 256 * 2;
constexpr size_t WS_W = al256(WS_F + (size_t)2 * 66 * 64 * 64 * 8);
__host__ __device__ constexpr bool win_tile_fp8(int pt) { return !((pt >= 8 && pt < 12) || (pt >= 18 && pt < 22)); }
__host__ __device__ constexpr int win_tile_slot(int pt) { return pt < 8 ? pt : pt < 12 ? pt - 8 : pt < 18 ? pt - 4 : pt < 22 ? pt - 14 : pt - 8; }
__host__ __device__ constexpr int win_fp8_tile(int j) { return j < 8 ? j : j < 14 ? j + 4 : j + 8; }
__host__ __device__ constexpr int win_bf16_tile(int j) { return j < 4 ? j + 8 : j + 14; }
constexpr size_t W_IN = 0;
constexpr size_t W_PAB = W_IN + (size_t)2048 * DM * 2;
constexpr size_t W_GLU = W_PAB + (size_t)4096 * 1024 * 2;
constexpr size_t W_O = W_GLU + (size_t)4096 * 1024 * 2;
constexpr size_t W_GU = W_O + (size_t)DM * DM * 2;
constexpr size_t W_DN = W_GU + (size_t)2 * FF * DM * 2;
constexpr size_t W_IN8 = W_DN + (size_t)DM * FF * 2;
constexpr size_t W_LAYER = W_IN8 + (size_t)9728 * DM;
constexpr size_t WS_XRES = al256(WS_W + NL * W_LAYER);
constexpr size_t WS_H = WS_XRES + (size_t)NT * DM * 4;
constexpr size_t WS_Z = WS_H + (size_t)NT * DM * 2;
constexpr size_t WS_ODA = WS_Z + (size_t)NT * NIN * 2;
constexpr size_t WS_APB = WS_ODA + (size_t)NT * DM * 2;
constexpr size_t WS_AGLU = WS_APB + (size_t)2 * NT * 1024 * 2;
constexpr size_t WS_PG = WS_AGLU + (size_t)NT * 1024 * 2;
constexpr size_t WS_MRG = WS_PG + (size_t)2 * NT * DM * 2;
constexpr size_t WS_T = WS_MRG + (size_t)NT * DM * 2;
constexpr size_t WS_ACT = WS_T + (size_t)NT * DM * 4;
constexpr size_t WS_SLAB = WS_ACT + (size_t)NT * FF * 2;
constexpr int SPLIT_O = 16, SPLIT_D = 22;
constexpr size_t WS_POW = WS_SLAB + (size_t)SPLIT_D * NCTX * DM * 4;
constexpr size_t WS_BBF = WS_POW + (size_t)NL * 2 * 64 * 17 * 64 * 8;
constexpr size_t WS_KTAB = WS_BBF + (size_t)NL * 2 * 64 * 64 * 16 * 8;
constexpr size_t WS_ETAB = WS_KTAB + (size_t)NL * 64 * 2 * 16 * 256 * 4;
constexpr size_t WS_BTAB = WS_ETAB + (size_t)NL * 64 * 256 * 256 * 2;
constexpr size_t WS_AP = WS_BTAB + (size_t)NL * 64 * 256 * 512 * 2;
constexpr size_t WS_S = WS_AP + (size_t)64 * 768 * 512 * 2;
constexpr size_t WS_H8 = WS_S + (size_t)64 * 768 * 256 * 4;
constexpr size_t WS_QB8 = WS_H8 + (size_t)NT * DM;
constexpr size_t WS_KB8 = WS_QB8 + (size_t)NT * 1024;
constexpr size_t WS_QKA8 = WS_KB8 + (size_t)NT * 256;
constexpr size_t WS_VB8T = WS_QKA8 + (size_t)NT * 2048;
constexpr size_t WS_VA8T = WS_VB8T + (size_t)2 * 132 * 128 * 64;
constexpr size_t WS_STATS = WS_VA8T + (size_t)8 * 132 * 128 * 64;
constexpr size_t WS_IDAFF = WS_STATS + (size_t)NLAT * 8;
constexpr size_t WS_END = WS_IDAFF + (size_t)2 * DM * 4;

constexpr int CW_TMO = 0, CW_BAR = 4096;

__device__ __forceinline__ unsigned f2bf(float f) { unsigned u = __builtin_bit_cast(unsigned, f); return (u + 0x7fffu + ((u >> 16) & 1u)) >> 16; }
__device__ __forceinline__ unsigned pk2(float lo, float hi) { return f2bf(lo) | (f2bf(hi) << 16); }
typedef float f32x2_ __attribute__((ext_vector_type(2))); typedef __bf16 bf16x2_ __attribute__((ext_vector_type(2)));
__device__ __forceinline__ unsigned cvt_pk_bf16(float lo, float hi) { const f32x2_ v = {lo, hi}; return __builtin_bit_cast(unsigned, __builtin_convertvector(v, bf16x2_)); }
__device__ __forceinline__ float bflo(unsigned w) { return __builtin_bit_cast(float, w << 16); }
__device__ __forceinline__ float bfhi(unsigned w) { return __builtin_bit_cast(float, w & 0xffff0000u); }
__device__ __forceinline__ void unpack8(u32x4 w, float (&f)[8]) { f[0] = bflo(w.x); f[1] = bfhi(w.x); f[2] = bflo(w.y); f[3] = bfhi(w.y); f[4] = bflo(w.z); f[5] = bfhi(w.z); f[6] = bflo(w.w); f[7] = bfhi(w.w); }
__device__ __forceinline__ u32x4 pack8(const float (&f)[8]) { u32x4 w; w.x = cvt_pk_bf16(f[0], f[1]); w.y = cvt_pk_bf16(f[2], f[3]); w.z = cvt_pk_bf16(f[4], f[5]); w.w = cvt_pk_bf16(f[6], f[7]); return w; }
__device__ __forceinline__ unsigned pk4_fp8(float a, float b, float c, float d) { int w = __builtin_amdgcn_cvt_pk_fp8_f32(a, b, 0, false); w = __builtin_amdgcn_cvt_pk_fp8_f32(c, d, w, true); return (unsigned)w; }
__device__ __forceinline__ float sigmoidf_(float x) { return __builtin_amdgcn_rcpf(1.f + __builtin_amdgcn_exp2f(-1.4426950408889634f * x)); }
__device__ __forceinline__ float siluf_(float x) { return x * sigmoidf_(x); }
__device__ __forceinline__ float gelu_tanh(float x) { const float z = 0.7978845608028654f * (x + 0.044715f * x * x * x); return x * sigmoidf_(2.f * z); }
__device__ __forceinline__ float wave_sum(float v) {
#pragma unroll
    for (int o = 1; o < 64; o <<= 1) v += __shfl_xor(v, o);
    return v;
}
__device__ __forceinline__ int opaque_tid() { int t = threadIdx.x; asm volatile("" : "+v"(t)); return t; }
#define LDS_WAIT() asm volatile("s_waitcnt lgkmcnt(0)" ::: "memory")
#define VM_WAIT() asm volatile("s_waitcnt vmcnt(0)" ::: "memory")

__device__ __forceinline__ void dsincos(double x, double& s, double& c) {
    const double inv2pi = 0.15915494309189533577, twopi = 6.283185307179586476925;
    double r = x * inv2pi; r = r - __builtin_rint(r); r *= twopi;
    double sg = 1.0;
    if (r > 1.5707963267948966) { r = 3.141592653589793 - r; sg = -1.0; } else if (r < -1.5707963267948966) { r = -3.141592653589793 - r; sg = -1.0; }
    const double r2 = r * r;
    double ss = 1.0, cc = 1.0, ts = 1.0, tc = 1.0;
#pragma unroll
    for (int k = 1; k <= 12; ++k) { tc *= -r2 / (double)((2 * k - 1) * (2 * k)); ts *= -r2 / (double)((2 * k) * (2 * k + 1)); cc += tc; ss += ts; }
    s = ss * r; c = sg * cc;
}
__device__ __forceinline__ double dexp(double x) {
    const double n = __builtin_rint(x * 1.4426950408889634);
    const double r = x - n * 0.6931471805599453094;
    double t = 1.0, sum = 1.0;
#pragma unroll
    for (int k = 1; k <= 14; ++k) { t *= r / (double)k; sum += t; }
    return __builtin_ldexp(sum, (int)n);
}

namespace pg8 {
constexpr int BM = 256, BK = 64, HALF = 128, HTB = HALF * BK * 2, STAGE_BYTES = 8 * HTB, NXCD = 8, WGM = 8;
__host__ __device__ __forceinline__ int lds_byte(int r, int c) { const int st = (r >> 4) * 2 + (c >> 5), rr = r & 15, cc = c & 31, ob = rr * 64 + cc * 2; return st * 1024 + (ob ^ (((ob >> 9) & 1) << 5)); }
__host__ __device__ __forceinline__ void stage_rc(int b, int& R, int& C) { const int st = b / 1024, sb = b % 1024, swz = sb ^ (((sb >> 9) & 1) << 5); R = (st >> 1) * 16 + swz / 64; C = (st & 1) * 32 + (swz % 64) / 2; }
__host__ __device__ __forceinline__ int perm32(int rho) { const int n = rho >> 4, i = rho & 15; return 8 * (i >> 2) + 4 * n + (i & 3); }
struct Unit { int pm, pn, kt0, nt; };
struct Gemm { const bf16_t* A; const bf16_t* Bt; int M, N, K, lda, ldb; };
struct StaticOrder {
    int nM, nN, nwg, G, c;
    __host__ __device__ void init(int M, int N, int G_, int c_) { nM = M / BM; nN = N / BM; nwg = nM * nN; G = G_; c = c_; }
    __host__ __device__ bool next(int i, Unit& u) const { const long L = (long)i * G + c; if (L >= nwg) return false; unit((int)L, u); return true; }
    __host__ __device__ void unit(int L, Unit& u) const {
        int wgid = L; { const int q = nwg / NXCD, r = nwg % NXCD, xcd = wgid % NXCD, off = wgid / NXCD; wgid = (xcd < r ? xcd * (q + 1) : r * (q + 1) + (xcd - r) * q) + off; }
        const int nig = WGM * nN, gid = wgid / nig, fm = gid * WGM, gsz = (nM - fm) < WGM ? (nM - fm) : WGM;
        u.pm = fm + ((wgid % nig) % gsz); u.pn = (wgid % nig) / gsz; u.kt0 = 0; u.nt = 0;
    }
    __device__ __forceinline__ void a_ready(const Unit&) const {}
    __device__ __forceinline__ void done(const Unit&) const {}
};
struct WinOrder {
    StaticOrder b;
    __host__ __device__ void init(int M, int N, int G_, int c_) { b.init(M, N, G_, c_); }
    __host__ __device__ bool next(int i, Unit& u) const {
        if (b.G != 256) return b.next(i, u);
        const int c = b.c; int L;
        if (i < 3) L = i * 256 + c;
        else if (i == 3) { if (c >= 240 && c < 248) return false; L = 768 + c; }
        else if (i == 4) { if (c < 230) L = 1024 + c; else if (c < 238) L = 768 + c + 10; else return false; }
        else return false;
        b.unit(L, u); return true;
    }
    __device__ __forceinline__ void a_ready(const Unit&) const {}
    __device__ __forceinline__ void done(const Unit&) const {}
};
struct PairOrder {
    int nM, nwg, G, c;
    __host__ __device__ void init(int nM_, int G_, int c_) { nM = nM_; nwg = 2 * nM_ * 8; G = G_; c = c_; }
    __host__ __device__ bool next(int i, Unit& u) const {
        if (nM == 33 && G == 256) {
            if (i < 2) { const int L = i * 256 + c, which = L >> 8, r = L & 255; u.pm = 33 * which + (r & 31); u.pn = 8 * which + (r >> 5); u.kt0 = 0; u.nt = 0; return true; }
            if (i == 2 && c < 16) { const int which = c >> 3; u.pm = 33 * which + 32; u.pn = 8 * which + (c & 7); u.kt0 = 0; u.nt = 0; return true; }
            return false;
        }
        const long L = (long)i * G + c; if (L >= nwg) return false;
        const int per = nM * 8, which = (int)L / per, r = (int)L % per;
        u.pm = 33 * which + (r % nM); u.pn = 8 * which + (r / nM); u.kt0 = 0; u.nt = 0; return true;
    }
    __device__ __forceinline__ void a_ready(const Unit&) const {}
    __device__ __forceinline__ void done(const Unit&) const {}
};

struct ResSplitOrder {
    StaticOrder lat; int G, c, S, ntS; bool ctx;
    __host__ __device__ void init(int N, int G_, int c_, bool ctx_, int S_, int ntS_) { lat.init(8192, N, G_, c_); G = G_; c = c_; ctx = ctx_; S = S_; ntS = ntS_; }
    __host__ __device__ bool next(int i, Unit& u) const {
        const long L = (long)i * G + c;
        if (L < lat.nwg) return lat.next(i, u);
        const int j = (int)(L - lat.nwg); if (!ctx || j >= 8 * S) return false;
        u.pm = 32; u.pn = j & 7; u.kt0 = (j >> 3) * ntS; u.nt = ntS; return true;
    }
    __device__ __forceinline__ void a_ready(const Unit&) const {}
    __device__ __forceinline__ void done(const Unit&) const {}
};
struct S5Order {
    int nmt, G, c;
    __host__ __device__ void init(int nmt_, int G_, int c_) { nmt = nmt_; G = G_; c = c_; }
    __host__ __device__ bool next(int i, Unit& u) const {
        const long L = (long)i * G + c; if (c < 0 || L >= 64 * nmt) return false;
        const int g = (int)L / nmt, mt = (int)L % nmt; u.pm = 3 * g + mt; u.pn = g; u.kt0 = 0; u.nt = 0; return true;
    }
    __device__ __forceinline__ void a_ready(const Unit&) const {}
    __device__ __forceinline__ void done(const Unit&) const {}
};
template <class Epi, class Sched, bool ALIGN_EPI = false, bool SP2 = false, bool FP8 = false>
__device__ __forceinline__ void gemm_phase(LAS unsigned char* lds, const Gemm g, const Sched& S, const Epi& E) {
    const int tid = opaque_tid(), wid = __builtin_amdgcn_readfirstlane(tid >> 6), lane = tid & 63, wr = wid >> 2, wc = wid & 3, fr = lane & 15, fq = lane >> 4;
    const int K = g.K, nt = K / BK, lda = g.lda ? g.lda : K, ldb = g.ldb ? g.ldb : K;
    unsigned voffA[2], voffB[2];
#pragma unroll
    for (int i = 0; i < 2; ++i) { int R, C; stage_rc(tid * 16 + i * 8192, R, C); const int Rb = Epi::PERM ? ((R & ~31) + perm32(R & 31)) : R;
        voffA[i] = (unsigned)(R * lda + C) * 2u; voffB[i] = (unsigned)(Rb * ldb + C) * 2u; }
    const size_t kstep = (size_t)(BK * 2);
    const size_t hstepA = (size_t)HALF * lda * 2, hstepB = (size_t)HALF * ldb * 2;
    const size_t tstepA = 2 * hstepA, tstepB = 2 * hstepB;
    const unsigned ldsw = (unsigned)wid * 1024u;
    const int aoff = lds_byte(wr * 64 + fr, fq * 8), boff = lds_byte(wc * 32 + fr, fq * 8);
#define PG8_SA(b, h) (((b) * 2 + (h)) * HTB)
#define PG8_SB(b, h) ((4 + (b) * 2 + (h)) * HTB)
#define PG8_STAGE(bufoff, gbase, voff) do { _Pragma("unroll") for (int _i = 0; _i < 2; ++_i) \
        __builtin_amdgcn_global_load_lds((const unsigned*)((const char*)(gbase) + (voff)[_i]), (LAS unsigned*)(lds + (bufoff) + ldsw + _i * 8192), 16, 0, 0); } while (0)
    typedef int v8i_ __attribute__((ext_vector_type(8))); typedef int v4i_ __attribute__((ext_vector_type(4)));
#define PG8_LDA(dst, b, h) do { _Pragma("unroll") for (int m = 0; m < 4; ++m) { const v4i_ lo_ = *(const LAS v4i_*)(lds + PG8_SA(b, h) + aoff + m * 2048), hi_ = *(const LAS v4i_*)(lds + PG8_SA(b, h) + aoff + m * 2048 + 1024); \
        dst[m] = __builtin_shufflevector(lo_, hi_, 0, 1, 2, 3, 4, 5, 6, 7); } } while (0)
#define PG8_LDB(dst, b, h) do { _Pragma("unroll") for (int n = 0; n < 2; ++n) { const v4i_ lo_ = *(const LAS v4i_*)(lds + PG8_SB(b, h) + boff + n * 2048), hi_ = *(const LAS v4i_*)(lds + PG8_SB(b, h) + boff + n * 2048 + 1024); \
        dst[n] = __builtin_shufflevector(lo_, hi_, 0, 1, 2, 3, 4, 5, 6, 7); } } while (0)
#define PG8_HALF(v, k) __builtin_bit_cast(bf16x8, (k) == 0 ? __builtin_shufflevector(v, v, 0, 1, 2, 3) : __builtin_shufflevector(v, v, 4, 5, 6, 7))
#define PG8_MMA(ai, bj, At, Bt) do { __builtin_amdgcn_s_setprio(1); _Pragma("unroll") for (int m = 0; m < 4; ++m) _Pragma("unroll") for (int n = 0; n < 2; ++n) { \
        if constexpr (FP8) asm volatile("v_mfma_scale_f32_16x16x128_f8f6f4 %0, %1, %2, %0, %3, %3 op_sel_hi:[0,0,0]" : "+v"(acc[ai][bj][m][n]) : "v"(Bt[n]), "v"(At[m]), "v"(one_scale));   \
        else { acc[ai][bj][m][n] = __builtin_amdgcn_mfma_f32_16x16x32_bf16(PG8_HALF(Bt[n], 0), PG8_HALF(At[m], 0), acc[ai][bj][m][n], 0, 0, 0); \
               acc[ai][bj][m][n] = __builtin_amdgcn_mfma_f32_16x16x32_bf16(PG8_HALF(Bt[n], 1), PG8_HALF(At[m], 1), acc[ai][bj][m][n], 0, 0, 0); } } \
        __builtin_amdgcn_s_setprio(0); } while (0)
#define PG8_WAIT_V(n) asm volatile("s_waitcnt vmcnt(" #n ")" ::: "memory")
#define PG8_WAIT_L(n) asm volatile("s_waitcnt lgkmcnt(" #n ")" ::: "memory")
#define PG8_BAR __builtin_amdgcn_s_barrier()
#define PG8_SCHED __builtin_amdgcn_sched_barrier(0)
    Unit cur, nxt; int ui = 0;
    if (!S.next(0, cur)) return;
    f32x4 acc[2][2][4][2];
#pragma unroll
    for (int a = 0; a < 2; ++a)
#pragma unroll
        for (int b = 0; b < 2; ++b)
#pragma unroll
            for (int m = 0; m < 4; ++m)
#pragma unroll
                for (int n = 0; n < 2; ++n) acc[a][b][m][n] = (f32x4){0.f, 0.f, 0.f, 0.f};
    v8i_ At[4], B0[2], B1[2]; const int one_scale = 0x7f7f7f7f; (void)one_scale;
    const char* cA = (const char*)g.A + (size_t)cur.pm * tstepA + (size_t)cur.kt0 * kstep; const char* cB = (const char*)g.Bt + (size_t)cur.pn * tstepB + (size_t)cur.kt0 * kstep;
    S.a_ready(cur);
    if constexpr (SP2) {
        PG8_STAGE(PG8_SB(0, 0), cB, voffB); PG8_STAGE(PG8_SB(0, 1), cB + hstepB, voffB); PG8_STAGE(PG8_SA(0, 0), cA, voffA); PG8_STAGE(PG8_SA(0, 1), cA + hstepA, voffA);
        if (wr == 1) PG8_BAR;
        PG8_WAIT_V(2); PG8_BAR;
        PG8_STAGE(PG8_SB(1, 0), cB + kstep, voffB); PG8_STAGE(PG8_SA(1, 0), cA + kstep, voffA); PG8_STAGE(PG8_SB(1, 1), cB + hstepB + kstep, voffB);
        PG8_WAIT_V(6); PG8_BAR;
    } else {
        PG8_STAGE(PG8_SB(0, 0), cB, voffB); PG8_STAGE(PG8_SA(0, 0), cA, voffA); PG8_STAGE(PG8_SB(0, 1), cB + hstepB, voffB); PG8_STAGE(PG8_SA(0, 1), cA + hstepA, voffA);
        if (wr == 1) PG8_BAR;
        PG8_WAIT_V(4); PG8_BAR;
        PG8_STAGE(PG8_SB(1, 0), cB + kstep, voffB); PG8_STAGE(PG8_SA(1, 0), cA + kstep, voffA); PG8_STAGE(PG8_SB(1, 1), cB + hstepB + kstep, voffB);
        PG8_WAIT_V(6); PG8_BAR;
    }
    for (;;) {
        const bool has_next = S.next(ui + 1, nxt);
        const char* nA = has_next ? (const char*)g.A + (size_t)nxt.pm * tstepA + (size_t)nxt.kt0 * kstep : cA; const char* nB = has_next ? (const char*)g.Bt + (size_t)nxt.pn * tstepB + (size_t)nxt.kt0 * kstep : cB;
        const int ntu = cur.nt ? cur.nt : nt;
        for (int t = 0; t < ntu; t += 2) {
            const bool last = (t == ntu - 2);
            const char* a1 = cA + (size_t)(t + 1) * kstep;
            const char* a2 = last ? nA : cA + (size_t)(t + 2) * kstep; const char* b2 = last ? nB : cB + (size_t)(t + 2) * kstep;
            const char* a3 = a2 + kstep; const char* b3 = b2 + kstep;
            if (last && has_next) S.a_ready(nxt);
            if constexpr (SP2) {
            PG8_LDB(B0, 0, 0); PG8_LDB(B1, 0, 1); PG8_SCHED; PG8_LDA(At, 0, 0); PG8_STAGE(PG8_SA(1, 1), a1 + hstepA, voffA);
            PG8_WAIT_V(8); PG8_WAIT_L(0); PG8_BAR; PG8_MMA(0, 0, At, B0); PG8_MMA(0, 1, At, B1); PG8_BAR; PG8_SCHED;
            PG8_LDA(At, 0, 1); PG8_STAGE(PG8_SB(0, 0), b2, voffB); PG8_STAGE(PG8_SB(0, 1), b2 + hstepB, voffB); PG8_STAGE(PG8_SA(0, 0), a2, voffA);
            PG8_WAIT_V(8); PG8_WAIT_L(0); PG8_BAR; PG8_MMA(1, 0, At, B0); PG8_MMA(1, 1, At, B1); PG8_BAR; PG8_SCHED;
            PG8_LDB(B0, 1, 0); PG8_LDB(B1, 1, 1); PG8_SCHED; PG8_LDA(At, 1, 0); PG8_STAGE(PG8_SA(0, 1), a2 + hstepA, voffA);
            PG8_WAIT_V(8); PG8_WAIT_L(0); PG8_BAR; PG8_MMA(0, 0, At, B0); PG8_MMA(0, 1, At, B1); PG8_BAR; PG8_SCHED;
            PG8_LDA(At, 1, 1); PG8_STAGE(PG8_SB(1, 0), b3, voffB); PG8_STAGE(PG8_SB(1, 1), b3 + hstepB, voffB); PG8_STAGE(PG8_SA(1, 0), a3, voffA);
            PG8_WAIT_V(8); PG8_WAIT_L(0); PG8_BAR; PG8_MMA(1, 0, At, B0); PG8_MMA(1, 1, At, B1); PG8_BAR; PG8_SCHED;
            } else {
            PG8_LDB(B0, 0, 0); PG8_SCHED; PG8_LDA(At, 0, 0); PG8_STAGE(PG8_SA(1, 1), a1 + hstepA, voffA);
            PG8_WAIT_L(8); PG8_BAR; PG8_WAIT_L(0); PG8_MMA(0, 0, At, B0); PG8_BAR; PG8_SCHED;
            PG8_LDB(B1, 0, 1); PG8_STAGE(PG8_SB(0, 0), b2, voffB);
            PG8_BAR; PG8_WAIT_L(0); PG8_MMA(0, 1, At, B1); PG8_BAR;
            PG8_LDA(At, 0, 1); PG8_STAGE(PG8_SA(0, 0), a2, voffA);
            PG8_BAR; PG8_WAIT_L(0); PG8_MMA(1, 0, At, B0); PG8_BAR; PG8_SCHED;
            PG8_STAGE(PG8_SB(0, 1), b2 + hstepB, voffB);
            PG8_WAIT_V(6); PG8_BAR; PG8_MMA(1, 1, At, B1); PG8_BAR;
            PG8_LDB(B0, 1, 0); PG8_SCHED; PG8_LDA(At, 1, 0); PG8_STAGE(PG8_SA(0, 1), a2 + hstepA, voffA);
            PG8_WAIT_L(8); PG8_BAR; PG8_WAIT_L(0); PG8_MMA(0, 0, At, B0); PG8_BAR; PG8_SCHED;
            PG8_LDB(B1, 1, 1); PG8_STAGE(PG8_SB(1, 0), b3, voffB);
            PG8_BAR; PG8_WAIT_L(0); PG8_MMA(0, 1, At, B1); PG8_BAR;
            PG8_LDA(At, 1, 1); PG8_STAGE(PG8_SA(1, 0), a3, voffA);
            PG8_BAR; PG8_WAIT_L(0); PG8_MMA(1, 0, At, B0); PG8_BAR; PG8_SCHED;
            PG8_STAGE(PG8_SB(1, 1), b3 + hstepB, voffB);
            PG8_WAIT_V(6); PG8_BAR; PG8_MMA(1, 1, At, B1); PG8_BAR;
            }
        }
        if constexpr (FP8) asm volatile("s_nop 15\n\ts_nop 15" ::: "memory");
        if constexpr (ALIGN_EPI) { if (wr == 0) PG8_BAR; }
        E(acc, cur, wr, wc, fr, fq); S.done(cur);
        if (!has_next) break;
#pragma unroll
        for (int a = 0; a < 2; ++a)
#pragma unroll
            for (int b = 0; b < 2; ++b)
#pragma unroll
                for (int m = 0; m < 4; ++m)
#pragma unroll
                    for (int n = 0; n < 2; ++n) acc[a][b][m][n] = (f32x4){0.f, 0.f, 0.f, 0.f};
        cur = nxt; cA = nA; cB = nB; ++ui;
        if constexpr (ALIGN_EPI) { if (wr == 1) PG8_BAR; }
    }
    PG8_WAIT_V(0);
    if constexpr (!ALIGN_EPI) { if (wr == 0) PG8_BAR; }
    PG8_BAR;
#undef PG8_SA
#undef PG8_SB
#undef PG8_STAGE
#undef PG8_LDA
#undef PG8_LDB
#undef PG8_MMA
#undef PG8_WAIT_V
#undef PG8_WAIT_L
#undef PG8_BAR
#undef PG8_SCHED
}

typedef f32x4 Acc[2][2][4][2];
struct EpiIn {
    static constexpr bool PERM = true;
    bf16_t* Z; bf16_t* AP; int f8; float scale;
    __device__ __forceinline__ void operator()(const Acc& acc, const Unit& u, int wr, int wc, int fr, int fq) const {
        const int pt = f8 ? win_fp8_tile(u.pn) : win_bf16_tile(u.pn), row0 = u.pm * BM + wr * 64 + fr, col0 = pt * BM + wc * 32 + 8 * fq; const bool sg = pt >= 22, s5 = pt >= 18 && pt < 22;
#pragma unroll
        for (int ai = 0; ai < 2; ++ai)
#pragma unroll
            for (int m = 0; m < 4; ++m) { const int row = row0 + ai * HALF + m * 16; bf16_t* rowp = Z + (size_t)row * NIN + col0;
#pragma unroll
                for (int bj = 0; bj < 2; ++bj) { f32x4 v0 = acc[ai][bj][m][0], v1 = acc[ai][bj][m][1];
                    if (sg) {
#pragma unroll
                        for (int j = 0; j < 4; ++j) { v0[j] = sigmoidf_(v0[j] * scale); v1[j] = sigmoidf_(v1[j] * scale); } }
                    else { v0 *= scale; v1 *= scale; }
                    u32x4 w; w.x = cvt_pk_bf16(v0[0], v0[1]); w.y = cvt_pk_bf16(v0[2], v0[3]); w.z = cvt_pk_bf16(v1[0], v1[1]); w.w = cvt_pk_bf16(v1[2], v1[3]);
                    if (s5) { const int cu = col0 + bj * HALF - C_U, g = cu >> 4, h0 = cu & 15;
                        *(u32x4*)(AP + ((size_t)(g * 768 + (row >> 4)) * 512 + (row & 15) * 16 + h0)) = w; }
                    else *(u32x4*)(rowp + bj * HALF) = w; } }
    }
};
struct EpiS {
    static constexpr bool PERM = true;
    float* S;
    __device__ __forceinline__ void operator()(const Acc& acc, const Unit& u, int wr, int wc, int fr, int fq) const {
        const int row0 = u.pm * BM + wr * 64 + fr, col0 = wc * 32 + 8 * fq;
#pragma unroll
        for (int ai = 0; ai < 2; ++ai)
#pragma unroll
            for (int m = 0; m < 4; ++m) { float* p = S + (size_t)(row0 + ai * HALF + m * 16) * 256 + col0;
#pragma unroll
                for (int bj = 0; bj < 2; ++bj) { *(f32x4*)(p + bj * HALF) = acc[ai][bj][m][0]; *(f32x4*)(p + bj * HALF + 4) = acc[ai][bj][m][1]; } }
    }
};
struct EpiY {
    static constexpr bool PERM = true;
    bf16_t* AG; int nchunk;
    __device__ __forceinline__ void operator()(const Acc& acc, const Unit& u, int wr, int wc, int fr, int fq) const {
        const int g = u.pn, c0 = (u.pm - 3 * g) * BM + wr * 64 + fr, n0 = wc * 32 + 8 * fq;
#pragma unroll
        for (int ai = 0; ai < 2; ++ai)
#pragma unroll
            for (int m = 0; m < 4; ++m) { const int c = c0 + ai * HALF + m * 16;
                if (c < nchunk) {
#pragma unroll
                    for (int bj = 0; bj < 2; ++bj) { const int n = n0 + bj * HALF, tt = n >> 4, h0 = n & 15; const f32x4 v0 = acc[ai][bj][m][0], v1 = acc[ai][bj][m][1];
                        u32x4 w; w.x = cvt_pk_bf16(gelu_tanh(v0[0]), gelu_tanh(v0[1])); w.y = cvt_pk_bf16(gelu_tanh(v0[2]), gelu_tanh(v0[3]));
                        w.z = cvt_pk_bf16(gelu_tanh(v1[0]), gelu_tanh(v1[1])); w.w = cvt_pk_bf16(gelu_tanh(v1[2]), gelu_tanh(v1[3]));
                        *(u32x4*)(AG + (size_t)(16 * c + tt) * 1024 + g * 16 + h0) = w; } } }
    }
};
struct EpiGate {
    static constexpr bool PERM = true;
    const bf16_t* Z; bf16_t* PG;
    __device__ __forceinline__ void operator()(const Acc& acc, const Unit& u, int wr, int wc, int fr, int fq) const {
        const int which = u.pm >= 33 ? 1 : 0, pm = u.pm - 33 * which, pn = u.pn - 8 * which;
        const int row0 = pm * BM + wr * 64 + fr, col0 = pn * BM + wc * 32 + 8 * fq;
        const bf16_t* gz = Z + C_G + which * DM + col0; bf16_t* out = PG + (size_t)which * NT * DM + col0;
#pragma unroll
        for (int ai = 0; ai < 2; ++ai)
#pragma unroll
            for (int m = 0; m < 4; ++m) { const size_t row = (size_t)(row0 + ai * HALF + m * 16);
#pragma unroll
                for (int bj = 0; bj < 2; ++bj) { float gt[8]; unpack8(*(const u32x4*)(gz + row * NIN + bj * HALF), gt);
                    const f32x4 v0 = acc[ai][bj][m][0], v1 = acc[ai][bj][m][1];
                    u32x4 w; w.x = cvt_pk_bf16(v0[0] * gt[0], v0[1] * gt[1]); w.y = cvt_pk_bf16(v0[2] * gt[2], v0[3] * gt[3]); w.z = cvt_pk_bf16(v1[0] * gt[4], v1[1] * gt[5]); w.w = cvt_pk_bf16(v1[2] * gt[6], v1[3] * gt[7]);
                    *(u32x4*)(out + row * DM + bj * HALF) = w; } }
    }
};
struct EpiGlu {
    static constexpr bool PERM = true;
    const bf16_t* Z; const bf16_t* PG; bf16_t* MRG;
    __device__ __forceinline__ void operator()(const Acc& acc, const Unit& u, int wr, int wc, int fr, int fq) const {
        const int row0 = u.pm * BM + wr * 64 + fr, mc0 = u.pn * HALF + wc * 32 + 8 * fq;
#pragma unroll
        for (int ai = 0; ai < 2; ++ai)
#pragma unroll
            for (int m = 0; m < 4; ++m) { const size_t row = (size_t)(row0 + ai * HALF + m * 16);
                float g2[8], pa[8], pb[8], o[8];
                unpack8(*(const u32x4*)(Z + row * NIN + C_G + 2 * DM + mc0), g2);
                unpack8(*(const u32x4*)(PG + row * DM + mc0), pa);
                unpack8(*(const u32x4*)(PG + (size_t)NT * DM + row * DM + mc0), pb);
                const f32x4 a0 = acc[ai][0][m][0], a1 = acc[ai][0][m][1], q0 = acc[ai][1][m][0], q1 = acc[ai][1][m][1];
#pragma unroll
                for (int j = 0; j < 4; ++j) { o[j] = pa[j] + pb[j] + g2[j] * a0[j] * sigmoidf_(q0[j]); o[4 + j] = pa[4 + j] + pb[4 + j] + g2[4 + j] * a1[j] * sigmoidf_(q1[j]); }
                *(u32x4*)(MRG + row * DM + mc0) = pack8(o); }
    }
};
struct EpiRes {
    static constexpr bool PERM = true;
    const float* ST; const float* lg; const float* lb; float* T; const float* gv_lat; const float* gv_ctx; float* SLAB;
    __device__ __forceinline__ void operator()(const Acc& acc, const Unit& u, int wr, int wc, int fr, int fq) const {
        const int row0 = u.pm * BM + wr * 64 + fr, col0 = u.pn * BM + wc * 32 + 8 * fq;
        if (u.nt != 0) {
            float* sl = SLAB + ((size_t)(u.kt0 / u.nt) * NCTX + (row0 - NLAT)) * DM + col0;
#pragma unroll
            for (int ai = 0; ai < 2; ++ai)
#pragma unroll
                for (int m = 0; m < 4; ++m) { const size_t off = (size_t)(ai * HALF + m * 16) * DM;
#pragma unroll
                    for (int bj = 0; bj < 2; ++bj) { *(f32x4*)(sl + off + bj * HALF) = acc[ai][bj][m][0]; *(f32x4*)(sl + off + bj * HALF + 4) = acc[ai][bj][m][1]; } }
            return;
        }
        const float* gv = (u.pm == 32 ? gv_ctx : gv_lat) + col0;
#pragma unroll
        for (int bj = 0; bj < 2; ++bj) {
            const f32x4 g0 = *(const f32x4*)(gv + bj * HALF), g1 = *(const f32x4*)(gv + bj * HALF + 4);
            const f32x4 a0 = *(const f32x4*)(lg + col0 + bj * HALF) * DN_ALPHA, a1 = *(const f32x4*)(lg + col0 + bj * HALF + 4) * DN_ALPHA;
            const f32x4 b0 = *(const f32x4*)(lb + col0 + bj * HALF) * DN_ALPHA, b1 = *(const f32x4*)(lb + col0 + bj * HALF + 4) * DN_ALPHA;
#pragma unroll
            for (int ai = 0; ai < 2; ++ai)
#pragma unroll
                for (int m = 0; m < 4; ++m) { const int row = row0 + ai * HALF + m * 16; const size_t off = (size_t)row * DM + col0 + bj * HALF;
                    const f32x2 st = *(const f32x2*)(ST + 2 * row);
                    const f32x4 x0 = *(const f32x4*)(T + off), x1 = *(const f32x4*)(T + off + 4);
                    *(f32x4*)(T + off) = ((x0 - st[0]) * st[1]) * a0 + b0 + g0 * acc[ai][bj][m][0];
                    *(f32x4*)(T + off + 4) = ((x1 - st[0]) * st[1]) * a1 + b1 + g1 * acc[ai][bj][m][1]; } }
    }
};
struct EpiSwi {
    static constexpr bool PERM = true;
    bf16_t* ACT;
    __device__ __forceinline__ void operator()(const Acc& acc, const Unit& u, int wr, int wc, int fr, int fq) const {
        const int row0 = u.pm * BM + wr * 64 + fr, c0 = u.pn * HALF + wc * 32 + 8 * fq;
#pragma unroll
        for (int ai = 0; ai < 2; ++ai)
#pragma unroll
            for (int m = 0; m < 4; ++m) { const size_t row = (size_t)(row0 + ai * HALF + m * 16);
                const f32x4 a0 = acc[ai][0][m][0], a1 = acc[ai][0][m][1], q0 = acc[ai][1][m][0], q1 = acc[ai][1][m][1]; float o[8];
#pragma unroll
                for (int j = 0; j < 4; ++j) { o[j] = siluf_(a0[j]) * q0[j]; o[4 + j] = siluf_(a1[j]) * q1[j]; }
                *(u32x4*)(ACT + row * FF + c0) = pack8(o); }
    }
};
}

namespace att {
constexpr int NW = 8, QBLK = 32, KVBLK = 64;
constexpr int LDQK = NIN;
constexpr size_t SHM_V = KVBLK * 128 * 2, SHM_K = KVBLK * 128 * 2, SHM_ATTN = 2 * SHM_V + 2 * SHM_K + NW * 64 * 4;
#define KSWZ(row, colB) ((row) * 256 + ((colB) ^ (((row) & 7) << 4)))
#define SBAR() __builtin_amdgcn_sched_barrier(0)
__device__ __forceinline__ int crow(int r, int hi) { return (r & 3) + 8 * (r >> 2) + 4 * hi; }
__device__ __forceinline__ unsigned cvtpk(float lo, float hi) { return cvt_pk_bf16(lo, hi); }

__device__ __forceinline__ float max3f(float a, float b, float c) { return __builtin_fmaxf(__builtin_fmaxf(a, b), c); }
template <bool FIRST>
__device__ __forceinline__ void partialSM(f32x16& p0, f32x16& p1, float& m_reg, f32x16& nb, float& alpha, const float thr) {
  float pmax;
  { float a0 = max3f(p0[0], p0[1], p0[2]), a1 = max3f(p0[3], p0[4], p0[5]), a2 = max3f(p0[6], p0[7], p0[8]), a3 = max3f(p0[9], p0[10], p0[11]);
    float a4 = max3f(p0[12], p0[13], p0[14]), a5 = max3f(p0[15], p1[0], p1[1]), a6 = max3f(p1[2], p1[3], p1[4]), a7 = max3f(p1[5], p1[6], p1[7]);
    float a8 = max3f(p1[8], p1[9], p1[10]), a9 = max3f(p1[11], p1[12], p1[13]);
    a0 = max3f(a0, a1, a2); a3 = max3f(a3, a4, a5); a6 = max3f(a6, a7, a8); a9 = max3f(a9, p1[14], p1[15]);
    a0 = max3f(a0, a3, a6); pmax = fmaxf(a0, a9); }
  { auto rr = __builtin_amdgcn_permlane32_swap(__float_as_uint(pmax), __float_as_uint(pmax), false, false);
    pmax = fmaxf(__uint_as_float(rr[0]), __uint_as_float(rr[1])); }
  if (!FIRST && __builtin_expect(__all(pmax <= thr), 1)) { alpha = 1.f; }
  else { const float d = FIRST ? pmax : fmaxf(pmax, 0.f); alpha = FIRST ? 1.f : __builtin_amdgcn_exp2f(-d); m_reg += d;
#pragma unroll
    for (int r = 0; r < 16; ++r) { p0[r] -= d; p1[r] -= d; nb[r] = -m_reg; }
    asm volatile("" : "+v"(nb)); }
#pragma unroll
  for (int r = 0; r < 16; ++r) p0[r] = __builtin_amdgcn_exp2f(p0[r]);
}
template <bool PACK = true>
__device__ __forceinline__ void finishSM(f32x16& p0, f32x16& p1, float alpha, float& l_reg, bf16x8& pa0, bf16x8& pa1, bf16x8& pa2, bf16x8& pa3) {
#pragma unroll
  for (int r = 0; r < 16; ++r) p1[r] = __builtin_amdgcn_exp2f(p1[r]);
  float ps = 0;
#pragma unroll
  for (int r = 0; r < 16; ++r) ps += p0[r];
#pragma unroll
  for (int r = 0; r < 16; ++r) ps += p1[r];
  { auto rr = __builtin_amdgcn_permlane32_swap(__float_as_uint(ps), __float_as_uint(ps), false, false);
    ps = __uint_as_float(rr[0]) + __uint_as_float(rr[1]); }
  l_reg = l_reg * alpha + ps;
#define PK4(P, BASE, OUT) do { u32x4 w = {cvtpk(P[BASE + 0], P[BASE + 1]), cvtpk(P[BASE + 2], P[BASE + 3]), cvtpk(P[BASE + 4], P[BASE + 5]), cvtpk(P[BASE + 6], P[BASE + 7])}; \
    OUT = *reinterpret_cast<bf16x8*>(&w); } while (0)
  if constexpr (PACK) { PK4(p0, 0, pa0); PK4(p0, 8, pa1); PK4(p1, 0, pa2); PK4(p1, 8, pa3); }
#undef PK4
}
__device__ __forceinline__ float rowmax32(const f32x16& p0, const f32x16& p1) {
  float a0 = max3f(p0[0], p0[1], p0[2]), a1 = max3f(p0[3], p0[4], p0[5]), a2 = max3f(p0[6], p0[7], p0[8]), a3 = max3f(p0[9], p0[10], p0[11]);
  float a4 = max3f(p0[12], p0[13], p0[14]), a5 = max3f(p0[15], p1[0], p1[1]), a6 = max3f(p1[2], p1[3], p1[4]), a7 = max3f(p1[5], p1[6], p1[7]);
  float a8 = max3f(p1[8], p1[9], p1[10]), a9 = max3f(p1[11], p1[12], p1[13]);
  a0 = max3f(a0, a1, a2); a3 = max3f(a3, a4, a5); a6 = max3f(a6, a7, a8); a9 = max3f(a9, p1[14], p1[15]);
  a0 = max3f(a0, a3, a6); float pmax = fmaxf(a0, a9);
  auto rr = __builtin_amdgcn_permlane32_swap(__float_as_uint(pmax), __float_as_uint(pmax), false, false);
  return fmaxf(__uint_as_float(rr[0]), __uint_as_float(rr[1]));
}
__device__ __forceinline__ void packP(const f32x16& p0, const f32x16& p1, bf16x8& pa0, bf16x8& pa1, bf16x8& pa2, bf16x8& pa3) {
#define PK4(P, BASE, OUT) do { u32x4 w = {cvtpk(P[BASE + 0], P[BASE + 1]), cvtpk(P[BASE + 2], P[BASE + 3]), cvtpk(P[BASE + 4], P[BASE + 5]), cvtpk(P[BASE + 6], P[BASE + 7])}; \
    OUT = *reinterpret_cast<bf16x8*>(&w); } while (0)
  PK4(p0, 0, pa0); PK4(p0, 8, pa1); PK4(p1, 0, pa2); PK4(p1, 8, pa3);
#undef PK4
}
constexpr float PS_BIG = 4096.f;
__device__ __forceinline__ void halfexp(f32x16& p0) {
#pragma unroll
  for (int r = 0; r < 16; ++r) p0[r] = __builtin_amdgcn_exp2f(p0[r]);
}
template <bool PACK = true>
__device__ __forceinline__ void finishFast(f32x16& p0, f32x16& p1, float& l_reg, float& psmax, bf16x8& pa0, bf16x8& pa1, bf16x8& pa2, bf16x8& pa3) {
  float dummy = 0.f; finishSM<PACK>(p0, p1, 0.f, dummy, pa0, pa1, pa2, pa3);
  l_reg += dummy; psmax = fmaxf(psmax, dummy);
}
typedef int v8i_att __attribute__((ext_vector_type(8)));
typedef int v4i_att __attribute__((ext_vector_type(4)));
__device__ __forceinline__ void packP8(const f32x16& p0, const f32x16& p1, v8i_att& p8) {
#pragma unroll
  for (int w = 0; w < 4; ++w) { p8[w] = (int)pk4_fp8(p0[4 * w], p0[4 * w + 1], p0[4 * w + 2], p0[4 * w + 3]); p8[4 + w] = (int)pk4_fp8(p1[4 * w], p1[4 * w + 1], p1[4 * w + 2], p1[4 * w + 3]); }
}
template <int D0> __device__ __forceinline__ void pv8_one(f32x16& od, const char* Vs, const v8i_att& p8, int r32, int hi) {
  const char* p = Vs + (D0 * 32 + r32) * 80 + 32 * hi;
  const v4i_att a = *reinterpret_cast<const v4i_att*>(p), b = *reinterpret_cast<const v4i_att*>(p + 16);
  od = __builtin_amdgcn_mfma_scale_f32_32x32x64_f8f6f4(p8, __builtin_shufflevector(a, b, 0, 1, 2, 3, 4, 5, 6, 7), od, 0, 0, 0, 0x7f7f7f7f, 0, 0x7f7f7f7f);
}
__device__ __forceinline__ void pv8(f32x16* o, const char* Vs, const v8i_att& p8, int r32, int hi) {
  pv8_one<0>(o[0], Vs, p8, r32, hi); pv8_one<1>(o[1], Vs, p8, r32, hi); pv8_one<2>(o[2], Vs, p8, r32, hi); pv8_one<3>(o[3], Vs, p8, r32, hi);
}
template <bool FULL>
__device__ __forceinline__ void qkt(f32x16& p0, f32x16& p1, const char* Ks, const bf16x8* qr, int r32, int hi, int kd0) {
  p0 = f32x16{}; p1 = f32x16{};
#pragma unroll
  for (int d0 = 0; d0 < (FULL ? 8 : 4); ++d0) { int cb = ((kd0 + d0) * 16 + hi * 8) * 2;
    bf16x8 b0 = *reinterpret_cast<const bf16x8*>(Ks + KSWZ(r32, cb));
    bf16x8 b1 = *reinterpret_cast<const bf16x8*>(Ks + KSWZ(32 + r32, cb));
    p0 = __builtin_amdgcn_mfma_f32_32x32x16_bf16(b0, qr[d0], p0, 0, 0, 0);
    p1 = __builtin_amdgcn_mfma_f32_32x32x16_bf16(b1, qr[d0], p1, 0, 0, 0); }
}
constexpr int QSC8 = 0x7c7c7c7c;
__device__ __forceinline__ void qkt8(f32x16& p0, f32x16& p1, const f32x16& nb, const char* Ks, const v8i_att* q8, int r32, int hi) {
#pragma unroll
  for (int s_ = 0; s_ < 2; ++s_) { const char* k0p = Ks + r32 * 144 + 64 * s_ + 32 * hi; const char* k1p = k0p + 32 * 144;
    const v4i_att a0 = *reinterpret_cast<const v4i_att*>(k0p), a1 = *reinterpret_cast<const v4i_att*>(k0p + 16), b0 = *reinterpret_cast<const v4i_att*>(k1p), b1 = *reinterpret_cast<const v4i_att*>(k1p + 16);
    p0 = __builtin_amdgcn_mfma_scale_f32_32x32x64_f8f6f4(__builtin_shufflevector(a0, a1, 0, 1, 2, 3, 4, 5, 6, 7), q8[s_], s_ == 0 ? nb : p0, 0, 0, 0, 0x7f7f7f7f, 0, QSC8);
    p1 = __builtin_amdgcn_mfma_scale_f32_32x32x64_f8f6f4(__builtin_shufflevector(b0, b1, 0, 1, 2, 3, 4, 5, 6, 7), q8[s_], s_ == 0 ? nb : p1, 0, 0, 0, 0x7f7f7f7f, 0, QSC8); }
}
__device__ __forceinline__ void qkt8d(f32x16& p0, f32x16& p1, const f32x16& nb, const char* Ks, const v8i_att& q8, int r32, int hi) {
  const char* k0p = Ks + r32 * 80 + 32 * hi; const char* k1p = k0p + 32 * 80;
  const v4i_att a0 = *reinterpret_cast<const v4i_att*>(k0p), a1 = *reinterpret_cast<const v4i_att*>(k0p + 16), b0 = *reinterpret_cast<const v4i_att*>(k1p), b1 = *reinterpret_cast<const v4i_att*>(k1p + 16);
  p0 = __builtin_amdgcn_mfma_scale_f32_32x32x64_f8f6f4(__builtin_shufflevector(a0, a1, 0, 1, 2, 3, 4, 5, 6, 7), q8, nb, 0, 0, 0, 0x7f7f7f7f, 0, QSC8);
  p1 = __builtin_amdgcn_mfma_scale_f32_32x32x64_f8f6f4(__builtin_shufflevector(b0, b1, 0, 1, 2, 3, 4, 5, 6, 7), q8, nb, 0, 0, 0, 0x7f7f7f7f, 0, QSC8);
}
__device__ __forceinline__ int v_st(int k, int c) { const int kk = k; return ((kk >> 3) * 4 + (c >> 5)) * 512 + ((kk & 7) * 32 + (c & 31)) * 2; }
__device__ __forceinline__ int v_rd_base(int lane) { return ((lane & 3) << 3) | (((lane >> 2) & 3) << 6) | (((lane >> 4) & 1) << 5) | (((lane >> 5) & 1) << 8); }
constexpr int v_rd_off(int d0, int ks, int half) { return d0 * 512 + ks * 4096 + half * 2048; }
template <int OFF> __device__ __forceinline__ s16x4 tr_read(int vb) {
  s16x4 r; asm volatile("ds_read_b64_tr_b16 %0, %1 offset:%2" : "=&v"(r) : "v"(vb), "i"(OFF) : "memory"); return r;
}
template <int D0> __device__ __forceinline__ void pv_one(f32x16& od, int vb, bf16x8 pa0, bf16x8 pa1, bf16x8 pa2, bf16x8 pa3) {
  const s16x4 l0 = tr_read<v_rd_off(D0, 0, 0)>(vb), h0 = tr_read<v_rd_off(D0, 0, 1)>(vb), l1 = tr_read<v_rd_off(D0, 1, 0)>(vb), h1 = tr_read<v_rd_off(D0, 1, 1)>(vb);
  const s16x4 l2 = tr_read<v_rd_off(D0, 2, 0)>(vb), h2 = tr_read<v_rd_off(D0, 2, 1)>(vb), l3 = tr_read<v_rd_off(D0, 3, 0)>(vb), h3 = tr_read<v_rd_off(D0, 3, 1)>(vb);
  asm volatile("s_waitcnt lgkmcnt(0)" ::: "memory"); SBAR();
#define PK(L, H) (bf16x8){L[0], L[1], L[2], L[3], H[0], H[1], H[2], H[3]}
  od = __builtin_amdgcn_mfma_f32_32x32x16_bf16(pa0, PK(l0, h0), od, 0, 0, 0);
  od = __builtin_amdgcn_mfma_f32_32x32x16_bf16(pa1, PK(l1, h1), od, 0, 0, 0);
  od = __builtin_amdgcn_mfma_f32_32x32x16_bf16(pa2, PK(l2, h2), od, 0, 0, 0);
  od = __builtin_amdgcn_mfma_f32_32x32x16_bf16(pa3, PK(l3, h3), od, 0, 0, 0);
#undef PK
}
__device__ __forceinline__ void pv_d0(f32x16* o, int vb, bf16x8 pa0, bf16x8 pa1, bf16x8 pa2, bf16x8 pa3) {
  pv_one<0>(o[0], vb, pa0, pa1, pa2, pa3); pv_one<1>(o[1], vb, pa0, pa1, pa2, pa3); pv_one<2>(o[2], vb, pa0, pa1, pa2, pa3); pv_one<3>(o[3], vb, pa0, pa1, pa2, pa3);
}


template <bool FULL, bool FAST>
__device__ __forceinline__ bool attn_dense_body(const bf16_t* __restrict__ Qb, const bf16_t* __restrict__ Kh, const bf16_t* __restrict__ Vh,
                                                bf16_t* __restrict__ Ob, const int ldo, const int seq, const int kd0, const float C, const float thr_s, char* lds) {
  const int tid = opaque_tid(), wid = tid >> 6, lane = tid & 63, r32 = lane & 31, hi = lane >> 5;
  char* V_lds = lds; char* K_lds = lds + 2 * SHM_V;
  float* ws = (float*)(lds + 2 * SHM_V + 2 * SHM_K) + wid * 64; float* li_l = ws; float* al_l = ws + 32;
  float m_reg = 0.f, l_reg = 0, psmax = 0.f; f32x16 o[4] = {}; f32x16 nb = {}; v8i_att q8[2]; (void)psmax;
  if constexpr (FULL) {
    const char* Q8w = (const char*)Qb + (long)(wid * QBLK + r32) * 1024 + 32 * hi;
#pragma unroll
    for (int s_ = 0; s_ < 2; ++s_) { const v4i_att x0 = *reinterpret_cast<const v4i_att*>(Q8w + 64 * s_), x1 = *reinterpret_cast<const v4i_att*>(Q8w + 64 * s_ + 16); q8[s_] = __builtin_shufflevector(x0, x1, 0, 1, 2, 3, 4, 5, 6, 7); }
  } else {
    const char* Q8w = (const char*)Qb + (long)(wid * QBLK + r32) * 2048 + 32 * hi;
    const v4i_att x0 = *reinterpret_cast<const v4i_att*>(Q8w), x1 = *reinterpret_cast<const v4i_att*>(Q8w + 16); q8[0] = __builtin_shufflevector(x0, x1, 0, 1, 2, 3, 4, 5, 6, 7);
  }
  const int sr = tid >> 4, sc = (tid & 15) * 8, vst0 = v_st(sr, sc), vst1 = v_st(32 + sr, sc);
  const int vb0 = (int)(uintptr_t)V_lds + v_rd_base(lane);
  constexpr int SDEPTH = 1;
  struct { bf16x8 vs0, vs1, ks0; } sr_[SDEPTH]; u32x2 kd8 = {0u, 0u}; v8i_att p8 = {}; (void)p8;
  const unsigned goff0 = (unsigned)(sr * LDQK + sc) * 2u, goff1 = goff0 + 32u * LDQK * 2u;
  const unsigned goffk = (unsigned)((tid >> 3) * LDQK + (tid & 7) * 8) * 2u;
#define SLOAD(i, k0) do { sr_[i].vs0 = *reinterpret_cast<const bf16x8*>((const char*)Vh + (size_t)((k0) >> 6) * 8192 + tid * 16); \
    if constexpr (FULL) sr_[i].ks0 = *reinterpret_cast<const bf16x8*>((const char*)Kh + (size_t)((k0) + (tid >> 3)) * 256 + (tid & 7) * 16); \
    else kd8 = *reinterpret_cast<const u32x2*>((const char*)Kh + (size_t)((k0) + (tid >> 3)) * 2048 + (tid & 7) * 8); } while (0)
#define SWRITE(b, i) do { *(bf16x8*)(V_lds + (b) * SHM_V + (tid >> 2) * 80 + (tid & 3) * 16) = sr_[i].vs0; \
    if constexpr (FULL) *(bf16x8*)(K_lds + (b) * SHM_K + (tid >> 3) * 144 + (tid & 7) * 16) = sr_[i].ks0; \
    else *(u32x2*)(K_lds + (b) * SHM_K + (tid >> 3) * 80 + (tid & 7) * 8) = kd8; } while (0)
#define PV(b) do { pv8(o, V_lds + (b) * SHM_V, p8, r32, hi); } while (0)
#define QKT(P0, P1, KS) do { if constexpr (FULL) qkt8(P0, P1, nb, KS, q8, r32, hi); else qkt8d(P0, P1, nb, KS, q8[0], r32, hi); } while (0)
#define SWAIT() do { if constexpr (SDEPTH == 2) asm volatile("s_waitcnt vmcnt(4)" ::: "memory"); else asm volatile("s_waitcnt vmcnt(0)" ::: "memory"); } while (0)
#define RESC(a) do { if constexpr (!FAST) if (__any((a) < 1.f)) { if (hi == 0) al_l[r32] = (a); asm volatile("s_waitcnt lgkmcnt(0)" ::: "memory"); \
    _Pragma("unroll") for (int d = 0; d < 4; ++d) _Pragma("unroll") for (int r = 0; r < 16; ++r) o[d][r] *= al_l[crow(r, hi)]; } } while (0)
#define PSM(P0, P1, AL) do { if constexpr (FAST) halfexp(P0); else partialSM<false>(P0, P1, m_reg, nb, AL, thr_s); } while (0)
#define FSM(P0, P1, AL) do { if constexpr (FAST) finishFast<false>(P0, P1, l_reg, psmax, pa0, pa1, pa2, pa3); else finishSM<false>(P0, P1, AL, l_reg, pa0, pa1, pa2, pa3); \
    packP8(P0, P1, p8); } while (0)
  f32x16 pA0, pA1, pB0, pB1; float alA = 1.f, alB = 1.f; bf16x8 pa0, pa1, pa2, pa3; const int NT_ = seq / KVBLK; (void)C;
  constexpr int SE = 0, SO = SDEPTH - 1;
  if constexpr (FAST) {
    float psA = 0.f, psB = 0.f;
#define SOFTQ(N0, N1, PSN, q) do { _Pragma("unroll") for (int r = 0; r < 8; ++r) { if constexpr ((q) < 2) { N0[8 * (q) + r] = __builtin_amdgcn_exp2f(N0[8 * (q) + r]); PSN += N0[8 * (q) + r]; } \
      else { N1[8 * ((q) - 2) + r] = __builtin_amdgcn_exp2f(N1[8 * ((q) - 2) + r]); PSN += N1[8 * ((q) - 2) + r]; } } } while (0)
#define PVQ(b, D) do { pv8_one<D>(o[D], V_lds + (b) * SHM_V, p8, r32, hi); } while (0)
#define PVS(b, N0, N1, PSN) do { PSN = 0.f; PVQ(b, 0); SOFTQ(N0, N1, PSN, 0); PVQ(b, 1); SOFTQ(N0, N1, PSN, 1); PVQ(b, 2); SOFTQ(N0, N1, PSN, 2); PVQ(b, 3); SOFTQ(N0, N1, PSN, 3); } while (0)
#define FIN(P0, P1, PS) do { { auto rr_ = __builtin_amdgcn_permlane32_swap(__float_as_uint(PS), __float_as_uint(PS), false, false); PS = __uint_as_float(rr_[0]) + __uint_as_float(rr_[1]); } \
      l_reg += PS; psmax = fmaxf(psmax, PS); packP8(P0, P1, p8); } while (0)
    constexpr int FS_K = 8192, FS_STAGE = 16384;
    const int wv_ = __builtin_amdgcn_readfirstlane(wid);
    const unsigned gV = (unsigned)((tid >> 2) * 64 + (((tid & 3) ^ ((tid >> 4) & 3)) * 16));
    const unsigned gK = FULL ? (unsigned)((tid >> 3) * 256 + (((tid & 7) ^ ((tid >> 4) & 7)) * 16))
                             : (unsigned)((tid >> 2) * 2048 + (((tid & 3) ^ ((tid >> 4) & 3)) * 16));
    const int swv = (r32 >> 2) & 3, vA = r32 * 64 + ((2 * hi) ^ swv) * 16, vB = r32 * 64 + ((2 * hi + 1) ^ swv) * 16;
    const int swk = FULL ? (r32 >> 1) & 7 : (r32 >> 2) & 3;
    const int kA0 = FULL ? r32 * 128 + ((2 * hi) ^ swk) * 16 : r32 * 64 + ((2 * hi) ^ swk) * 16, kB0 = FULL ? r32 * 128 + ((2 * hi + 1) ^ swk) * 16 : r32 * 64 + ((2 * hi + 1) ^ swk) * 16;
    const int kA1 = r32 * 128 + ((4 + 2 * hi) ^ swk) * 16, kB1 = r32 * 128 + ((5 + 2 * hi) ^ swk) * 16;
#define DMA(st, k0) do { __builtin_amdgcn_global_load_lds((const unsigned*)((const char*)Vh + (size_t)((k0) >> 6) * 8192 + gV), (LAS unsigned*)((LAS char*)(uintptr_t)(unsigned)(uintptr_t)lds + (st) + wv_ * 1024), 16, 0, 0); \
      if constexpr (FULL) __builtin_amdgcn_global_load_lds((const unsigned*)((const char*)Kh + (size_t)(k0) * 256 + gK), (LAS unsigned*)((LAS char*)(uintptr_t)(unsigned)(uintptr_t)lds + (st) + FS_K + wv_ * 1024), 16, 0, 0); \
      else if (wv_ < 4) __builtin_amdgcn_global_load_lds((const unsigned*)((const char*)Kh + (size_t)(k0) * 2048 + gK), (LAS unsigned*)((LAS char*)(uintptr_t)(unsigned)(uintptr_t)lds + (st) + FS_K + wv_ * 1024), 16, 0, 0); } while (0)
#define LDV4(off) (*reinterpret_cast<const v4i_att*>(lds + (off)))
#define QKTS(P0, P1, st) do { const int kb_ = (st) + FS_K; \
      if constexpr (FULL) { const v4i_att a0 = LDV4(kb_ + kA0), a1 = LDV4(kb_ + kB0), b0 = LDV4(kb_ + 4096 + kA0), b1 = LDV4(kb_ + 4096 + kB0); \
        const v4i_att c0 = LDV4(kb_ + kA1), c1 = LDV4(kb_ + kB1), d0 = LDV4(kb_ + 4096 + kA1), d1 = LDV4(kb_ + 4096 + kB1); \
        P0 = __builtin_amdgcn_mfma_scale_f32_32x32x64_f8f6f4(__builtin_shufflevector(a0, a1, 0, 1, 2, 3, 4, 5, 6, 7), q8[0], nb, 0, 0, 0, 0x7f7f7f7f, 0, QSC8); \
        P1 = __builtin_amdgcn_mfma_scale_f32_32x32x64_f8f6f4(__builtin_shufflevector(b0, b1, 0, 1, 2, 3, 4, 5, 6, 7), q8[0], nb, 0, 0, 0, 0x7f7f7f7f, 0, QSC8); \
        P0 = __builtin_amdgcn_mfma_scale_f32_32x32x64_f8f6f4(__builtin_shufflevector(c0, c1, 0, 1, 2, 3, 4, 5, 6, 7), q8[1], P0, 0, 0, 0, 0x7f7f7f7f, 0, QSC8); \
        P1 = __builtin_amdgcn_mfma_scale_f32_32x32x64_f8f6f4(__builtin_shufflevector(d0, d1, 0, 1, 2, 3, 4, 5, 6, 7), q8[1], P1, 0, 0, 0, 0x7f7f7f7f, 0, QSC8); } \
      else { const v4i_att a0 = LDV4(kb_ + kA0), a1 = LDV4(kb_ + kB0), b0 = LDV4(kb_ + 2048 + kA0), b1 = LDV4(kb_ + 2048 + kB0); \
        P0 = __builtin_amdgcn_mfma_scale_f32_32x32x64_f8f6f4(__builtin_shufflevector(a0, a1, 0, 1, 2, 3, 4, 5, 6, 7), q8[0], nb, 0, 0, 0, 0x7f7f7f7f, 0, QSC8); \
        P1 = __builtin_amdgcn_mfma_scale_f32_32x32x64_f8f6f4(__builtin_shufflevector(b0, b1, 0, 1, 2, 3, 4, 5, 6, 7), q8[0], nb, 0, 0, 0, 0x7f7f7f7f, 0, QSC8); } } while (0)
#undef PVQ
#define PVQ(st, D) do { const v4i_att a_ = LDV4((st) + (D) * 2048 + vA), b_ = LDV4((st) + (D) * 2048 + vB); \
      o[D] = __builtin_amdgcn_mfma_scale_f32_32x32x64_f8f6f4(p8, __builtin_shufflevector(a_, b_, 0, 1, 2, 3, 4, 5, 6, 7), o[D], 0, 0, 0, 0x7f7f7f7f, 0, 0x7f7f7f7f); } while (0)
#define STEP_END() do { asm volatile("s_waitcnt vmcnt(0)" ::: "memory"); __syncthreads(); { const int t_ = oC; oC = oN; oN = oW; oW = t_; } } while (0)
    int oC = 0, oN = FS_STAGE, oW = 2 * FS_STAGE;
    DMA(0, 0); DMA(FS_STAGE, KVBLK); asm volatile("s_waitcnt vmcnt(0)" ::: "memory"); __syncthreads();
    QKTS(pA0, pA1, oC);
    { const float d = rowmax32(pA0, pA1); m_reg = d;
#pragma unroll
      for (int r = 0; r < 16; ++r) { pA0[r] = __builtin_amdgcn_exp2f(pA0[r] - d); pA1[r] = __builtin_amdgcn_exp2f(pA1[r] - d); nb[r] = -d; }
      asm volatile("" : "+v"(nb));
#pragma unroll
      for (int r = 0; r < 16; ++r) psA += pA0[r] + pA1[r]; }
    for (int j = 0; j + 2 < NT_; j += 2) {
      DMA(oW, (j + 2) * KVBLK); SBAR(); QKTS(pB0, pB1, oN);
      FIN(pA0, pA1, psA); SBAR();
      PVS(oC, pB0, pB1, psB);
      STEP_END();
      DMA(oW, (j + 3) * KVBLK); SBAR(); QKTS(pA0, pA1, oN);
      FIN(pB0, pB1, psB); SBAR();
      PVS(oC, pA0, pA1, psA);
      STEP_END();
    }
    SBAR(); QKTS(pB0, pB1, oN);
    FIN(pA0, pA1, psA); SBAR();
    PVS(oC, pB0, pB1, psB);
    FIN(pB0, pB1, psB); SBAR();
    PVQ(oN, 0); PVQ(oN, 1); PVQ(oN, 2); PVQ(oN, 3);
#undef DMA
#undef LDV4
#undef QKTS
#undef STEP_END
#undef SOFTQ
#undef PVQ
#undef PVS
#undef FIN
  } else {
  SLOAD(SE, 0); asm volatile("s_waitcnt vmcnt(0)" ::: "memory"); SWRITE(0, SE); __syncthreads();
  QKT(pA0, pA1, K_lds); partialSM<true>(pA0, pA1, m_reg, nb, alA, thr_s);
  SLOAD(SO, KVBLK); if constexpr (SDEPTH == 2) { if (2 < NT_) SLOAD(SE, 2 * KVBLK); }
  SWAIT(); SWRITE(1, SO); __syncthreads();
  for (int j = 1; j + 1 < NT_; j += 2) {
    SBAR(); QKT(pB0, pB1, K_lds + SHM_K);
    FSM(pA0, pA1, alA); SBAR();
    SLOAD(SO, (j + SDEPTH) * KVBLK); SBAR();
    PV(0); PSM(pB0, pB1, alB);
    __syncthreads(); SWAIT(); SWRITE(0, SE);
    RESC(alB); __syncthreads();
    SBAR(); QKT(pA0, pA1, K_lds);
    FSM(pB0, pB1, alB); SBAR();
    if (SDEPTH == 1 || j + 3 < NT_) SLOAD(SE, (j + 1 + SDEPTH) * KVBLK); SBAR();
    PV(1); PSM(pA0, pA1, alA);
    __syncthreads(); SWAIT(); SWRITE(1, SO);
    RESC(alA); __syncthreads();
  }
  SBAR(); QKT(pB0, pB1, K_lds + SHM_K);
  FSM(pA0, pA1, alA); SBAR();
  PV(0); PSM(pB0, pB1, alB);
  __syncthreads(); RESC(alB);
  FSM(pB0, pB1, alB); SBAR();
  PV(1);
  }
  if constexpr (FAST) {
    int* badf = (int*)(lds + SHM_ATTN); const bool wbad = !__all(psmax <= 256.f);
    if (lane == 0) badf[wid] = wbad ? 1 : 0;
    __syncthreads();
    int anyb = 0;
#pragma unroll
    for (int w = 0; w < NW; ++w) anyb |= badf[w];
    if (__builtin_amdgcn_readfirstlane(anyb)) return true;
  }
  if (hi == 0) li_l[r32] = l_reg; asm volatile("s_waitcnt lgkmcnt(0)" ::: "memory");
  float rli[16];
#pragma unroll
  for (int r = 0; r < 16; ++r) rli[r] = __builtin_amdgcn_rcpf(li_l[crow(r, hi)]);
  bf16_t* Ow = Ob + (long)(wid * QBLK) * ldo;
#pragma unroll
  for (int r = 0; r < 16; ++r) { int orow = crow(r, hi);
#pragma unroll
    for (int d0 = 0; d0 < 4; ++d0) Ow[(long)orow * ldo + d0 * 32 + r32] = (bf16_t)f2bf(o[d0][r] * rli[r]); }
#undef SLOAD
#undef SWRITE
#undef SWAIT
#undef QKT
#undef RESC
#undef PSM
#undef FSM
#undef PV
  return false;
}
}

#define XB_TMO      128
#define XB_XCNT(j)  (256  + 64 * (j))
#define XB_XSUB(j)  (1280 + 64 * (j))
#define XB_XGEN(j)  (2304 + 64 * (j))
#define XB_TOP      3328
#define XB_TOPGEN   3392
#define XCD_BAR_WORDS 3456
#define XB_SPIN_CAP (1u << 21)
__device__ __forceinline__ unsigned xb_ld(unsigned* p)              { return __hip_atomic_load(p, __ATOMIC_RELAXED, __HIP_MEMORY_SCOPE_AGENT); }
__device__ __forceinline__ unsigned xb_add(unsigned* p, unsigned v) { return __hip_atomic_fetch_add(p, v, __ATOMIC_RELAXED, __HIP_MEMORY_SCOPE_AGENT); }
__device__ __forceinline__ unsigned xb_xcc_id() { return (unsigned)__builtin_amdgcn_s_getreg((3 << 11) | 20) & 0xFu; }
#define XB_SPIN(cond, bar) do { unsigned _sp = 0; while (cond) { __builtin_amdgcn_s_sleep(1); \
    if ((++_sp & 255u) == 0u) { if (xb_ld(&(bar)[XB_TMO])) break; if (_sp > XB_SPIN_CAP) { atomicAdd(&(bar)[XB_TMO], 1u); break; } } } } while (0)
struct XcdBarrier { unsigned* bar; unsigned x; volatile LAS unsigned* st; };
__device__ __forceinline__ XcdBarrier xcd_barrier_post(unsigned* bar, volatile LAS unsigned* st) {
    XcdBarrier b; b.bar = bar; b.x = (unsigned)__builtin_amdgcn_readfirstlane((int)xb_xcc_id()); b.st = st;
    if (threadIdx.x == 0) (void)xb_add(&bar[XB_XCNT(b.x)], 1u);
    return b;
}
__device__ __forceinline__ void xcd_barrier_complete(unsigned* bar, unsigned x, unsigned& nloc, unsigned& nx) {
    const unsigned G = gridDim.x * gridDim.y * gridDim.z;
    unsigned sum, cnt, mine, sp = 0u;
    for (;;) {
        sum = 0u; cnt = 0u; mine = 0u;
#pragma unroll
        for (unsigned j = 0; j < 16; ++j) { const unsigned c = xb_ld(&bar[XB_XCNT(j)]); sum += c; cnt += (c > 0u) ? 1u : 0u; mine = (j == x) ? c : mine; }
        if (sum == G) break;
        __builtin_amdgcn_s_sleep(1);
        if ((++sp & 255u) == 0u) { if (xb_ld(&bar[XB_TMO])) break; if (sp > XB_SPIN_CAP) { atomicAdd(&bar[XB_TMO], 1u); break; } }
    }
    nloc = mine > 0u ? mine : 1u; nx = cnt > 0u ? cnt : 1u;
}
__device__ __forceinline__ void xcd_barrier(const XcdBarrier& b) {
    asm volatile("s_waitcnt vmcnt(0)" ::: "memory");
    __syncthreads();
    if (threadIdx.x == 0) {
        unsigned* bar = b.bar;
        __builtin_amdgcn_s_waitcnt(0);
        unsigned nloc = b.st[0], nx = b.st[1];
        if (nloc == 0u) { xcd_barrier_complete(bar, b.x, nloc, nx); b.st[0] = nloc; b.st[1] = nx; }
        const unsigned old = xb_add(&bar[XB_XSUB(b.x)], 1u);
        const unsigned gen = old / nloc;
        if (old + 1u == (gen + 1u) * nloc) {
            __builtin_amdgcn_fence(__ATOMIC_RELEASE, "agent");
            asm volatile("s_waitcnt vmcnt(0)" ::: "memory");
            const unsigned og = xb_add(&bar[XB_TOP], 1u);
            const unsigned tg = og / nx;
            if (og + 1u == (tg + 1u) * nx) xb_add(&bar[XB_TOPGEN], 1u);
            else XB_SPIN(xb_ld(&bar[XB_TOPGEN]) == tg, bar);
            __builtin_amdgcn_fence(__ATOMIC_ACQUIRE, "agent");
            xb_add(&bar[XB_XGEN(b.x)], 1u);
            asm volatile("s_waitcnt vmcnt(0)" ::: "memory");
        } else {
            XB_SPIN(xb_ld(&bar[XB_XGEN(b.x)]) == gen, bar);
            __builtin_amdgcn_fence(__ATOMIC_ACQUIRE, "agent");
            asm volatile("s_waitcnt vmcnt(0)" ::: "memory");
        }
    }
    __syncthreads();
}

constexpr int RING_BYTES = 131072, MISC_OFF = RING_BYTES + 320, LDS_BYTES = 147456;

struct Args { const float* in[33]; float* out; unsigned char* ws; };
enum { I_X = 0, I_C, I_CTX, I_CCTX, I_WADA, I_BADA, I_WIN, I_LQ1, I_LK1, I_LQ2, I_LK2, I_SUBLN, I_WPA, I_QNORM, I_KNORM, I_WPB, I_ARE, I_AIM, I_LOGDT, I_BRE, I_BIM, I_CRE, I_CIM,
       I_S5D, I_WGLU, I_WO, I_LNMG, I_LNMB, I_WG, I_WU, I_WD, I_LNFG, I_LNFB };

typedef const float* cfp_t;
struct InTab {
    __device__ __forceinline__ cfp_t operator[](int i) const {
        const __attribute__((address_space(4))) unsigned char* k = (const __attribute__((address_space(4))) unsigned char*)__builtin_amdgcn_kernarg_segment_ptr();
        asm volatile("" : "+s"(k));
        return (cfp_t)(const GAS float*)(*(const __attribute__((address_space(4))) cfp_t*)(k + 8 * i));
    }
};
struct Frame {
    LAS unsigned char* lds; int tid, lane, wave, vcu, G, gw, NGW;
    InTab in; GAS float* out; GAS unsigned char* ws;
};

__device__ __forceinline__ void transpose_item(const float* W, int K, int N, bf16_t* WT, int k0, int n0, int out_row0, LAS float* scr, int lane, bool fp8 = false) {
    const float* src = W + (size_t)k0 * N + n0 + lane;
#pragma unroll
    for (int h = 0; h < 2; ++h) { float v[32];
#pragma unroll
        for (int i = 0; i < 32; ++i) v[i] = src[(size_t)(32 * h + i) * N];
#pragma unroll
        for (int i = 0; i < 32; ++i) scr[(32 * h + i) * 64 + (lane ^ (8 * ((32 * h + i) >> 3)))] = v[i]; }
    LDS_WAIT(); asm volatile("" ::: "memory");
    const int c = lane & 7;
#pragma unroll
    for (int j = 0; j < 8; ++j) { const int n = (lane >> 3) + 8 * j; const LAS float* s = scr + (8 * c) * 64 + (n ^ (8 * c));
        if (fp8) { u32x2 o8; o8.x = pk4_fp8(64.f * s[0 * 64], 64.f * s[1 * 64], 64.f * s[2 * 64], 64.f * s[3 * 64]); o8.y = pk4_fp8(64.f * s[4 * 64], 64.f * s[5 * 64], 64.f * s[6 * 64], 64.f * s[7 * 64]);
            *(u32x2*)((unsigned char*)WT + (size_t)(out_row0 + n) * K + k0 + 8 * c) = o8; }
        else { u32x4 o; o.x = pk2(s[0 * 64], s[1 * 64]); o.y = pk2(s[2 * 64], s[3 * 64]); o.z = pk2(s[4 * 64], s[5 * 64]); o.w = pk2(s[6 * 64], s[7 * 64]);
        *(u32x4*)(WT + (size_t)(out_row0 + n) * K + k0 + 8 * c) = o; } }
    LDS_WAIT(); asm volatile("" ::: "memory");
}
constexpr int IT_IN = (DM / 64) * (NIN / 64), IT_PA = (1024 / 64) * (DM / 64), IT_PB = IT_PA, IT_GLU = (1024 / 64) * (4096 / 64), IT_O = (DM / 64) * (DM / 64),
              IT_G = (DM / 64) * (FF / 64), IT_U = IT_G, IT_D = (FF / 64) * (DM / 64);
constexpr int IT_LAYER = IT_IN + IT_PA + IT_PB + IT_GLU + IT_O + IT_G + IT_U + IT_D;

__device__ __forceinline__ void convert_item(Frame& F, int it, LAS float* scr) {
    const int l = it / IT_LAYER; int r = it % IT_LAYER;
    GAS unsigned char* wl = F.ws + WS_W + (size_t)l * W_LAYER;
    const float* W; int K, N; bf16_t* WT; int mode;
    int rowoff = 0;
    if (r < IT_IN) { W = F.in[I_WIN] + (size_t)l * DM * NIN; K = DM; N = NIN; WT = (bf16_t*)(wl + W_IN); mode = 0; }
    else if ((r -= IT_IN) < IT_PA) { W = F.in[I_WPA] + (size_t)l * 1024 * DM; K = 1024; N = DM; WT = (bf16_t*)(wl + W_PAB); mode = 0; }
    else if ((r -= IT_PA) < IT_PB) { W = F.in[I_WPB] + (size_t)l * 1024 * DM; K = 1024; N = DM; WT = (bf16_t*)(wl + W_PAB); mode = 0; rowoff = 2048; }
    else if ((r -= IT_PB) < IT_GLU) { W = F.in[I_WGLU] + (size_t)l * 1024 * 4096; K = 1024; N = 4096; WT = (bf16_t*)(wl + W_GLU); mode = 1; }
    else if ((r -= IT_GLU) < IT_O) { W = F.in[I_WO] + (size_t)l * DM * DM; K = DM; N = DM; WT = (bf16_t*)(wl + W_O); mode = 0; }
    else if ((r -= IT_O) < IT_G) { W = F.in[I_WG] + (size_t)l * DM * FF; K = DM; N = FF; WT = (bf16_t*)(wl + W_GU); mode = 2; }
    else if ((r -= IT_G) < IT_U) { W = F.in[I_WU] + (size_t)l * DM * FF; K = DM; N = FF; WT = (bf16_t*)(wl + W_GU); mode = 3; }
    else { r -= IT_U; W = F.in[I_WD] + (size_t)l * FF * DM; K = FF; N = DM; WT = (bf16_t*)(wl + W_DN); mode = 0; }
    const int nblk = N / 64, kb = r / nblk, nb = r % nblk, k0 = 64 * kb, n0 = 64 * nb;
    int orow; bool fp8 = false;
    if (mode == 0 && N == NIN) { const int pt = n0 >> 8; orow = win_tile_slot(pt) * 256 + (n0 & 255);
        if (win_tile_fp8(pt)) { fp8 = true; WT = (bf16_t*)(wl + W_IN8); } }
    else if (mode == 0) orow = rowoff + n0;
    else if (mode == 1) orow = 256 * ((n0 % 2048) / 128) + 128 * (n0 / 2048) + (n0 % 128);
    else orow = 256 * (n0 / 128) + (mode == 3 ? 128 : 0) + (n0 % 128);
    transpose_item(W, K, N, WT, k0, n0, orow, scr, F.lane, fp8);
}

__device__ __forceinline__ void mod_item(Frame& F, int it) {
    const int cb = it % 48, slab = (it / 48) % MOD_SLABS, l = it / (48 * MOD_SLABS);
    const int col = cb * 256 + 4 * F.lane, k0 = slab * 64;
    const float* W = F.in[I_WADA] + ((size_t)l * DM + k0) * 12288 + col;
    const float* c = F.in[I_C] + k0; const float* cc = F.in[I_CCTX] + k0;
    f32x4 a0 = {0.f, 0.f, 0.f, 0.f}, a1 = a0;
#pragma unroll 8
    for (int k = 0; k < 64; ++k) { const f32x4 w = *(const f32x4*)(W + (size_t)k * 12288); const float s0 = siluf_(c[k]), s1 = siluf_(cc[k]); a0 += w * s0; a1 += w * s1; }
    float* P = (float*)(F.ws + WS_MODP) + (((size_t)slab * NL + l) * 2) * 12288 + col;
    *(f32x4*)P = a0; *(f32x4*)(P + 12288) = a1;
}

__device__ __forceinline__ void s5_param_item(Frame& F, int it) {
    const int p = it & 63, g = (it >> 6) & 63, dir = (it >> 12) & 1, l = it >> 13;
    const int gi = (l * 2 + dir) * 64 + g;
    double are = (double)F.in[I_ARE][gi * 64 + p]; if (are > -1e-4) are = (double)(-1e-4f);
    const double aim = (double)F.in[I_AIM][gi * 64 + p];
    const double dt = dexp((double)F.in[I_LOGDT][gi]);
    double s, c; dsincos(aim * dt, s, c);
    const double mag = dexp(are * dt), lr = mag * c, li = mag * s;
    const double den = are * are + aim * aim, nr = lr - 1.0;
    const double cr = (nr * are + li * aim) / den, ci = (li * are - nr * aim) / den;
    const float* bre = F.in[I_BRE] + ((size_t)gi * 64 + p) * 16; const float* bim = F.in[I_BIM] + ((size_t)gi * 64 + p) * 16;
    f32x2* BBF = (f32x2*)(F.ws + WS_BBF) + ((size_t)gi * 64 + p) * 16;
#pragma unroll
    for (int h = 0; h < 16; ++h) { const double br = bre[h], bi = bim[h];
        BBF[h] = (f32x2){(float)(cr * br - ci * bi), (float)(cr * bi + ci * br)}; }
    { f32x2* POW = (f32x2*)(F.ws + WS_POW) + (size_t)gi * 17 * 64 + p; double pr = 1.0, pi = 0.0;
      for (int k = 0; k <= 16; ++k) { POW[k * 64] = (f32x2){(float)pr, (float)pi}; const double nr = pr * lr - pi * li, ni = pr * li + pi * lr; pr = nr; pi = ni; } }
}

__device__ __forceinline__ void modulate_row(int lane, const float* xrow, float* xres, bf16_t* hrow, unsigned char* h8row, const float* sh, const float* sc) {
#pragma unroll
    for (int j = 0; j < 8; ++j) { const int c = 4 * lane + 256 * j; const f32x4 v = *(const f32x4*)(xrow + c), a = *(const f32x4*)(sc + c), b = *(const f32x4*)(sh + c);
        if (xres) *(f32x4*)(xres + c) = v;
        const f32x4 y = v * (a + 1.f) + b; u32x2 w; w.x = cvt_pk_bf16(y[0], y[1]); w.y = cvt_pk_bf16(y[2], y[3]); *(u32x2*)(hrow + c) = w;
        *(unsigned*)(h8row + c) = pk4_fp8(y[0], y[1], y[2], y[3]); }
}
__device__ __forceinline__ void ln_finish(int lane, f32x4 (&v)[8], float* xrow, bf16_t* hrow, const float* g, const float* b, const float* sh, const float* sc, unsigned char* h8row = nullptr, float* stats = nullptr) {
    float s = 0.f;
#pragma unroll
    for (int j = 0; j < 8; ++j) s += (v[j][0] + v[j][1]) + (v[j][2] + v[j][3]);
    const float mean = wave_sum(s) * (1.f / DM); float s2 = 0.f;
#pragma unroll
    for (int j = 0; j < 8; ++j) { v[j] = v[j] - mean; s2 += (v[j][0] * v[j][0] + v[j][1] * v[j][1]) + (v[j][2] * v[j][2] + v[j][3] * v[j][3]); }
    const float rstd = 1.f / sqrtf(wave_sum(s2) * (1.f / DM) + 1e-6f);
    if (stats && lane == 0) { f32x2 st = {mean, rstd}; *(f32x2*)stats = st; }
#pragma unroll
    for (int j = 0; j < 8; ++j) { const int c = 4 * lane + 256 * j; const f32x4 y = v[j] * rstd * *(const f32x4*)(g + c) + *(const f32x4*)(b + c);
        if (xrow) *(f32x4*)(xrow + c) = y;
        if (hrow) { const f32x4 z = y * (*(const f32x4*)(sc + c) + 1.f) + *(const f32x4*)(sh + c); u32x2 w; w.x = cvt_pk_bf16(z[0], z[1]); w.y = cvt_pk_bf16(z[2], z[3]); *(u32x2*)(hrow + c) = w;
            if (h8row) *(unsigned*)(h8row + c) = pk4_fp8(z[0], z[1], z[2], z[3]); } }
}
__device__ __forceinline__ void ln_row(int lane, const float* trow, float* xrow, bf16_t* hrow, const float* g, const float* b, const float* sh, const float* sc, unsigned char* h8row = nullptr, float* stats = nullptr) {
    f32x4 v[8];
#pragma unroll
    for (int j = 0; j < 8; ++j) v[j] = *(const f32x4*)(trow + 4 * lane + 256 * j);
    ln_finish(lane, v, xrow, hrow, g, b, sh, sc, h8row, stats);
}
__device__ __forceinline__ void ln_ctx_row(Frame& F, int r, const float* slab, int nslab, const float* gvec, const float* g, const float* b, const float* sh, const float* sc, bool h8) {
    const int lane = F.lane; LAS float* xb = (LAS float*)F.lds;
    f32x4 a[8];
#pragma unroll
    for (int j = 0; j < 8; ++j) a[j] = (f32x4){0.f, 0.f, 0.f, 0.f};
    for (int q = F.wave; q < nslab; q += NWAVES) { const float* sp = slab + ((size_t)q * NCTX + r) * DM + 4 * lane;
#pragma unroll
        for (int j = 0; j < 8; ++j) a[j] += *(const f32x4*)(sp + 256 * j); }
#pragma unroll
    for (int j = 0; j < 8; ++j) *(LAS f32x4*)(xb + F.wave * DM + 4 * lane + 256 * j) = a[j];
    __syncthreads();
    if (F.wave == 0) {
        float* xrow = (float*)(F.ws + WS_XRES) + (size_t)(NLAT + r) * DM; f32x4 v[8];
#pragma unroll
        for (int j = 0; j < 8; ++j) { const int c = 4 * lane + 256 * j; f32x4 t = *(const LAS f32x4*)(xb + c);
#pragma unroll
            for (int w = 1; w < NWAVES; ++w) t += *(const LAS f32x4*)(xb + w * DM + c);
            v[j] = *(const f32x4*)(xrow + c) * DN_ALPHA + *(const f32x4*)(gvec + c) * t; }
        ln_finish(lane, v, xrow, (bf16_t*)(F.ws + WS_H) + (size_t)(NLAT + r) * DM, g, b, sh, sc, h8 ? (unsigned char*)(F.ws + WS_H8) + (size_t)(NLAT + r) * DM : (unsigned char*)nullptr);
    }
    __syncthreads();
}

__device__ __forceinline__ void prep_row(Frame& F, int l, int t) {
    bf16_t* z = (bf16_t*)(F.ws + WS_Z) + (size_t)t * NIN;
    const bool lat = t < NLAT; const int prow = t >> 6, pcol = t & 63, lane = F.lane;
    const f32x2* RD = (const f32x2*)(F.ws + WS_ROPE_DA); const f32x2* RG = (const f32x2*)(F.ws + WS_ROPE_GQ);
    {
#pragma unroll
        for (int rep = 0; rep < 2; ++rep) { const int task = lane + 64 * rep, b = task >> 1, a = task & 1;
            const bf16_t* p = z + b * 32 + 8 * a; const int pos = (b & 1) ? pcol : prow;
            float x1[8], x2[8]; unpack8(*(const u32x4*)p, x1); unpack8(*(const u32x4*)(p + 16), x2);
            float o1[8], o2[8];
            if (lat) { const f32x2* cs = RD + pos * 16 + 8 * a;
#pragma unroll
                for (int j = 0; j < 8; ++j) { const f32x2 q = cs[j]; o1[j] = x1[j] * q[0] - x2[j] * q[1]; o2[j] = x2[j] * q[0] + x1[j] * q[1]; } }
            else {
#pragma unroll
                for (int j = 0; j < 8; ++j) { o1[j] = x1[j]; o2[j] = x2[j]; } }
            if (b < 32) {
#pragma unroll
                for (int j = 0; j < 8; ++j) { o1[j] *= 0.125f * 1.4426950408889634f * 8.f; o2[j] *= 0.125f * 1.4426950408889634f * 8.f; } }
            unsigned char* d8 = (unsigned char*)(F.ws + WS_QKA8) + (size_t)t * 2048 + b * 32 + 8 * a;
            u32x2 w1, w2; w1.x = pk4_fp8(o1[0], o1[1], o1[2], o1[3]); w1.y = pk4_fp8(o1[4], o1[5], o1[6], o1[7]); w2.x = pk4_fp8(o2[0], o2[1], o2[2], o2[3]); w2.y = pk4_fp8(o2[4], o2[5], o2[6], o2[7]);
            *(u32x2*)d8 = w1; *(u32x2*)(d8 + 16) = w2; }
    }
#pragma unroll
    for (int pass = 0; pass < 2; ++pass) {
        const int seg = lane >> 3, sub = lane & 7, axis = sub >> 2, a = sub & 3;
        const bool active = pass == 0 || seg < 2;
        bf16_t* p = z + (pass == 0 ? C_QB : C_KB) + (active ? seg : 0) * 128 + axis * 64 + 8 * a;
        const float* nw = F.in[pass == 0 ? I_QNORM : I_KNORM] + l * 128 + axis * 64 + 8 * a;
        float x1[8], x2[8]; unpack8(*(const u32x4*)p, x1); unpack8(*(const u32x4*)(p + 32), x2);
        float ss = 0.f;
#pragma unroll
        for (int j = 0; j < 8; ++j) ss += x1[j] * x1[j] + x2[j] * x2[j];
        ss += __shfl_xor(ss, 1); ss += __shfl_xor(ss, 2); ss += __shfl_xor(ss, 4);
        const float r = 1.f / sqrtf(ss * (1.f / 128.f) + 1e-6f);
        float o1[8], o2[8];
#pragma unroll
        for (int j = 0; j < 8; ++j) { x1[j] = x1[j] * r * nw[j]; x2[j] = x2[j] * r * nw[32 + j]; }
        if (lat) { const int pos = axis ? pcol : prow; const f32x2* cs = RG + pos * 32 + 8 * a;
#pragma unroll
            for (int j = 0; j < 8; ++j) { const f32x2 q = cs[j]; o1[j] = x1[j] * q[0] - x2[j] * q[1]; o2[j] = x2[j] * q[0] + x1[j] * q[1]; } }
        else {
#pragma unroll
            for (int j = 0; j < 8; ++j) { o1[j] = x1[j]; o2[j] = x2[j]; } }
        if (pass == 0) {
#pragma unroll
            for (int j = 0; j < 8; ++j) { o1[j] *= 0.088388347648318440f * 1.4426950408889634f * 8.f; o2[j] *= 0.088388347648318440f * 1.4426950408889634f * 8.f; } }
        if (active) { unsigned char* d8 = (pass == 0 ? (unsigned char*)(F.ws + WS_QB8) + (size_t)t * 1024 : (unsigned char*)(F.ws + WS_KB8) + (size_t)t * 256) + seg * 128 + axis * 64 + 8 * a;
            u32x2 w1, w2; w1.x = pk4_fp8(o1[0], o1[1], o1[2], o1[3]); w1.y = pk4_fp8(o1[4], o1[5], o1[6], o1[7]); w2.x = pk4_fp8(o2[0], o2[1], o2[2], o2[3]); w2.y = pk4_fp8(o2[4], o2[5], o2[6], o2[7]);
            *(u32x2*)d8 = w1; *(u32x2*)(d8 + 32) = w2; }
    }
}

__device__ __forceinline__ void vt8_task(Frame& F, int task, LAS unsigned char* scr) {
    const int dvq = task & 3, tile = (task >> 2) % 132, hh = task / (4 * 132), lane = F.lane; const bool da = hh >= 2; const int kvh = da ? hh - 2 : hh;
    const bf16_t* p = (const bf16_t*)(F.ws + WS_Z) + (size_t)(tile * 64 + lane) * NIN + (da ? C_VA : C_VB) + kvh * 128 + dvq * 32;
    const int kk = lane & 31, slot = ((kk >> 2) & 1) * 32 + (lane >> 5) * 16 + (kk & 3) + 4 * (kk >> 3);
#pragma unroll
    for (int q = 0; q < 4; ++q) { float x[8]; unpack8(*(const u32x4*)(p + 8 * q), x);
        const unsigned w0 = pk4_fp8(x[0], x[1], x[2], x[3]), w1 = pk4_fp8(x[4], x[5], x[6], x[7]);
#pragma unroll
        for (int j = 0; j < 4; ++j) { scr[(8 * q + j) * 80 + slot] = (unsigned char)(w0 >> (8 * j)); scr[(8 * q + 4 + j) * 80 + slot] = (unsigned char)(w1 >> (8 * j)); } }
    LDS_WAIT(); asm volatile("" ::: "memory");
    unsigned char* dst = (unsigned char*)(F.ws + (da ? WS_VA8T : WS_VB8T)) + ((size_t)(kvh * 132 + tile) * 128 + dvq * 32) * 64;
#pragma unroll
    for (int rep = 0; rep < 2; ++rep) { const int piece = lane + 64 * rep, row = piece >> 2, part = piece & 3;
        *(u32x4*)(dst + row * 64 + part * 16) = *(const LAS u32x4*)(scr + row * 80 + part * 16); }
    LDS_WAIT(); asm volatile("" ::: "memory");
}

__device__ __forceinline__ void da_combine_row(Frame& F, int l, int t, float lam, float one_m_li) {
    const int lane = F.lane, h = lane >> 3, d0 = (lane & 7) * 16;
    const bf16_t* o1p = (const bf16_t*)(F.ws + WS_ODA) + (size_t)t * DM + (2 * h) * 128 + d0; const bf16_t* o2p = o1p + 128;
    const float* w = F.in[I_SUBLN] + l * 128 + d0;
    float a[16], b[16]; unpack8(*(const u32x4*)o1p, *(float(*)[8])a); unpack8(*(const u32x4*)(o1p + 8), *(float(*)[8])(a + 8));
    unpack8(*(const u32x4*)o2p, *(float(*)[8])b); unpack8(*(const u32x4*)(o2p + 8), *(float(*)[8])(b + 8));
    float ss = 0.f;
#pragma unroll
    for (int j = 0; j < 16; ++j) { a[j] = a[j] - lam * b[j]; ss += a[j] * a[j]; }
    ss += __shfl_xor(ss, 1); ss += __shfl_xor(ss, 2); ss += __shfl_xor(ss, 4);
    const float r = one_m_li / sqrtf(ss * (1.f / 128.f) + 1e-5f);
#pragma unroll
    for (int j = 0; j < 16; ++j) a[j] = a[j] * r * w[j];
    bf16_t* out = (bf16_t*)(F.ws + WS_APB) + (size_t)t * 1024 + h * 128 + d0;
    *(u32x4*)out = pack8(*(float(*)[8])a); *(u32x4*)(out + 8) = pack8(*(float(*)[8])(a + 8));
}


__device__ __forceinline__ void s5_ktab_item(Frame& F, int idx) {
    const int hp = idx & 15, h = (idx >> 4) & 15, dir = (idx >> 8) & 1, g = (idx >> 9) & 63, l = idx >> 15;
    const int gi = (l * 2 + dir) * 64 + g;
    const float* cre = F.in[I_CRE] + ((size_t)gi * 16 + h) * 64; const float* cim = F.in[I_CIM] + ((size_t)gi * 16 + h) * 64;
    const f32x2* L1 = (const f32x2*)(F.ws + WS_POW) + ((size_t)gi * 17 + 1) * 64; const f32x2* BBF = (const f32x2*)(F.ws + WS_BBF) + (size_t)gi * 64 * 16 + hp;
    float acc[16];
#pragma unroll
    for (int k = 0; k < 16; ++k) acc[k] = 0.f;
#pragma unroll 4
    for (int p = 0; p < 64; ++p) { const float cr = cre[p], ci = cim[p]; const f32x2 L = L1[p], B = BBF[p * 16];
        float wr = cr * B[0] - ci * B[1], wi = cr * B[1] + ci * B[0];
#pragma unroll
        for (int k = 0; k < 16; ++k) { acc[k] += wr; const float nr = wr * L[0] - wi * L[1], ni = wr * L[1] + wi * L[0]; wr = nr; wi = ni; } }
    float* KT = (float*)(F.ws + WS_KTAB) + (size_t)((l * 64 + g) * 2 + dir) * 16 * 256 + h * 16 + hp;
#pragma unroll
    for (int k = 0; k < 16; ++k) KT[k * 256] = acc[k];
}
template <int NB>
__device__ __forceinline__ void s5_etab_items(Frame& F, int idx0, int stride, int nitems) {
    f32x2 L[NB], B[NB][8]; int im_[NB]; size_t dst[NB]; bool ok[NB];
#pragma unroll
    for (int b = 0; b < NB; ++b) { const int idx = idx0 + b * stride; ok[b] = idx < nitems; const int id = ok[b] ? idx : 0;
        const int k0 = (id & 31) * 8, n = (id >> 5) & 255, g = (id >> 13) & 63, l = id >> 19;
        const int dir = n >> 7, p = n & 63, tt = k0 >> 4, h0 = k0 & 15, e = dir == 0 ? 15 - tt : tt, gi = (l * 2 + dir) * 64 + g; im_[b] = (n >> 6) & 1;
        L[b] = ((const f32x2*)(F.ws + WS_POW))[((size_t)gi * 17 + e) * 64 + p]; const f32x2* BBF = (const f32x2*)(F.ws + WS_BBF) + ((size_t)gi * 64 + p) * 16 + h0;
#pragma unroll
        for (int j = 0; j < 8; ++j) B[b][j] = BBF[j];
        dst[b] = ((size_t)(l * 64 + g) * 256 + n) * 256 + k0; }
#pragma unroll
    for (int b = 0; b < NB; ++b) { float o[8];
#pragma unroll
        for (int j = 0; j < 8; ++j) o[j] = im_[b] ? L[b][0] * B[b][j][1] + L[b][1] * B[b][j][0] : L[b][0] * B[b][j][0] - L[b][1] * B[b][j][1];
        if (ok[b]) *(u32x4*)((bf16_t*)(F.ws + WS_ETAB) + dst[b]) = pack8(o); }
}
template <int NB>
__device__ __forceinline__ void s5_gtab_items(Frame& F, int idx0, int stride, int nitems) {
    f32x2 L[NB][8]; float cr[NB][8], ci[NB][8]; int im_[NB]; size_t dst[NB]; bool ok[NB];
#pragma unroll
    for (int b = 0; b < NB; ++b) { const int idx = idx0 + b * stride; ok[b] = idx < nitems; const int id = ok[b] ? idx : 0;
        const int k8 = id & 31, n = (id >> 5) & 255, g = (id >> 13) & 63, l = id >> 19;
        const int dir = k8 >> 4, comp0 = (k8 & 15) * 8, p0 = comp0 & 63, tt = n >> 4, h = n & 15, e = dir == 0 ? tt + 1 : 16 - tt, gi = (l * 2 + dir) * 64 + g; im_[b] = comp0 >> 6;
        const f32x2* POW = (const f32x2*)(F.ws + WS_POW) + ((size_t)gi * 17 + e) * 64 + p0;
        const float* cre = F.in[I_CRE] + ((size_t)gi * 16 + h) * 64 + p0; const float* cim = F.in[I_CIM] + ((size_t)gi * 16 + h) * 64 + p0;
#pragma unroll
        for (int j = 0; j < 8; ++j) { L[b][j] = POW[j]; cr[b][j] = cre[j]; ci[b][j] = cim[j]; }
        dst[b] = ((size_t)(l * 64 + g) * 256 + n) * 512 + 256 + 8 * k8; }
#pragma unroll
    for (int b = 0; b < NB; ++b) { float o[8];
#pragma unroll
        for (int j = 0; j < 8; ++j) o[j] = im_[b] ? -(cr[b][j] * L[b][j][1] + ci[b][j] * L[b][j][0]) : cr[b][j] * L[b][j][0] - ci[b][j] * L[b][j][1];
        if (ok[b]) *(u32x4*)((bf16_t*)(F.ws + WS_BTAB) + dst[b]) = pack8(o); }
}
template <int NB>
__device__ __forceinline__ void s5_ttab_items(Frame& F, int idx0, int stride, int nitems) {
    float o[NB][8]; size_t dst[NB]; bool ok[NB];
#pragma unroll
    for (int b = 0; b < NB; ++b) { const int idx = idx0 + b * stride; ok[b] = idx < nitems; const int id = ok[b] ? idx : 0;
        const int k0 = (id & 31) * 8, n = (id >> 5) & 255, g = (id >> 13) & 63, l = id >> 19;
        const int tp = k0 >> 4, hp0 = k0 & 15, tt = n >> 4, h = n & 15;
        const float* KT = (const float*)(F.ws + WS_KTAB) + (size_t)(l * 64 + g) * 2 * 16 * 256;
        const bool f = tp <= tt, r = tp >= tt;
        const float* kf = KT + (size_t)(f ? tt - tp : 0) * 256 + h * 16 + hp0; const float* kr = KT + (size_t)(16 + (r ? tp - tt : 0)) * 256 + h * 16 + hp0;
        const float dsk = F.in[I_S5D][l * 1024 + g * 16 + h];
#pragma unroll
        for (int j = 0; j < 8; ++j) o[b][j] = (f ? kf[j] : 0.f) + (r ? kr[j] : 0.f);
        if (tp == tt && (h >> 3) == (hp0 >> 3)) o[b][h & 7] += dsk;
        dst[b] = ((size_t)(l * 64 + g) * 256 + n) * 512 + k0; }
#pragma unroll
    for (int b = 0; b < NB; ++b) if (ok[b]) *(u32x4*)((bf16_t*)(F.ws + WS_BTAB) + dst[b]) = pack8(o[b]);
}
template <int PASS>
__device__ __forceinline__ void s5_scan_task(Frame& F, int l, int task) {
    const int run = task % 33, gd = task / 33, dir = gd & 1, g = gd >> 1, p = F.lane, gi = (l * 2 + dir) * 64 + g;
    const f32x2 L16 = ((const f32x2*)(F.ws + WS_POW))[((size_t)gi * 17 + 16) * 64 + p];
    const float* S = (const float*)(F.ws + WS_S) + (size_t)g * 768 * 256 + dir * 128 + p;
    f32x2* GF = (f32x2*)(F.ws + WS_F) + ((size_t)gd * 33) * 64 + p;
    float sr[16], si[16];
#pragma unroll
    for (int q = 0; q < 16; ++q) { const int s_ = run * 16 + q, c = dir == 0 ? (s_ < 16 ? 512 + s_ : s_ - 16) : 527 - s_; sr[q] = S[(size_t)c * 256]; si[q] = S[(size_t)c * 256 + 64]; }
    float xr = 0.f, xi = 0.f;
    if (PASS == 2) {
        float ar = L16[0], ai = L16[1];
#pragma unroll
        for (int q = 0; q < 4; ++q) { const float nr = ar * ar - ai * ai, ni = 2.f * ar * ai; ar = nr; ai = ni; }
        for (int r = 0; r < run; ++r) { const f32x2 f = GF[(size_t)r * 64]; const float nr = ar * xr - ai * xi + f[0], ni = ar * xi + ai * xr + f[1]; xr = nr; xi = ni; }
    }
    bf16_t* X = (bf16_t*)(F.ws + WS_AP) + (size_t)g * 768 * 512 + 256 + dir * 128 + p;
#pragma unroll
    for (int q = 0; q < 16; ++q) { const int s_ = run * 16 + q, c = dir == 0 ? (s_ < 16 ? 512 + s_ : s_ - 16) : 527 - s_;
        if (PASS == 2) { X[(size_t)c * 512] = (bf16_t)f2bf(xr); X[(size_t)c * 512 + 64] = (bf16_t)f2bf(xi); }
        const float nr = L16[0] * xr - L16[1] * xi + sr[q], ni = L16[0] * xi + L16[1] * xr + si[q]; xr = nr; xi = ni; }
    if (PASS == 1) GF[(size_t)run * 64] = (f32x2){xr, xi};
}

__global__ void __launch_bounds__(NTHR, 2) hyb_fwd(Args args) {
    extern __shared__ __attribute__((aligned(16))) unsigned char lds_raw[];
    Frame F;
    F.lds = (LAS unsigned char*)lds_raw;
    F.tid = threadIdx.x; F.lane = F.tid & 63; F.wave = __builtin_amdgcn_readfirstlane(F.tid >> 6);
    F.G = gridDim.x; { const int bx = blockIdx.x; F.vcu = (F.G % 8 == 0) ? (bx % 8) * (F.G / 8) + bx / 8 : bx; }
    F.gw = F.vcu * NWAVES + F.wave; F.NGW = F.G * NWAVES;
    F.out = (GAS float*)args.out; F.ws = (GAS unsigned char*)args.ws;
    volatile LAS unsigned* MISC = (volatile LAS unsigned*)(F.lds + MISC_OFF);
    for (int u = F.tid; u < (LDS_BYTES - RING_BYTES) / 4; u += NTHR) ((LAS unsigned*)(F.lds + RING_BYTES))[u] = 0u;
    __syncthreads();
    unsigned* ctl = (unsigned*)(F.ws + WS_CTL);
    XcdBarrier bar = xcd_barrier_post(ctl + CW_BAR, MISC + 8);
#define GRID_BAR() do { asm volatile("" : "+s"(bar.bar), "+s"(bar.x)); xcd_barrier(bar); F.tid = opaque_tid(); F.lane = F.tid & 63; asm volatile("" : "+s"(F.ws)); } while (0)
    LAS float* wscr = (LAS float*)(F.lds + F.wave * 16384);

    {
        for (int it = F.gw; it < NL * MOD_SLABS * 48; it += F.NGW) mod_item(F, it);
        for (int it = F.gw * 64 + F.lane; it < NL * 2 * 64 * 64; it += F.NGW * 64) s5_param_item(F, it);
        for (int it = F.gw * 64 + F.lane; it < 128 * 16 + 128 * 32; it += F.NGW * 64) {
            const bool da = it < 128 * 16; const int r = da ? it : it - 128 * 16, nf = da ? 16 : 32, pos = r / nf, i = r % nf;
            const float invf = (float)dexp(-(double)(2 * i) / (double)(2 * nf) * 9.210340371976184);
            const float ang = (float)pos * invf; double s, c; dsincos((double)ang, s, c);
            ((f32x2*)(F.ws + (da ? WS_ROPE_DA : WS_ROPE_GQ)))[r] = (f32x2){(float)c, (float)s};
        }
        if (F.gw < NL) { const int l = F.gw;
            const float a = wave_sum(F.in[I_LQ1][l * 64 + F.lane] * F.in[I_LK1][l * 64 + F.lane]), b = wave_sum(F.in[I_LQ2][l * 64 + F.lane] * F.in[I_LK2][l * 64 + F.lane]);
            const float lam_init = 0.8f - 0.6f * (float)dexp(-0.3 * (double)l);
            if (F.lane == 0) ((float*)(F.ws + WS_LAMV))[l] = (float)(dexp((double)a) - dexp((double)b)) + lam_init; }
    }
    GRID_BAR();
    for (int it = F.gw * 64 + F.lane; it < NL * 2 * 12288; it += F.NGW * 64) { const int j = it % 12288, ls = it / 12288, l = ls >> 1;
        float s = F.in[I_BADA][l * 12288 + j]; const float* P = (const float*)(F.ws + WS_MODP) + (size_t)ls * 12288 + j;
        for (int sl = 0; sl < MOD_SLABS; ++sl) s += P[(size_t)sl * NL * 2 * 12288];
        ((float*)(F.ws + WS_MOD))[it] = s; }
#pragma nounroll
    for (int pass_ = 0; pass_ < 2; ++pass_) {
        if ((pass_ == 0) == ((F.wave & 1) != 0)) {
            for (int it = F.gw * 64 + F.lane; it < NL * 64 * 2 * 256; it += F.NGW * 64) s5_ktab_item(F, it);
            for (int it = F.gw * 64 + F.lane; it < NL * 64 * 256 * 32; it += 4 * F.NGW * 64) { s5_etab_items<4>(F, it, F.NGW * 64, NL * 64 * 256 * 32); s5_gtab_items<4>(F, it, F.NGW * 64, NL * 64 * 256 * 32); }
        } else {
            for (int it = F.gw; it < NL * IT_LAYER; it += F.NGW) convert_item(F, it, wscr);
        }
    }
    GRID_BAR();
    for (int c = F.gw * 64 + F.lane; c < 2 * DM; c += F.NGW * 64) ((float*)(F.ws + WS_IDAFF))[c] = c < DM ? 1.f : 0.f;
#pragma nounroll
    for (int pass_ = 0; pass_ < 2; ++pass_) {
        if ((pass_ == 0) == ((F.wave & 1) != 0)) {
            for (int it = F.gw * 64 + F.lane; it < NL * 64 * 256 * 32; it += 4 * F.NGW * 64) s5_ttab_items<4>(F, it, F.NGW * 64, NL * 64 * 256 * 32);
        } else {
        for (int t = F.gw; t < NT; t += F.NGW) { const bool lat = t < NLAT; const float* md = (const float*)(F.ws + WS_MOD) + (lat ? 0 : 12288);
            const float* xr = lat ? F.in[I_X] + (size_t)t * DM : F.in[I_CTX] + (size_t)(t - NLAT) * DM;
            modulate_row(F.lane, xr, (lat ? (float*)(F.ws + WS_T) : (float*)(F.ws + WS_XRES)) + (size_t)t * DM, (bf16_t*)(F.ws + WS_H) + (size_t)t * DM, (unsigned char*)(F.ws + WS_H8) + (size_t)t * DM, md, md + DM);
            if (lat && F.lane == 0) { f32x2 st = {0.f, 1.f}; *(f32x2*)((float*)(F.ws + WS_STATS) + 2 * t) = st; } }
        }
    }
    GRID_BAR();

    for (int l = 0; l < NL; ++l) {
        GAS unsigned char* wl = F.ws + WS_W + (size_t)l * W_LAYER;
        const bool last = (l == NL - 1);
        const int Mrows = last ? NLAT : NT;
        const float* modl = (const float*)(F.ws + WS_MOD) + (size_t)l * 2 * 12288;
        { int k8_ = DM / 2; asm volatile("" : "+s"(k8_));
          pg8::Gemm g{(const bf16_t*)(F.ws + WS_H8), (const bf16_t*)(wl + W_IN8), NT, 9728, k8_, DM / 2, DM / 2}; pg8::WinOrder S; S.init(NT, 9728, F.G, (int)blockIdx.x);
          pg8::EpiIn E{(bf16_t*)(F.ws + WS_Z), (bf16_t*)(F.ws + WS_AP), 1, 1.f / 64.f};
          pg8::gemm_phase<pg8::EpiIn, pg8::WinOrder, true, true, true>(F.lds, g, S, E); }
        { pg8::Gemm g{(const bf16_t*)(F.ws + WS_H), (const bf16_t*)(wl + W_IN), NT, 2048, DM}; pg8::StaticOrder S; S.init(NT, 2048, F.G, ((int)blockIdx.x + 16) % F.G);
          pg8::EpiIn E{(bf16_t*)(F.ws + WS_Z), (bf16_t*)(F.ws + WS_AP), 0, 1.f};
          pg8::gemm_phase<pg8::EpiIn, pg8::StaticOrder, true, true, false>(F.lds, g, S, E); }
        GRID_BAR();
        for (int t = F.gw; t < NT; t += F.NGW) prep_row(F, l, t);
        for (int t = F.gw; t < 10 * 132 * 4; t += F.NGW) vt8_task(F, t, F.lds + F.wave * 16384);
        { __syncthreads(); int ks_ = 256; asm volatile("" : "+s"(ks_));
          pg8::Gemm g{(const bf16_t*)(F.ws + WS_AP), (const bf16_t*)(F.ws + WS_ETAB) + (size_t)l * 64 * 256 * 256, 64 * 768, 64 * 256, ks_, 512, 256}; pg8::S5Order S; S.init(3, F.G, (int)blockIdx.x);
          pg8::EpiS E{(float*)(F.ws + WS_S)};
          pg8::gemm_phase<pg8::EpiS, pg8::S5Order, true, true>(F.lds, g, S, E); }
        GRID_BAR();
        for (int t = F.gw; t < 128 * 33; t += F.NGW) s5_scan_task<1>(F, l, t);
        {
            const bf16_t* Z = (const bf16_t*)(F.ws + WS_Z);
#define GQ_UNIT(FAST_) att::attn_dense_body<true, FAST_>((const bf16_t*)((const unsigned char*)(F.ws + WS_QB8) + qrow * 1024 + h * 128), (const bf16_t*)((const unsigned char*)(F.ws + WS_KB8) + krow * 256 + (h >> 2) * 128), \
                (const bf16_t*)((const unsigned char*)(F.ws + WS_VB8T) + ((size_t)(h >> 2) * 132 + (krow >> 6)) * 8192), (bf16_t*)(F.ws + WS_APB) + ((size_t)NT + qrow) * 1024 + h * 128, 1024, seq, 0, 1.f, 8.f, (char*)lds_raw)
#define DA_UNIT(FAST_) att::attn_dense_body<false, FAST_>((const bf16_t*)((const unsigned char*)(F.ws + WS_QKA8) + qrow * 2048 + hs * 64), (const bf16_t*)((const unsigned char*)(F.ws + WS_QKA8) + krow * 2048 + 1024 + hs * 64), \
                (const bf16_t*)((const unsigned char*)(F.ws + WS_VA8T) + ((size_t)(hs >> 1) * 132 + (krow >> 6)) * 8192), (bf16_t*)(F.ws + WS_ODA) + qrow * DM + hs * 128, DM, seq, 0, 1.f, 8.f, (char*)lds_raw)
            unsigned redo = 0u, bit = 1u;
            for (int u = (int)blockIdx.x; u < 256 + (last ? 0 : 24); u += F.G, bit <<= 1) { if (u >= 256 && u < 272) continue;
                const bool cx = u >= 256; const int h = cx ? u - 272 : u >> 5, seq = cx ? NCTX : NT; const size_t qrow = cx ? (size_t)NLAT : (size_t)(u & 31) * 256, krow = cx ? (size_t)NLAT : 0;
                if (GQ_UNIT(true)) redo |= bit;
                __syncthreads();
            }
            bit = 1u << 8;
            for (int u = (int)blockIdx.x; u < 512 + (last ? 0 : 16); u += F.G, bit <<= 1) {
                const bool cx = u >= 512; const int hs = cx ? u - 512 : u >> 5, seq = cx ? NCTX : NT; const size_t qrow = cx ? (size_t)NLAT : (size_t)(u & 31) * 256, krow = cx ? (size_t)NLAT : 0;
                if (DA_UNIT(true)) redo |= bit;
                __syncthreads();
            }
            if (redo & 0xffu) { bit = 1u;
                for (int u = (int)blockIdx.x; u < 256 + (last ? 0 : 24); u += F.G, bit <<= 1) { if (!(redo & bit)) continue;
                    const bool cx = u >= 256; const int h = cx ? u - 272 : u >> 5, seq = cx ? NCTX : NT; const size_t qrow = cx ? (size_t)NLAT : (size_t)(u & 31) * 256, krow = cx ? (size_t)NLAT : 0;
                    GQ_UNIT(false); __syncthreads(); } }
            if (redo >> 8) { bit = 1u << 8;
                for (int u = (int)blockIdx.x; u < 512 + (last ? 0 : 16); u += F.G, bit <<= 1) { if (!(redo & bit)) continue;
                    const bool cx = u >= 512; const int hs = cx ? u - 512 : u >> 5, seq = cx ? NCTX : NT; const size_t qrow = cx ? (size_t)NLAT : (size_t)(u & 31) * 256, krow = cx ? (size_t)NLAT : 0;
                    DA_UNIT(false); __syncthreads(); } }
#undef GQ_UNIT
#undef DA_UNIT
        }
        GRID_BAR();
        { const float lam = ((const float*)(F.ws + WS_LAMV))[l]; const float lam_init = 0.8f - 0.6f * __expf(-0.3f * (float)l);
          for (int t = F.gw; t < 128 * 33; t += F.NGW) s5_scan_task<2>(F, l, t);
          for (int t = F.gw; t < Mrows; t += F.NGW) da_combine_row(F, l, t, lam, 1.f - lam_init); }
        GRID_BAR();
        { pg8::Gemm g{(const bf16_t*)(F.ws + WS_APB), (const bf16_t*)(wl + W_PAB), 2 * NT, 4096, 1024}; pg8::PairOrder S; S.init(Mrows / 256, F.G, (int)blockIdx.x);
          pg8::EpiGate E{(const bf16_t*)(F.ws + WS_Z), (bf16_t*)(F.ws + WS_PG)};
          pg8::gemm_phase<pg8::EpiGate, pg8::PairOrder, true, true>(F.lds, g, S, E); }
        {
          int ky_ = 512; asm volatile("" : "+s"(ky_));
          pg8::Gemm g{(const bf16_t*)(F.ws + WS_AP), (const bf16_t*)(F.ws + WS_BTAB) + (size_t)l * 64 * 256 * 512, 64 * 768, 64 * 256, ky_, 512, 512}; pg8::S5Order S;
          S.init(last ? 2 : 3, F.G, (!last && F.G == 256) ? (int)blockIdx.x - 16 : (int)blockIdx.x);
          pg8::EpiY E{(bf16_t*)(F.ws + WS_AGLU), last ? 512 : 528};
          pg8::gemm_phase<pg8::EpiY, pg8::S5Order, true, true>(F.lds, g, S, E); }
        GRID_BAR();
        { pg8::Gemm g{(const bf16_t*)(F.ws + WS_AGLU), (const bf16_t*)(wl + W_GLU), Mrows, 4096, 1024}; pg8::StaticOrder S; S.init(Mrows, 4096, F.G, (int)blockIdx.x);
          pg8::EpiGlu E{(const bf16_t*)(F.ws + WS_Z), (const bf16_t*)(F.ws + WS_PG), (bf16_t*)(F.ws + WS_MRG)};
          pg8::gemm_phase<pg8::EpiGlu, pg8::StaticOrder, true, true>(F.lds, g, S, E); }
        GRID_BAR();
        { pg8::Gemm g{(const bf16_t*)(F.ws + WS_MRG), (const bf16_t*)(wl + W_O), Mrows, DM, DM}; pg8::ResSplitOrder S; S.init(DM, F.G, (int)blockIdx.x, !last, SPLIT_O, (DM / 64) / SPLIT_O);
          const float* pg_ = l == 0 ? (const float*)(F.ws + WS_IDAFF) : F.in[I_LNFG] + (l - 1) * DM; const float* pb_ = l == 0 ? (const float*)(F.ws + WS_IDAFF) + DM : F.in[I_LNFB] + (l - 1) * DM;
          pg8::EpiRes E{(const float*)(F.ws + WS_STATS), pg_, pb_, (float*)(F.ws + WS_T), modl + 2 * DM, modl + 12288 + 2 * DM, (float*)(F.ws + WS_SLAB)};
          pg8::gemm_phase<pg8::EpiRes, pg8::ResSplitOrder, true, true>(F.lds, g, S, E); }
        GRID_BAR();
        {
        for (int t = F.gw; t < NLAT; t += F.NGW)
            ln_row(F.lane, (const float*)(F.ws + WS_T) + (size_t)t * DM, (float*)nullptr, (bf16_t*)(F.ws + WS_H) + (size_t)t * DM,
                   F.in[I_LNMG] + l * DM, F.in[I_LNMB] + l * DM, modl + 3 * DM, modl + 4 * DM, (unsigned char*)nullptr, (float*)(F.ws + WS_STATS) + 2 * t);
        if (!last) for (int r = (int)blockIdx.x; r < NCTX; r += F.G) { const float* md = modl + 12288;
            ln_ctx_row(F, r, (const float*)(F.ws + WS_SLAB), SPLIT_O, md + 2 * DM, F.in[I_LNMG] + l * DM, F.in[I_LNMB] + l * DM, md + 3 * DM, md + 4 * DM, false); }
        }
        GRID_BAR();
        { pg8::Gemm g{(const bf16_t*)(F.ws + WS_H), (const bf16_t*)(wl + W_GU), Mrows, 2 * FF, DM}; pg8::StaticOrder S; S.init(Mrows, 2 * FF, F.G, (int)blockIdx.x);
          pg8::EpiSwi E{(bf16_t*)(F.ws + WS_ACT)};
          pg8::gemm_phase<pg8::EpiSwi, pg8::StaticOrder, true, true>(F.lds, g, S, E); }
        GRID_BAR();
        { pg8::Gemm g{(const bf16_t*)(F.ws + WS_ACT), (const bf16_t*)(wl + W_DN), Mrows, DM, FF}; pg8::ResSplitOrder S; S.init(DM, F.G, (int)blockIdx.x, !last, SPLIT_D, (FF / 64) / SPLIT_D);
          pg8::EpiRes E{(const float*)(F.ws + WS_STATS), F.in[I_LNMG] + l * DM, F.in[I_LNMB] + l * DM, (float*)(F.ws + WS_T), modl + 5 * DM, modl + 12288 + 5 * DM, (float*)(F.ws + WS_SLAB)};
          pg8::gemm_phase<pg8::EpiRes, pg8::ResSplitOrder, true, true>(F.lds, g, S, E); }
        GRID_BAR();
        {
        for (int t = F.gw; t < NLAT; t += F.NGW) { const float* mdn = modl + 2 * 12288;
            float* dst = last ? (float*)(F.out + (size_t)t * DM) : (float*)nullptr;
            ln_row(F.lane, (const float*)(F.ws + WS_T) + (size_t)t * DM, dst, last ? (bf16_t*)nullptr : (bf16_t*)(F.ws + WS_H) + (size_t)t * DM,
                   F.in[I_LNFG] + l * DM, F.in[I_LNFB] + l * DM, mdn, mdn + DM, last ? (unsigned char*)nullptr : (unsigned char*)(F.ws + WS_H8) + (size_t)t * DM, (float*)(F.ws + WS_STATS) + 2 * t); }
        if (!last) for (int r = (int)blockIdx.x; r < NCTX; r += F.G) { const float* mdn = modl + 3 * 12288;
            ln_ctx_row(F, r, (const float*)(F.ws + WS_SLAB), SPLIT_D, modl + 12288 + 5 * DM, F.in[I_LNFG] + l * DM, F.in[I_LNFB] + l * DM, mdn, mdn + DM, true); }
        }
        if (!last) GRID_BAR();
    }
}

extern "C" void kernel_launch(void* const* d_in, const int* in_sizes, int n_in, void* d_out, int out_size, void* d_ws, size_t ws_size, hipStream_t stream) {
    static int grid = 0;
    if (grid == 0) {
        if (n_in != 33 || out_size != NLAT * DM || ws_size < WS_END) { fprintf(stderr, "kernel_launch: built for 33 inputs, out %d, ws >= %zu; got n_in %d out %d ws %zu\n", NLAT * DM, (size_t)WS_END, n_in, out_size, ws_size); grid = -1; return; }
        int dev = 0, cus = 0;
        if (hipGetDevice(&dev) != hipSuccess || hipDeviceGetAttribute(&cus, hipDeviceAttributeMultiprocessorCount, dev) != hipSuccess) { grid = -1; return; }
        if (hipFuncSetAttribute((const void*)hyb_fwd, hipFuncAttributeMaxDynamicSharedMemorySize, LDS_BYTES) != hipSuccess) { fprintf(stderr, "kernel_launch: hipFuncSetAttribute failed\n"); grid = -1; return; }
        int per_cu = 0;
        if (hipOccupancyMaxActiveBlocksPerMultiprocessor(&per_cu, (const void*)hyb_fwd, NTHR, LDS_BYTES) != hipSuccess || per_cu < 1) { fprintf(stderr, "kernel_launch: occupancy query says %d\n", per_cu); }
        (void)hipGetLastError();
        grid = cus;
    }
    if (grid < 0) return;
    (void)hipMemsetAsync((char*)d_ws + WS_CTL, 0, CTL_ZERO_BYTES, stream);
    Args a{};
    for (int i = 0; i < 33; ++i) a.in[i] = (const float*)d_in[i];
    a.out = (float*)d_out; a.ws = (unsigned char*)d_ws;
    hipLaunchKernelGGL(hyb_fwd, dim3(grid), dim3(NTHR), LDS_BYTES, stream, a);
}
```

```cpp
#include <hip/hip_runtime.h>
#include <cstdio>
#include <cstdint>

#define LAS __attribute__((address_space(3)))
#define GAS __attribute__((address_space(1)))
typedef unsigned short bf16_t;
typedef short bf16x8 __attribute__((ext_vector_type(8)));
typedef short s16x4 __attribute__((ext_vector_type(4)));
typedef float f32x4 __attribute__((ext_vector_type(4)));
typedef float f32x2 __attribute__((ext_vector_type(2)));
typedef float f32x16 __attribute__((ext_vector_type(16)));
typedef unsigned u32x4 __attribute__((ext_vector_type(4)));
typedef unsigned u32x2 __attribute__((ext_vector_type(2)));

constexpr int NT = 8448, NLAT = 8192, NCTX = 256, DM = 2048, NIN = 11776, FF = 5632, NL = 4;
constexpr int C_QA = 0, C_KA = 1024, C_VA = 2048, C_QB = 3072, C_KB = 4096, C_VB = 4352, C_U = 4608, C_G = 5632;
constexpr float DN_ALPHA = 1.6817928305074290f;
constexpr int NWAVES = 8, NTHR = 512;
constexpr int MOD_SLABS = 32;

constexpr size_t al256(size_t x) { return (x + 255) & ~(size_t)255; }
constexpr size_t WS_CTL = 0, CTL_ZERO_BYTES = 1u << 20;
constexpr size_t WS_MODP = CTL_ZERO_BYTES;
constexpr size_t WS_MOD = WS_MODP + al256((size_t)MOD_SLABS * NL * 2 * 12288 * 4);
constexpr size_t WS_LAMV = WS_MOD + al256((size_t)NL * 2 * 12288 * 4);
constexpr size_t WS_ROPE_DA = WS_LAMV + 256;
constexpr size_t WS_ROPE_GQ = WS_ROPE_DA + 128 * 16 * 8;
constexpr size_t WS_LAM = WS_ROPE_GQ + 128 * 32 * 8;
constexpr size_t WS_BB = WS_LAM + (size_t)NL * 2 * 64 * 64 * 16;
constexpr size_t WS_CC = WS_BB + (size_t)NL * 2 * 64 * 128 * 16 * 2;
constexpr size_t WS_F = WS_CC + (size_t)NL * 64 * 16 * 256 * 2;
constexpr size_t WS_W = al256(WS_F + (size_t)2 * 66 * 64 * 64 * 8);
__host__ __device__ constexpr bool win_tile_fp8(int pt) { return !((pt >= 8 && pt < 12) || (pt >= 18 && pt < 22)); }
__host__ __device__ constexpr int win_tile_slot(int pt) { return pt < 8 ? pt : pt < 12 ? pt - 8 : pt < 18 ? pt - 4 : pt < 22 ? pt - 14 : pt - 8; }
__host__ __device__ constexpr int win_fp8_tile(int j) { return j < 8 ? j : j < 14 ? j + 4 : j + 8; }
__host__ __device__ constexpr int win_bf16_tile(int j) { return j < 4 ? j + 8 : j + 14; }
constexpr size_t W_IN = 0;
constexpr size_t W_PAB = W_IN + (size_t)2048 * DM * 2;
constexpr size_t W_GLU = W_PAB + (size_t)4096 * 1024 * 2;
constexpr size_t W_O = W_GLU + (size_t)4096 * 1024 * 2;
constexpr size_t W_GU = W_O + (size_t)DM * DM * 2;
constexpr size_t W_DN = W_GU + (size_t)2 * FF * DM * 2;
constexpr size_t W_IN8 = W_DN + (size_t)DM * FF * 2;
constexpr size_t W_LAYER = W_IN8 + (size_t)9728 * DM;
constexpr size_t WS_XRES = al256(WS_W + NL * W_LAYER);
constexpr size_t WS_H = WS_XRES + (size_t)NT * DM * 4;
constexpr size_t WS_Z = WS_H + (size_t)NT * DM * 2;
constexpr size_t WS_ODA = WS_Z + (size_t)NT * NIN * 2;
constexpr size_t WS_APB = WS_ODA + (size_t)NT * DM * 2;
constexpr size_t WS_AGLU = WS_APB + (size_t)2 * NT * 1024 * 2;
constexpr size_t WS_PG = WS_AGLU + (size_t)NT * 1024 * 2;
constexpr size_t WS_MRG = WS_PG + (size_t)2 * NT * DM * 2;
constexpr size_t WS_T = WS_MRG + (size_t)NT * DM * 2;
constexpr size_t WS_ACT = WS_T + (size_t)NT * DM * 4;
constexpr size_t WS_SLAB = WS_ACT + (size_t)NT * FF * 2;
constexpr int SPLIT_O = 16, SPLIT_D = 22;
constexpr size_t WS_POW = WS_SLAB + (size_t)SPLIT_D * NCTX * DM * 4;
constexpr size_t WS_BBF = WS_POW + (size_t)NL * 2 * 64 * 17 * 64 * 8;
constexpr size_t WS_KTAB = WS_BBF + (size_t)NL * 2 * 64 * 64 * 16 * 8;
constexpr size_t WS_ETAB = WS_KTAB + (size_t)NL * 64 * 2 * 16 * 256 * 4;
constexpr size_t WS_BTAB = WS_ETAB + (size_t)NL * 64 * 256 * 256 * 2;
constexpr size_t WS_AP = WS_BTAB + (size_t)NL * 64 * 256 * 512 * 2;
constexpr size_t WS_S = WS_AP + (size_t)64 * 768 * 512 * 2;
constexpr size_t WS_H8 = WS_S + (size_t)64 * 768 * 256 * 4;
constexpr size_t WS_QB8 = WS_H8 + (size_t)NT * DM;
constexpr size_t WS_KB8 = WS_QB8 + (size_t)NT * 1024;
constexpr size_t WS_QKA8 = WS_KB8 + (size_t)NT * 256;
constexpr size_t WS_VB8T = WS_QKA8 + (size_t)NT * 2048;
constexpr size_t WS_VA8T = WS_VB8T + (size_t)2 * 132 * 128 * 64;
constexpr size_t WS_STATS = WS_VA8T + (size_t)8 * 132 * 128 * 64;
constexpr size_t WS_IDAFF = WS_STATS + (size_t)NLAT * 8;
constexpr size_t WS_END = WS_IDAFF + (size_t)2 * DM * 4;

constexpr int CW_TMO = 0, CW_BAR = 4096;

__device__ __forceinline__ unsigned f2bf(float f) { unsigned u = __builtin_bit_cast(unsigned, f); return (u + 0x7fffu + ((u >> 16) & 1u)) >> 16; }
__device__ __forceinline__ unsigned pk2(float lo, float hi) { return f2bf(lo) | (f2bf(hi) << 16); }
typedef float f32x2_ __attribute__((ext_vector_type(2))); typedef __bf16 bf16x2_ __attribute__((ext_vector_type(2)));
__device__ __forceinline__ unsigned cvt_pk_bf16(float lo, float hi) { const f32x2_ v = {lo, hi}; return __builtin_bit_cast(unsigned, __builtin_convertvector(v, bf16x2_)); }
__device__ __forceinline__ float bflo(unsigned w) { return __builtin_bit_cast(float, w << 16); }
__device__ __forceinline__ float bfhi(unsigned w) { return __builtin_bit_cast(float, w & 0xffff0000u); }
__device__ __forceinline__ void unpack8(u32x4 w, float (&f)[8]) { f[0] = bflo(w.x); f[1] = bfhi(w.x); f[2] = bflo(w.y); f[3] = bfhi(w.y); f[4] = bflo(w.z); f[5] = bfhi(w.z); f[6] = bflo(w.w); f[7] = bfhi(w.w); }
__device__ __forceinline__ u32x4 pack8(const float (&f)[8]) { u32x4 w; w.x = cvt_pk_bf16(f[0], f[1]); w.y = cvt_pk_bf16(f[2], f[3]); w.z = cvt_pk_bf16(f[4], f[5]); w.w = cvt_pk_bf16(f[6], f[7]); return w; }
__device__ __forceinline__ unsigned pk4_fp8(float a, float b, float c, float d) { int w = __builtin_amdgcn_cvt_pk_fp8_f32(a, b, 0, false); w = __builtin_amdgcn_cvt_pk_fp8_f32(c, d, w, true); return (unsigned)w; }
__device__ __forceinline__ float sigmoidf_(float x) { return __builtin_amdgcn_rcpf(1.f + __builtin_amdgcn_exp2f(-1.4426950408889634f * x)); }
__device__ __forceinline__ float siluf_(float x) { return x * sigmoidf_(x); }
__device__ __forceinline__ float gelu_tanh(float x) { const float z = 0.7978845608028654f * (x + 0.044715f * x * x * x); return x * sigmoidf_(2.f * z); }
__device__ __forceinline__ float wave_sum(float v) {
#pragma unroll
    for (int o = 1; o < 64; o <<= 1) v += __shfl_xor(v, o);
    return v;
}
__device__ __forceinline__ int opaque_tid() { int t = threadIdx.x; asm volatile("" : "+v"(t)); return t; }
#define LDS_WAIT() asm volatile("s_waitcnt lgkmcnt(0)" ::: "memory")
#define VM_WAIT() asm volatile("s_waitcnt vmcnt(0)" ::: "memory")

__device__ __forceinline__ void dsincos(double x, double& s, double& c) {
    const double inv2pi = 0.15915494309189533577, twopi = 6.283185307179586476925;
    double r = x * inv2pi; r = r - __builtin_rint(r); r *= twopi;
    double sg = 1.0;
    if (r > 1.5707963267948966) { r = 3.141592653589793 - r; sg = -1.0; } else if (r < -1.5707963267948966) { r = -3.141592653589793 - r; sg = -1.0; }
    const double r2 = r * r;
    double ss = 1.0, cc = 1.0, ts = 1.0, tc = 1.0;
#pragma unroll
    for (int k = 1; k <= 12; ++k) { tc *= -r2 / (double)((2 * k - 1) * (2 * k)); ts *= -r2 / (double)((2 * k) * (2 * k + 1)); cc += tc; ss += ts; }
    s = ss * r; c = sg * cc;
}
__device__ __forceinline__ double dexp(double x) {
    const double n = __builtin_rint(x * 1.4426950408889634);
    const double r = x - n * 0.6931471805599453094;
    double t = 1.0, sum = 1.0;
#pragma unroll
    for (int k = 1; k <= 14; ++k) { t *= r / (double)k; sum += t; }
    return __builtin_ldexp(sum, (int)n);
}

namespace pg8 {
constexpr int BM = 256, BK = 64, HALF = 128, HTB = HALF * BK * 2, STAGE_BYTES = 8 * HTB, NXCD = 8, WGM = 8;
__host__ __device__ __forceinline__ int lds_byte(int r, int c) { const int st = (r >> 4) * 2 + (c >> 5), rr = r & 15, cc = c & 31, ob = rr * 64 + cc * 2; return st * 1024 + (ob ^ (((ob >> 9) & 1) << 5)); }
__host__ __device__ __forceinline__ void stage_rc(int b, int& R, int& C) { const int st = b / 1024, sb = b % 1024, swz = sb ^ (((sb >> 9) & 1) << 5); R = (st >> 1) * 16 + swz / 64; C = (st & 1) * 32 + (swz % 64) / 2; }
__host__ __device__ __forceinline__ int perm32(int rho) { const int n = rho >> 4, i = rho & 15; return 8 * (i >> 2) + 4 * n + (i & 3); }
struct Unit { int pm, pn, kt0, nt; };
struct Gemm { const bf16_t* A; const bf16_t* Bt; int M, N, K, lda, ldb; };
struct StaticOrder {
    int nM, nN, nwg, G, c;
    __host__ __device__ void init(int M, int N, int G_, int c_) { nM = M / BM; nN = N / BM; nwg = nM * nN; G = G_; c = c_; }
    __host__ __device__ bool next(int i, Unit& u) const { const long L = (long)i * G + c; if (L >= nwg) return false; unit((int)L, u); return true; }
    __host__ __device__ void unit(int L, Unit& u) const {
        int wgid = L; { const int q = nwg / NXCD, r = nwg % NXCD, xcd = wgid % NXCD, off = wgid / NXCD; wgid = (xcd < r ? xcd * (q + 1) : r * (q + 1) + (xcd - r) * q) + off; }
        const int nig = WGM * nN, gid = wgid / nig, fm = gid * WGM, gsz = (nM - fm) < WGM ? (nM - fm) : WGM;
        u.pm = fm + ((wgid % nig) % gsz); u.pn = (wgid % nig) / gsz; u.kt0 = 0; u.nt = 0;
    }
    __device__ __forceinline__ void a_ready(const Unit&) const {}
    __device__ __forceinline__ void done(const Unit&) const {}
};
struct WinOrder {
    StaticOrder b;
    __host__ __device__ void init(int M, int N, int G_, int c_) { b.init(M, N, G_, c_); }
    __host__ __device__ bool next(int i, Unit& u) const {
        if (b.G != 256) return b.next(i, u);
        const int c = b.c; int L;
        if (i < 3) L = i * 256 + c;
        else if (i == 3) { if (c >= 240 && c < 248) return false; L = 768 + c; }
        else if (i == 4) { if (c < 230) L = 1024 + c; else if (c < 238) L = 768 + c + 10; else return false; }
        else return false;
        b.unit(L, u); return true;
    }
    __device__ __forceinline__ void a_ready(const Unit&) const {}
    __device__ __forceinline__ void done(const Unit&) const {}
};
struct PairOrder {
    int nM, nwg, G, c;
    __host__ __device__ void init(int nM_, int G_, int c_) { nM = nM_; nwg = 2 * nM_ * 8; G = G_; c = c_; }
    __host__ __device__ bool next(int i, Unit& u) const {
        if (nM == 33 && G == 256) {
            if (i < 2) { const int L = i * 256 + c, which = L >> 8, r = L & 255; u.pm = 33 * which + (r & 31); u.pn = 8 * which + (r >> 5); u.kt0 = 0; u.nt = 0; return true; }
            if (i == 2 && c < 16) { const int which = c >> 3; u.pm = 33 * which + 32; u.pn = 8 * which + (c & 7); u.kt0 = 0; u.nt = 0; return true; }
            return false;
        }
        const long L = (long)i * G + c; if (L >= nwg) return false;
        const int per = nM * 8, which = (int)L / per, r = (int)L % per;
        u.pm = 33 * which + (r % nM); u.pn = 8 * which + (r / nM); u.kt0 = 0; u.nt = 0; return true;
    }
    __device__ __forceinline__ void a_ready(const Unit&) const {}
    __device__ __forceinline__ void done(const Unit&) const {}
};

struct ResSplitOrder {
    StaticOrder lat; int G, c, S, ntS; bool ctx;
    __host__ __device__ void init(int N, int G_, int c_, bool ctx_, int S_, int ntS_) { lat.init(8192, N, G_, c_); G = G_; c = c_; ctx = ctx_; S = S_; ntS = ntS_; }
    __host__ __device__ bool next(int i, Unit& u) const {
        const long L = (long)i * G + c;
        if (L < lat.nwg) return lat.next(i, u);
        const int j = (int)(L - lat.nwg); if (!ctx || j >= 8 * S) return false;
        u.pm = 32; u.pn = j & 7; u.kt0 = (j >> 3) * ntS; u.nt = ntS; return true;
    }
    __device__ __forceinline__ void a_ready(const Unit&) const {}
    __device__ __forceinline__ void done(const Unit&) const {}
};
struct S5Order {
    int nmt, G, c;
    __host__ __device__ void init(int nmt_, int G_, int c_) { nmt = nmt_; G = G_; c = c_; }
    __host__ __device__ bool next(int i, Unit& u) const {
        const long L = (long)i * G + c; if (c < 0 || L >= 64 * nmt) return false;
        const int g = (int)L / nmt, mt = (int)L % nmt; u.pm = 3 * g + mt; u.pn = g; u.kt0 = 0; u.nt = 0; return true;
    }
    __device__ __forceinline__ void a_ready(const Unit&) const {}
    __device__ __forceinline__ void done(const Unit&) const {}
};
template <class Epi, class Sched, bool ALIGN_EPI = false, bool SP2 = false, bool FP8 = false>
__device__ __forceinline__ void gemm_phase(LAS unsigned char* lds, const Gemm g, const Sched& S, const Epi& E) {
    const int tid = opaque_tid(), wid = __builtin_amdgcn_readfirstlane(tid >> 6), lane = tid & 63, wr = wid >> 2, wc = wid & 3, fr = lane & 15, fq = lane >> 4;
    const int K = g.K, nt = K / BK, lda = g.lda ? g.lda : K, ldb = g.ldb ? g.ldb : K;
    unsigned voffA[2], voffB[2];
#pragma unroll
    for (int i = 0; i < 2; ++i) { int R, C; stage_rc(tid * 16 + i * 8192, R, C); const int Rb = Epi::PERM ? ((R & ~31) + perm32(R & 31)) : R;
        voffA[i] = (unsigned)(R * lda + C) * 2u; voffB[i] = (unsigned)(Rb * ldb + C) * 2u; }
    const size_t kstep = (size_t)(BK * 2);
    const size_t hstepA = (size_t)HALF * lda * 2, hstepB = (size_t)HALF * ldb * 2;
    const size_t tstepA = 2 * hstepA, tstepB = 2 * hstepB;
    const unsigned ldsw = (unsigned)wid * 1024u;
    const int aoff = lds_byte(wr * 64 + fr, fq * 8), boff = lds_byte(wc * 32 + fr, fq * 8);
#define PG8_SA(b, h) (((b) * 2 + (h)) * HTB)
#define PG8_SB(b, h) ((4 + (b) * 2 + (h)) * HTB)
#define PG8_STAGE(bufoff, gbase, voff) do { _Pragma("unroll") for (int _i = 0; _i < 2; ++_i) \
        __builtin_amdgcn_global_load_lds((const unsigned*)((const char*)(gbase) + (voff)[_i]), (LAS unsigned*)(lds + (bufoff) + ldsw + _i * 8192), 16, 0, 0); } while (0)
    typedef int v8i_ __attribute__((ext_vector_type(8))); typedef int v4i_ __attribute__((ext_vector_type(4)));
#define PG8_LDA(dst, b, h) do { _Pragma("unroll") for (int m = 0; m < 4; ++m) { const v4i_ lo_ = *(const LAS v4i_*)(lds + PG8_SA(b, h) + aoff + m * 2048), hi_ = *(const LAS v4i_*)(lds + PG8_SA(b, h) + aoff + m * 2048 + 1024); \
        dst[m] = __builtin_shufflevector(lo_, hi_, 0, 1, 2, 3, 4, 5, 6, 7); } } while (0)
#define PG8_LDB(dst, b, h) do { _Pragma("unroll") for (int n = 0; n < 2; ++n) { const v4i_ lo_ = *(const LAS v4i_*)(lds + PG8_SB(b, h) + boff + n * 2048), hi_ = *(const LAS v4i_*)(lds + PG8_SB(b, h) + boff + n * 2048 + 1024); \
        dst[n] = __builtin_shufflevector(lo_, hi_, 0, 1, 2, 3, 4, 5, 6, 7); } } while (0)
#define PG8_HALF(v, k) __builtin_bit_cast(bf16x8, (k) == 0 ? __builtin_shufflevector(v, v, 0, 1, 2, 3) : __builtin_shufflevector(v, v, 4, 5, 6, 7))
#define PG8_MMA(ai, bj, At, Bt) do { __builtin_amdgcn_s_setprio(1); _Pragma("unroll") for (int m = 0; m < 4; ++m) _Pragma("unroll") for (int n = 0; n < 2; ++n) { \
        if constexpr (FP8) asm volatile("v_mfma_scale_f32_16x16x128_f8f6f4 %0, %1, %2, %0, %3, %3 op_sel_hi:[0,0,0]" : "+v"(acc[ai][bj][m][n]) : "v"(Bt[n]), "v"(At[m]), "v"(one_scale));   \
        else { acc[ai][bj][m][n] = __builtin_amdgcn_mfma_f32_16x16x32_bf16(PG8_HALF(Bt[n], 0), PG8_HALF(At[m], 0), acc[ai][bj][m][n], 0, 0, 0); \
               acc[ai][bj][m][n] = __builtin_amdgcn_mfma_f32_16x16x32_bf16(PG8_HALF(Bt[n], 1), PG8_HALF(At[m], 1), acc[ai][bj][m][n], 0, 0, 0); } } \
        __builtin_amdgcn_s_setprio(0); } while (0)
#define PG8_WAIT_V(n) asm volatile("s_waitcnt vmcnt(" #n ")" ::: "memory")
#define PG8_WAIT_L(n) asm volatile("s_waitcnt lgkmcnt(" #n ")" ::: "memory")
#define PG8_BAR __builtin_amdgcn_s_barrier()
#define PG8_SCHED __builtin_amdgcn_sched_barrier(0)
    Unit cur, nxt; int ui = 0;
    if (!S.next(0, cur)) return;
    f32x4 acc[2][2][4][2];
#pragma unroll
    for (int a = 0; a < 2; ++a)
#pragma unroll
        for (int b = 0; b < 2; ++b)
#pragma unroll
            for (int m = 0; m < 4; ++m)
#pragma unroll
                for (int n = 0; n < 2; ++n) acc[a][b][m][n] = (f32x4){0.f, 0.f, 0.f, 0.f};
    v8i_ At[4], B0[2], B1[2]; const int one_scale = 0x7f7f7f7f; (void)one_scale;
    const char* cA = (const char*)g.A + (size_t)cur.pm * tstepA + (size_t)cur.kt0 * kstep; const char* cB = (const char*)g.Bt + (size_t)cur.pn * tstepB + (size_t)cur.kt0 * kstep;
    S.a_ready(cur);
    if constexpr (SP2) {
        PG8_STAGE(PG8_SB(0, 0), cB, voffB); PG8_STAGE(PG8_SB(0, 1), cB + hstepB, voffB); PG8_STAGE(PG8_SA(0, 0), cA, voffA); PG8_STAGE(PG8_SA(0, 1), cA + hstepA, voffA);
        if (wr == 1) PG8_BAR;
        PG8_WAIT_V(2); PG8_BAR;
        PG8_STAGE(PG8_SB(1, 0), cB + kstep, voffB); PG8_STAGE(PG8_SA(1, 0), cA + kstep, voffA); PG8_STAGE(PG8_SB(1, 1), cB + hstepB + kstep, voffB);
        PG8_WAIT_V(6); PG8_BAR;
    } else {
        PG8_STAGE(PG8_SB(0, 0), cB, voffB); PG8_STAGE(PG8_SA(0, 0), cA, voffA); PG8_STAGE(PG8_SB(0, 1), cB + hstepB, voffB); PG8_STAGE(PG8_SA(0, 1), cA + hstepA, voffA);
        if (wr == 1) PG8_BAR;
        PG8_WAIT_V(4); PG8_BAR;
        PG8_STAGE(PG8_SB(1, 0), cB + kstep, voffB); PG8_STAGE(PG8_SA(1, 0), cA + kstep, voffA); PG8_STAGE(PG8_SB(1, 1), cB + hstepB + kstep, voffB);
        PG8_WAIT_V(6); PG8_BAR;
    }
    for (;;) {
        const bool has_next = S.next(ui + 1, nxt);
        const char* nA = has_next ? (const char*)g.A + (size_t)nxt.pm * tstepA + (size_t)nxt.kt0 * kstep : cA; const char* nB = has_next ? (const char*)g.Bt + (size_t)nxt.pn * tstepB + (size_t)nxt.kt0 * kstep : cB;
        const int ntu = cur.nt ? cur.nt : nt;
        for (int t = 0; t < ntu; t += 2) {
            const bool last = (t == ntu - 2);
            const char* a1 = cA + (size_t)(t + 1) * kstep;
            const char* a2 = last ? nA : cA + (size_t)(t + 2) * kstep; const char* b2 = last ? nB : cB + (size_t)(t + 2) * kstep;
            const char* a3 = a2 + kstep; const char* b3 = b2 + kstep;
            if (last && has_next) S.a_ready(nxt);
            if constexpr (SP2) {
            PG8_LDB(B0, 0, 0); PG8_LDB(B1, 0, 1); PG8_SCHED; PG8_LDA(At, 0, 0); PG8_STAGE(PG8_SA(1, 1), a1 + hstepA, voffA);
            PG8_WAIT_V(8); PG8_WAIT_L(0); PG8_BAR; PG8_MMA(0, 0, At, B0); PG8_MMA(0, 1, At, B1); PG8_BAR; PG8_SCHED;
            PG8_LDA(At, 0, 1); PG8_STAGE(PG8_SB(0, 0), b2, voffB); PG8_STAGE(PG8_SB(0, 1), b2 + hstepB, voffB); PG8_STAGE(PG8_SA(0, 0), a2, voffA);
            PG8_WAIT_V(8); PG8_WAIT_L(0); PG8_BAR; PG8_MMA(1, 0, At, B0); PG8_MMA(1, 1, At, B1); PG8_BAR; PG8_SCHED;
            PG8_LDB(B0, 1, 0); PG8_LDB(B1, 1, 1); PG8_SCHED; PG8_LDA(At, 1, 0); PG8_STAGE(PG8_SA(0, 1), a2 + hstepA, voffA);
            PG8_WAIT_V(8); PG8_WAIT_L(0); PG8_BAR; PG8_MMA(0, 0, At, B0); PG8_MMA(0, 1, At, B1); PG8_BAR; PG8_SCHED;
            PG8_LDA(At, 1, 1); PG8_STAGE(PG8_SB(1, 0), b3, voffB); PG8_STAGE(PG8_SB(1, 1), b3 + hstepB, voffB); PG8_STAGE(PG8_SA(1, 0), a3, voffA);
            PG8_WAIT_V(8); PG8_WAIT_L(0); PG8_BAR; PG8_MMA(1, 0, At, B0); PG8_MMA(1, 1, At, B1); PG8_BAR; PG8_SCHED;
            } else {
            PG8_LDB(B0, 0, 0); PG8_SCHED; PG8_LDA(At, 0, 0); PG8_STAGE(PG8_SA(1, 1), a1 + hstepA, voffA);
            PG8_WAIT_L(8); PG8_BAR; PG8_WAIT_L(0); PG8_MMA(0, 0, At, B0); PG8_BAR; PG8_SCHED;
            PG8_LDB(B1, 0, 1); PG8_STAGE(PG8_SB(0, 0), b2, voffB);
            PG8_BAR; PG8_WAIT_L(0); PG8_MMA(0, 1, At, B1); PG8_BAR;
            PG8_LDA(At, 0, 1); PG8_STAGE(PG8_SA(0, 0), a2, voffA);
            PG8_BAR; PG8_WAIT_L(0); PG8_MMA(1, 0, At, B0); PG8_BAR; PG8_SCHED;
            PG8_STAGE(PG8_SB(0, 1), b2 + hstepB, voffB);
            PG8_WAIT_V(6); PG8_BAR; PG8_MMA(1, 1, At, B1); PG8_BAR;
            PG8_LDB(B0, 1, 0); PG8_SCHED; PG8_LDA(At, 1, 0); PG8_STAGE(PG8_SA(0, 1), a2 + hstepA, voffA);
            PG8_WAIT_L(8); PG8_BAR; PG8_WAIT_L(0); PG8_MMA(0, 0, At, B0); PG8_BAR; PG8_SCHED;
            PG8_LDB(B1, 1, 1); PG8_STAGE(PG8_SB(1, 0), b3, voffB);
            PG8_BAR; PG8_WAIT_L(0); PG8_MMA(0, 1, At, B1); PG8_BAR;
            PG8_LDA(At, 1, 1); PG8_STAGE(PG8_SA(1, 0), a3, voffA);
            PG8_BAR; PG8_WAIT_L(0); PG8_MMA(1, 0, At, B0); PG8_BAR; PG8_SCHED;
            PG8_STAGE(PG8_SB(1, 1), b3 + hstepB, voffB);
            PG8_WAIT_V(6); PG8_BAR; PG8_MMA(1, 1, At, B1); PG8_BAR;
            }
        }
        if constexpr (FP8) asm volatile("s_nop 15\n\ts_nop 15" ::: "memory");
        if constexpr (ALIGN_EPI) { if (wr == 0) PG8_BAR; }
        E(acc, cur, wr, wc, fr, fq); S.done(cur);
        if (!has_next) break;
#pragma unroll
        for (int a = 0; a < 2; ++a)
#pragma unroll
            for (int b = 0; b < 2; ++b)
#pragma unroll
                for (int m = 0; m < 4; ++m)
#pragma unroll
                    for (int n = 0; n < 2; ++n) acc[a][b][m][n] = (f32x4){0.f, 0.f, 0.f, 0.f};
        cur = nxt; cA = nA; cB = nB; ++ui;
        if constexpr (ALIGN_EPI) { if (wr == 1) PG8_BAR; }
    }
    PG8_WAIT_V(0);
    if constexpr (!ALIGN_EPI) { if (wr == 0) PG8_BAR; }
    PG8_BAR;
#undef PG8_SA
#undef PG8_SB
#undef PG8_STAGE
#undef PG8_LDA
#undef PG8_LDB
#undef PG8_MMA
#undef PG8_WAIT_V
#undef PG8_WAIT_L
#undef PG8_BAR
#undef PG8_SCHED
}

typedef f32x4 Acc[2][2][4][2];
struct EpiIn {
    static constexpr bool PERM = true;
    bf16_t* Z; bf16_t* AP; int f8; float scale;
    __device__ __forceinline__ void operator()(const Acc& acc, const Unit& u, int wr, int wc, int fr, int fq) const {
        const int pt = f8 ? win_fp8_tile(u.pn) : win_bf16_tile(u.pn), row0 = u.pm * BM + wr * 64 + fr, col0 = pt * BM + wc * 32 + 8 * fq; const bool sg = pt >= 22, s5 = pt >= 18 && pt < 22;
#pragma unroll
        for (int ai = 0; ai < 2; ++ai)
#pragma unroll
            for (int m = 0; m < 4; ++m) { const int row = row0 + ai * HALF + m * 16; bf16_t* rowp = Z + (size_t)row * NIN + col0;
#pragma unroll
                for (int bj = 0; bj < 2; ++bj) { f32x4 v0 = acc[ai][bj][m][0], v1 = acc[ai][bj][m][1];
                    if (sg) {
#pragma unroll
                        for (int j = 0; j < 4; ++j) { v0[j] = sigmoidf_(v0[j] * scale); v1[j] = sigmoidf_(v1[j] * scale); } }
                    else { v0 *= scale; v1 *= scale; }
                    u32x4 w; w.x = cvt_pk_bf16(v0[0], v0[1]); w.y = cvt_pk_bf16(v0[2], v0[3]); w.z = cvt_pk_bf16(v1[0], v1[1]); w.w = cvt_pk_bf16(v1[2], v1[3]);
                    if (s5) { const int cu = col0 + bj * HALF - C_U, g = cu >> 4, h0 = cu & 15;
                        *(u32x4*)(AP + ((size_t)(g * 768 + (row >> 4)) * 512 + (row & 15) * 16 + h0)) = w; }
                    else *(u32x4*)(rowp + bj * HALF) = w; } }
    }
};
struct EpiS {
    static constexpr bool PERM = true;
    float* S;
    __device__ __forceinline__ void operator()(const Acc& acc, const Unit& u, int wr, int wc, int fr, int fq) const {
        const int row0 = u.pm * BM + wr * 64 + fr, col0 = wc * 32 + 8 * fq;
#pragma unroll
        for (int ai = 0; ai < 2; ++ai)
#pragma unroll
            for (int m = 0; m < 4; ++m) { float* p = S + (size_t)(row0 + ai * HALF + m * 16) * 256 + col0;
#pragma unroll
                for (int bj = 0; bj < 2; ++bj) { *(f32x4*)(p + bj * HALF) = acc[ai][bj][m][0]; *(f32x4*)(p + bj * HALF + 4) = acc[ai][bj][m][1]; } }
    }
};
struct EpiY {
    static constexpr bool PERM = true;
    bf16_t* AG; int nchunk;
    __device__ __forceinline__ void operator()(const Acc& acc, const Unit& u, int wr, int wc, int fr, int fq) const {
        const int g = u.pn, c0 = (u.pm - 3 * g) * BM + wr * 64 + fr, n0 = wc * 32 + 8 * fq;
#pragma unroll
        for (int ai = 0; ai < 2; ++ai)
#pragma unroll
            for (int m = 0; m < 4; ++m) { const int c = c0 + ai * HALF + m * 16;
                if (c < nchunk) {
#pragma unroll
                    for (int bj = 0; bj < 2; ++bj) { const int n = n0 + bj * HALF, tt = n >> 4, h0 = n & 15; const f32x4 v0 = acc[ai][bj][m][0], v1 = acc[ai][bj][m][1];
                        u32x4 w; w.x = cvt_pk_bf16(gelu_tanh(v0[0]), gelu_tanh(v0[1])); w.y = cvt_pk_bf16(gelu_tanh(v0[2]), gelu_tanh(v0[3]));
                        w.z = cvt_pk_bf16(gelu_tanh(v1[0]), gelu_tanh(v1[1])); w.w = cvt_pk_bf16(gelu_tanh(v1[2]), gelu_tanh(v1[3]));
                        *(u32x4*)(AG + (size_t)(16 * c + tt) * 1024 + g * 16 + h0) = w; } } }
    }
};
struct EpiGate {
    static constexpr bool PERM = true;
    const bf16_t* Z; bf16_t* PG;
    __device__ __forceinline__ void operator()(const Acc& acc, const Unit& u, int wr, int wc, int fr, int fq) const {
        const int which = u.pm >= 33 ? 1 : 0, pm = u.pm - 33 * which, pn = u.pn - 8 * which;
        const int row0 = pm * BM + wr * 64 + fr, col0 = pn * BM + wc * 32 + 8 * fq;
        const bf16_t* gz = Z + C_G + which * DM + col0; bf16_t* out = PG + (size_t)which * NT * DM + col0;
#pragma unroll
        for (int ai = 0; ai < 2; ++ai)
#pragma unroll
            for (int m = 0; m < 4; ++m) { const size_t row = (size_t)(row0 + ai * HALF + m * 16);
#pragma unroll
                for (int bj = 0; bj < 2; ++bj) { float gt[8]; unpack8(*(const u32x4*)(gz + row * NIN + bj * HALF), gt);
                    const f32x4 v0 = acc[ai][bj][m][0], v1 = acc[ai][bj][m][1];
                    u32x4 w; w.x = cvt_pk_bf16(v0[0] * gt[0], v0[1] * gt[1]); w.y = cvt_pk_bf16(v0[2] * gt[2], v0[3] * gt[3]); w.z = cvt_pk_bf16(v1[0] * gt[4], v1[1] * gt[5]); w.w = cvt_pk_bf16(v1[2] * gt[6], v1[3] * gt[7]);
                    *(u32x4*)(out + row * DM + bj * HALF) = w; } }
    }
};
struct EpiGlu {
    static constexpr bool PERM = true;
    const bf16_t* Z; const bf16_t* PG; bf16_t* MRG;
    __device__ __forceinline__ void operator()(const Acc& acc, const Unit& u, int wr, int wc, int fr, int fq) const {
        const int row0 = u.pm * BM + wr * 64 + fr, mc0 = u.pn * HALF + wc * 32 + 8 * fq;
#pragma unroll
        for (int ai = 0; ai < 2; ++ai)
#pragma unroll
            for (int m = 0; m < 4; ++m) { const size_t row = (size_t)(row0 + ai * HALF + m * 16);
                float g2[8], pa[8], pb[8], o[8];
                unpack8(*(const u32x4*)(Z + row * NIN + C_G + 2 * DM + mc0), g2);
                unpack8(*(const u32x4*)(PG + row * DM + mc0), pa);
                unpack8(*(const u32x4*)(PG + (size_t)NT * DM + row * DM + mc0), pb);
                const f32x4 a0 = acc[ai][0][m][0], a1 = acc[ai][0][m][1], q0 = acc[ai][1][m][0], q1 = acc[ai][1][m][1];
#pragma unroll
                for (int j = 0; j < 4; ++j) { o[j] = pa[j] + pb[j] + g2[j] * a0[j] * sigmoidf_(q0[j]); o[4 + j] = pa[4 + j] + pb[4 + j] + g2[4 + j] * a1[j] * sigmoidf_(q1[j]); }
                *(u32x4*)(MRG + row * DM + mc0) = pack8(o); }
    }
};
struct EpiRes {
    static constexpr bool PERM = true;
    const float* ST; const float* lg; const float* lb; float* T; const float* gv_lat; const float* gv_ctx; float* SLAB;
    __device__ __forceinline__ void operator()(const Acc& acc, const Unit& u, int wr, int wc, int fr, int fq) const {
        const int row0 = u.pm * BM + wr * 64 + fr, col0 = u.pn * BM + wc * 32 + 8 * fq;
        if (u.nt != 0) {
            float* sl = SLAB + ((size_t)(u.kt0 / u.nt) * NCTX + (row0 - NLAT)) * DM + col0;
#pragma unroll
            for (int ai = 0; ai < 2; ++ai)
#pragma unroll
                for (int m = 0; m < 4; ++m) { const size_t off = (size_t)(ai * HALF + m * 16) * DM;
#pragma unroll
                    for (int bj = 0; bj < 2; ++bj) { *(f32x4*)(sl + off + bj * HALF) = acc[ai][bj][m][0]; *(f32x4*)(sl + off + bj * HALF + 4) = acc[ai][bj][m][1]; } }
            return;
        }
        const float* gv = (u.pm == 32 ? gv_ctx : gv_lat) + col0;
#pragma unroll
        for (int bj = 0; bj < 2; ++bj) {
            const f32x4 g0 = *(const f32x4*)(gv + bj * HALF), g1 = *(const f32x4*)(gv + bj * HALF + 4);
            const f32x4 a0 = *(const f32x4*)(lg + col0 + bj * HALF) * DN_ALPHA, a1 = *(const f32x4*)(lg + col0 + bj * HALF + 4) * DN_ALPHA;
            const f32x4 b0 = *(const f32x4*)(lb + col0 + bj * HALF) * DN_ALPHA, b1 = *(const f32x4*)(lb + col0 + bj * HALF + 4) * DN_ALPHA;
#pragma unroll
            for (int ai = 0; ai < 2; ++ai)
#pragma unroll
                for (int m = 0; m < 4; ++m) { const int row = row0 + ai * HALF + m * 16; const size_t off = (size_t)row * DM + col0 + bj * HALF;
                    const f32x2 st = *(const f32x2*)(ST + 2 * row);
                    const f32x4 x0 = *(const f32x4*)(T + off), x1 = *(const f32x4*)(T + off + 4);
                    *(f32x4*)(T + off) = ((x0 - st[0]) * st[1]) * a0 + b0 + g0 * acc[ai][bj][m][0];
                    *(f32x4*)(T + off + 4) = ((x1 - st[0]) * st[1]) * a1 + b1 + g1 * acc[ai][bj][m][1]; } }
    }
};
struct EpiSwi {
    static constexpr bool PERM = true;
    bf16_t* ACT;
    __device__ __forceinline__ void operator()(const Acc& acc, const Unit& u, int wr, int wc, int fr, int fq) const {
        const int row0 = u.pm * BM + wr * 64 + fr, c0 = u.pn * HALF + wc * 32 + 8 * fq;
#pragma unroll
        for (int ai = 0; ai < 2; ++ai)
#pragma unroll
            for (int m = 0; m < 4; ++m) { const size_t row = (size_t)(row0 + ai * HALF + m * 16);
                const f32x4 a0 = acc[ai][0][m][0], a1 = acc[ai][0][m][1], q0 = acc[ai][1][m][0], q1 = acc[ai][1][m][1]; float o[8];
#pragma unroll
                for (int j = 0; j < 4; ++j) { o[j] = siluf_(a0[j]) * q0[j]; o[4 + j] = siluf_(a1[j]) * q1[j]; }
                *(u32x4*)(ACT + row * FF + c0) = pack8(o); }
    }
};
}

namespace att {
constexpr int NW = 8, QBLK = 32, KVBLK = 64;
constexpr int LDQK = NIN;
constexpr size_t SHM_V = KVBLK * 128 * 2, SHM_K = KVBLK * 128 * 2, SHM_ATTN = 2 * SHM_V + 2 * SHM_K + NW * 64 * 4;
#define KSWZ(row, colB) ((row) * 256 + ((colB) ^ (((row) & 7) << 4)))
#define SBAR() __builtin_amdgcn_sched_barrier(0)
__device__ __forceinline__ int crow(int r, int hi) { return (r & 3) + 8 * (r >> 2) + 4 * hi; }
__device__ __forceinline__ unsigned cvtpk(float lo, float hi) { return cvt_pk_bf16(lo, hi); }

__device__ __forceinline__ float max3f(float a, float b, float c) { return __builtin_fmaxf(__builtin_fmaxf(a, b), c); }
template <bool FIRST>
__device__ __forceinline__ void partialSM(f32x16& p0, f32x16& p1, float& m_reg, f32x16& nb, float& alpha, const float thr) {
  float pmax;
  { float a0 = max3f(p0[0], p0[1], p0[2]), a1 = max3f(p0[3], p0[4], p0[5]), a2 = max3f(p0[6], p0[7], p0[8]), a3 = max3f(p0[9], p0[10], p0[11]);
    float a4 = max3f(p0[12], p0[13], p0[14]), a5 = max3f(p0[15], p1[0], p1[1]), a6 = max3f(p1[2], p1[3], p1[4]), a7 = max3f(p1[5], p1[6], p1[7]);
    float a8 = max3f(p1[8], p1[9], p1[10]), a9 = max3f(p1[11], p1[12], p1[13]);
    a0 = max3f(a0, a1, a2); a3 = max3f(a3, a4, a5); a6 = max3f(a6, a7, a8); a9 = max3f(a9, p1[14], p1[15]);
    a0 = max3f(a0, a3, a6); pmax = fmaxf(a0, a9); }
  { auto rr = __builtin_amdgcn_permlane32_swap(__float_as_uint(pmax), __float_as_uint(pmax), false, false);
    pmax = fmaxf(__uint_as_float(rr[0]), __uint_as_float(rr[1])); }
  if (!FIRST && __builtin_expect(__all(pmax <= thr), 1)) { alpha = 1.f; }
  else { const float d = FIRST ? pmax : fmaxf(pmax, 0.f); alpha = FIRST ? 1.f : __builtin_amdgcn_exp2f(-d); m_reg += d;
#pragma unroll
    for (int r = 0; r < 16; ++r) { p0[r] -= d; p1[r] -= d; nb[r] = -m_reg; }
    asm volatile("" : "+v"(nb)); }
#pragma unroll
  for (int r = 0; r < 16; ++r) p0[r] = __builtin_amdgcn_exp2f(p0[r]);
}
template <bool PACK = true>
__device__ __forceinline__ void finishSM(f32x16& p0, f32x16& p1, float alpha, float& l_reg, bf16x8& pa0, bf16x8& pa1, bf16x8& pa2, bf16x8& pa3) {
#pragma unroll
  for (int r = 0; r < 16; ++r) p1[r] = __builtin_amdgcn_exp2f(p1[r]);
  float ps = 0;
#pragma unroll
  for (int r = 0; r < 16; ++r) ps += p0[r];
#pragma unroll
  for (int r = 0; r < 16; ++r) ps += p1[r];
  { auto rr = __builtin_amdgcn_permlane32_swap(__float_as_uint(ps), __float_as_uint(ps), false, false);
    ps = __uint_as_float(rr[0]) + __uint_as_float(rr[1]); }
  l_reg = l_reg * alpha + ps;
#define PK4(P, BASE, OUT) do { u32x4 w = {cvtpk(P[BASE + 0], P[BASE + 1]), cvtpk(P[BASE + 2], P[BASE + 3]), cvtpk(P[BASE + 4], P[BASE + 5]), cvtpk(P[BASE + 6], P[BASE + 7])}; \
    OUT = *reinterpret_cast<bf16x8*>(&w); } while (0)
  if constexpr (PACK) { PK4(p0, 0, pa0); PK4(p0, 8, pa1); PK4(p1, 0, pa2); PK4(p1, 8, pa3); }
#undef PK4
}
__device__ __forceinline__ float rowmax32(const f32x16& p0, const f32x16& p1) {
  float a0 = max3f(p0[0], p0[1], p0[2]), a1 = max3f(p0[3], p0[4], p0[5]), a2 = max3f(p0[6], p0[7], p0[8]), a3 = max3f(p0[9], p0[10], p0[11]);
  float a4 = max3f(p0[12], p0[13], p0[14]), a5 = max3f(p0[15], p1[0], p1[1]), a6 = max3f(p1[2], p1[3], p1[4]), a7 = max3f(p1[5], p1[6], p1[7]);
  float a8 = max3f(p1[8], p1[9], p1[10]), a9 = max3f(p1[11], p1[12], p1[13]);
  a0 = max3f(a0, a1, a2); a3 = max3f(a3, a4, a5); a6 = max3f(a6, a7, a8); a9 = max3f(a9, p1[14], p1[15]);
  a0 = max3f(a0, a3, a6); float pmax = fmaxf(a0, a9);
  auto rr = __builtin_amdgcn_permlane32_swap(__float_as_uint(pmax), __float_as_uint(pmax), false, false);
  return fmaxf(__uint_as_float(rr[0]), __uint_as_float(rr[1]));
}
__device__ __forceinline__ void packP(const f32x16& p0, const f32x16& p1, bf16x8& pa0, bf16x8& pa1, bf16x8& pa2, bf16x8& pa3) {
#define PK4(P, BASE, OUT) do { u32x4 w = {cvtpk(P[BASE + 0], P[BASE + 1]), cvtpk(P[BASE + 2], P[BASE + 3]), cvtpk(P[BASE + 4], P[BASE + 5]), cvtpk(P[BASE + 6], P[BASE + 7])}; \
    OUT = *reinterpret_cast<bf16x8*>(&w); } while (0)
  PK4(p0, 0, pa0); PK4(p0, 8, pa1); PK4(p1, 0, pa2); PK4(p1, 8, pa3);
#undef PK4
}
constexpr float PS_BIG = 4096.f;
__device__ __forceinline__ void halfexp(f32x16& p0) {
#pragma unroll
  for (int r = 0; r < 16; ++r) p0[r] = __builtin_amdgcn_exp2f(p0[r]);
}
template <bool PACK = true>
__device__ __forceinline__ void finishFast(f32x16& p0, f32x16& p1, float& l_reg, float& psmax, bf16x8& pa0, bf16x8& pa1, bf16x8& pa2, bf16x8& pa3) {
  float dummy = 0.f; finishSM<PACK>(p0, p1, 0.f, dummy, pa0, pa1, pa2, pa3);
  l_reg += dummy; psmax = fmaxf(psmax, dummy);
}
typedef int v8i_att __attribute__((ext_vector_type(8)));
typedef int v4i_att __attribute__((ext_vector_type(4)));
__device__ __forceinline__ void packP8(const f32x16& p0, const f32x16& p1, v8i_att& p8) {
#pragma unroll
  for (int w = 0; w < 4; ++w) { p8[w] = (int)pk4_fp8(p0[4 * w], p0[4 * w + 1], p0[4 * w + 2], p0[4 * w + 3]); p8[4 + w] = (int)pk4_fp8(p1[4 * w], p1[4 * w + 1], p1[4 * w + 2], p1[4 * w + 3]); }
}
template <int D0> __device__ __forceinline__ void pv8_one(f32x16& od, const char* Vs, const v8i_att& p8, int r32, int hi) {
  const char* p = Vs + (D0 * 32 + r32) * 80 + 32 * hi;
  const v4i_att a = *reinterpret_cast<const v4i_att*>(p), b = *reinterpret_cast<const v4i_att*>(p + 16);
  od = __builtin_amdgcn_mfma_scale_f32_32x32x64_f8f6f4(p8, __builtin_shufflevector(a, b, 0, 1, 2, 3, 4, 5, 6, 7), od, 0, 0, 0, 0x7f7f7f7f, 0, 0x7f7f7f7f);
}
__device__ __forceinline__ void pv8(f32x16* o, const char* Vs, const v8i_att& p8, int r32, int hi) {
  pv8_one<0>(o[0], Vs, p8, r32, hi); pv8_one<1>(o[1], Vs, p8, r32, hi); pv8_one<2>(o[2], Vs, p8, r32, hi); pv8_one<3>(o[3], Vs, p8, r32, hi);
}
template <bool FULL>
__device__ __forceinline__ void qkt(f32x16& p0, f32x16& p1, const char* Ks, const bf16x8* qr, int r32, int hi, int kd0) {
  p0 = f32x16{}; p1 = f32x16{};
#pragma unroll
  for (int d0 = 0; d0 < (FULL ? 8 : 4); ++d0) { int cb = ((kd0 + d0) * 16 + hi * 8) * 2;
    bf16x8 b0 = *reinterpret_cast<const bf16x8*>(Ks + KSWZ(r32, cb));
    bf16x8 b1 = *reinterpret_cast<const bf16x8*>(Ks + KSWZ(32 + r32, cb));
    p0 = __builtin_amdgcn_mfma_f32_32x32x16_bf16(b0, qr[d0], p0, 0, 0, 0);
    p1 = __builtin_amdgcn_mfma_f32_32x32x16_bf16(b1, qr[d0], p1, 0, 0, 0); }
}
constexpr int QSC8 = 0x7c7c7c7c;
__device__ __forceinline__ void qkt8(f32x16& p0, f32x16& p1, const f32x16& nb, const char* Ks, const v8i_att* q8, int r32, int hi) {
#pragma unroll
  for (int s_ = 0; s_ < 2; ++s_) { const char* k0p = Ks + r32 * 144 + 64 * s_ + 32 * hi; const char* k1p = k0p + 32 * 144;
    const v4i_att a0 = *reinterpret_cast<const v4i_att*>(k0p), a1 = *reinterpret_cast<const v4i_att*>(k0p + 16), b0 = *reinterpret_cast<const v4i_att*>(k1p), b1 = *reinterpret_cast<const v4i_att*>(k1p + 16);
    p0 = __builtin_amdgcn_mfma_scale_f32_32x32x64_f8f6f4(__builtin_shufflevector(a0, a1, 0, 1, 2, 3, 4, 5, 6, 7), q8[s_], s_ == 0 ? nb : p0, 0, 0, 0, 0x7f7f7f7f, 0, QSC8);
    p1 = __builtin_amdgcn_mfma_scale_f32_32x32x64_f8f6f4(__builtin_shufflevector(b0, b1, 0, 1, 2, 3, 4, 5, 6, 7), q8[s_], s_ == 0 ? nb : p1, 0, 0, 0, 0x7f7f7f7f, 0, QSC8); }
}
__device__ __forceinline__ void qkt8d(f32x16& p0, f32x16& p1, const f32x16& nb, const char* Ks, const v8i_att& q8, int r32, int hi) {
  const char* k0p = Ks + r32 * 80 + 32 * hi; const char* k1p = k0p + 32 * 80;
  const v4i_att a0 = *reinterpret_cast<const v4i_att*>(k0p), a1 = *reinterpret_cast<const v4i_att*>(k0p + 16), b0 = *reinterpret_cast<const v4i_att*>(k1p), b1 = *reinterpret_cast<const v4i_att*>(k1p + 16);
  p0 = __builtin_amdgcn_mfma_scale_f32_32x32x64_f8f6f4(__builtin_shufflevector(a0, a1, 0, 1, 2, 3, 4, 5, 6, 7), q8, nb, 0, 0, 0, 0x7f7f7f7f, 0, QSC8);
  p1 = __builtin_amdgcn_mfma_scale_f32_32x32x64_f8f6f4(__builtin_shufflevector(b0, b1, 0, 1, 2, 3, 4, 5, 6, 7), q8, nb, 0, 0, 0, 0x7f7f7f7f, 0, QSC8);
}
__device__ __forceinline__ int v_st(int k, int c) { const int kk = k; return ((kk >> 3) * 4 + (c >> 5)) * 512 + ((kk & 7) * 32 + (c & 31)) * 2; }
__device__ __forceinline__ int v_rd_base(int lane) { return ((lane & 3) << 3) | (((lane >> 2) & 3) << 6) | (((lane >> 4) & 1) << 5) | (((lane >> 5) & 1) << 8); }
constexpr int v_rd_off(int d0, int ks, int half) { return d0 * 512 + ks * 4096 + half * 2048; }
template <int OFF> __device__ __forceinline__ s16x4 tr_read(int vb) {
  s16x4 r; asm volatile("ds_read_b64_tr_b16 %0, %1 offset:%2" : "=&v"(r) : "v"(vb), "i"(OFF) : "memory"); return r;
}
template <int D0> __device__ __forceinline__ void pv_one(f32x16& od, int vb, bf16x8 pa0, bf16x8 pa1, bf16x8 pa2, bf16x8 pa3) {
  const s16x4 l0 = tr_read<v_rd_off(D0, 0, 0)>(vb), h0 = tr_read<v_rd_off(D0, 0, 1)>(vb), l1 = tr_read<v_rd_off(D0, 1, 0)>(vb), h1 = tr_read<v_rd_off(D0, 1, 1)>(vb);
  const s16x4 l2 = tr_read<v_rd_off(D0, 2, 0)>(vb), h2 = tr_read<v_rd_off(D0, 2, 1)>(vb), l3 = tr_read<v_rd_off(D0, 3, 0)>(vb), h3 = tr_read<v_rd_off(D0, 3, 1)>(vb);
  asm volatile("s_waitcnt lgkmcnt(0)" ::: "memory"); SBAR();
#define PK(L, H) (bf16x8){L[0], L[1], L[2], L[3], H[0], H[1], H[2], H[3]}
  od = __builtin_amdgcn_mfma_f32_32x32x16_bf16(pa0, PK(l0, h0), od, 0, 0, 0);
  od = __builtin_amdgcn_mfma_f32_32x32x16_bf16(pa1, PK(l1, h1), od, 0, 0, 0);
  od = __builtin_amdgcn_mfma_f32_32x32x16_bf16(pa2, PK(l2, h2), od, 0, 0, 0);
  od = __builtin_amdgcn_mfma_f32_32x32x16_bf16(pa3, PK(l3, h3), od, 0, 0, 0);
#undef PK
}
__device__ __forceinline__ void pv_d0(f32x16* o, int vb, bf16x8 pa0, bf16x8 pa1, bf16x8 pa2, bf16x8 pa3) {
  pv_one<0>(o[0], vb, pa0, pa1, pa2, pa3); pv_one<1>(o[1], vb, pa0, pa1, pa2, pa3); pv_one<2>(o[2], vb, pa0, pa1, pa2, pa3); pv_one<3>(o[3], vb, pa0, pa1, pa2, pa3);
}


template <bool FULL, bool FAST>
__device__ __forceinline__ bool attn_dense_body(const bf16_t* __restrict__ Qb, const bf16_t* __restrict__ Kh, const bf16_t* __restrict__ Vh,
                                                bf16_t* __restrict__ Ob, const int ldo, const int seq, const int kd0, const float C, const float thr_s, char* lds) {
  const int tid = opaque_tid(), wid = tid >> 6, lane = tid & 63, r32 = lane & 31, hi = lane >> 5;
  char* V_lds = lds; char* K_lds = lds + 2 * SHM_V;
  float* ws = (float*)(lds + 2 * SHM_V + 2 * SHM_K) + wid * 64; float* li_l = ws; float* al_l = ws + 32;
  float m_reg = 0.f, l_reg = 0, psmax = 0.f; f32x16 o[4] = {}; f32x16 nb = {}; v8i_att q8[2]; (void)psmax; (void)l_reg;
  f32x16 lacc = {};
  if constexpr (FULL) {
    const char* Q8w = (const char*)Qb + (long)(wid * QBLK + r32) * 1024 + 32 * hi;
#pragma unroll
    for (int s_ = 0; s_ < 2; ++s_) { const v4i_att x0 = *reinterpret_cast<const v4i_att*>(Q8w + 64 * s_), x1 = *reinterpret_cast<const v4i_att*>(Q8w + 64 * s_ + 16); q8[s_] = __builtin_shufflevector(x0, x1, 0, 1, 2, 3, 4, 5, 6, 7); }
  } else {
    const char* Q8w = (const char*)Qb + (long)(wid * QBLK + r32) * 2048 + 32 * hi;
    const v4i_att x0 = *reinterpret_cast<const v4i_att*>(Q8w), x1 = *reinterpret_cast<const v4i_att*>(Q8w + 16); q8[0] = __builtin_shufflevector(x0, x1, 0, 1, 2, 3, 4, 5, 6, 7);
  }
  const int sr = tid >> 4, sc = (tid & 15) * 8, vst0 = v_st(sr, sc), vst1 = v_st(32 + sr, sc);
  const int vb0 = (int)(uintptr_t)V_lds + v_rd_base(lane);
  constexpr int SDEPTH = 1;
  struct { bf16x8 vs0, vs1, ks0; } sr_[SDEPTH]; u32x2 kd8 = {0u, 0u}; v8i_att p8 = {}; (void)p8;
  const unsigned goff0 = (unsigned)(sr * LDQK + sc) * 2u, goff1 = goff0 + 32u * LDQK * 2u;
  const unsigned goffk = (unsigned)((tid >> 3) * LDQK + (tid & 7) * 8) * 2u;
#define SLOAD(i, k0) do { sr_[i].vs0 = *reinterpret_cast<const bf16x8*>((const char*)Vh + (size_t)((k0) >> 6) * 8192 + tid * 16); \
    if constexpr (FULL) sr_[i].ks0 = *reinterpret_cast<const bf16x8*>((const char*)Kh + (size_t)((k0) + (tid >> 3)) * 256 + (tid & 7) * 16); \
    else kd8 = *reinterpret_cast<const u32x2*>((const char*)Kh + (size_t)((k0) + (tid >> 3)) * 2048 + (tid & 7) * 8); } while (0)
#define SWRITE(b, i) do { *(bf16x8*)(V_lds + (b) * SHM_V + (tid >> 2) * 80 + (tid & 3) * 16) = sr_[i].vs0; \
    if constexpr (FULL) *(bf16x8*)(K_lds + (b) * SHM_K + (tid >> 3) * 144 + (tid & 7) * 16) = sr_[i].ks0; \
    else *(u32x2*)(K_lds + (b) * SHM_K + (tid >> 3) * 80 + (tid & 7) * 8) = kd8; } while (0)
#define PV(b) do { pv8(o, V_lds + (b) * SHM_V, p8, r32, hi); } while (0)
#define QKT(P0, P1, KS) do { if constexpr (FULL) qkt8(P0, P1, nb, KS, q8, r32, hi); else qkt8d(P0, P1, nb, KS, q8[0], r32, hi); } while (0)
#define SWAIT() do { if constexpr (SDEPTH == 2) asm volatile("s_waitcnt vmcnt(4)" ::: "memory"); else asm volatile("s_waitcnt vmcnt(0)" ::: "memory"); } while (0)
#define RESC(a) do { if constexpr (!FAST) if (__any((a) < 1.f)) { if (hi == 0) al_l[r32] = (a); asm volatile("s_waitcnt lgkmcnt(0)" ::: "memory"); \
    _Pragma("unroll") for (int d = 0; d < 4; ++d) _Pragma("unroll") for (int r = 0; r < 16; ++r) o[d][r] *= al_l[crow(r, hi)]; } } while (0)
#define PSM(P0, P1, AL) do { if constexpr (FAST) halfexp(P0); else partialSM<false>(P0, P1, m_reg, nb, AL, thr_s); } while (0)
#define FSM(P0, P1, AL) do { if constexpr (FAST) finishFast<false>(P0, P1, l_reg, psmax, pa0, pa1, pa2, pa3); else finishSM<false>(P0, P1, AL, l_reg, pa0, pa1, pa2, pa3); \
    packP8(P0, P1, p8); } while (0)
  f32x16 pA0, pA1, pB0, pB1; float alA = 1.f, alB = 1.f; bf16x8 pa0, pa1, pa2, pa3; const int NT_ = seq / KVBLK; (void)C;
  constexpr int SE = 0, SO = SDEPTH - 1;
  if constexpr (FAST) {
    constexpr bool LM = !FULL;
    v8i_att ones8 = {0x38383838, 0x38383838, 0x38383838, 0x38383838, 0x38383838, 0x38383838, 0x38383838, 0x38383838}; if constexpr (LM) asm volatile("" : "+v"(ones8));
    float psA = 0.f, psB = 0.f; (void)psA; (void)psB;
#define SOFTQ(N0, N1, PSN, q) do { _Pragma("unroll") for (int r = 0; r < 8; ++r) { if constexpr ((q) < 2) { N0[8 * (q) + r] = __builtin_amdgcn_exp2f(N0[8 * (q) + r]); if constexpr (!LM) PSN += N0[8 * (q) + r]; } \
      else { N1[8 * ((q) - 2) + r] = __builtin_amdgcn_exp2f(N1[8 * ((q) - 2) + r]); if constexpr (!LM) PSN += N1[8 * ((q) - 2) + r]; } } } while (0)
#define PVQ(b, D) do { pv8_one<D>(o[D], V_lds + (b) * SHM_V, p8, r32, hi); } while (0)
#define LSUM() do { if constexpr (LM) lacc = __builtin_amdgcn_mfma_scale_f32_32x32x64_f8f6f4(p8, ones8, lacc, 0, 0, 0, 0x7f7f7f7f, 0, 0x7f7f7f7f); } while (0)
#define PVS(b, N0, N1, PSN) do { if constexpr (!LM) PSN = 0.f; LSUM(); SOFTQ(N0, N1, PSN, 0); PVQ(b, 0); SOFTQ(N0, N1, PSN, 1); PVQ(b, 1); SOFTQ(N0, N1, PSN, 2); PVQ(b, 2); SOFTQ(N0, N1, PSN, 3); PVQ(b, 3); } while (0)
#define FIN(P0, P1, PS) do { if constexpr (!LM) { { auto rr_ = __builtin_amdgcn_permlane32_swap(__float_as_uint(PS), __float_as_uint(PS), false, false); PS = __uint_as_float(rr_[0]) + __uint_as_float(rr_[1]); } \
      l_reg += PS; psmax = fmaxf(psmax, PS); } packP8(P0, P1, p8); } while (0)
    constexpr int FS_K = 8192, FS_STAGE = 16384;
    const int wv_ = __builtin_amdgcn_readfirstlane(wid);
    const unsigned gV = (unsigned)((tid >> 2) * 64 + (((tid & 3) ^ ((tid >> 4) & 3)) * 16));
    const unsigned gK = FULL ? (unsigned)((tid >> 3) * 256 + (((tid & 7) ^ ((tid >> 4) & 7)) * 16))
                             : (unsigned)((tid >> 2) * 2048 + (((tid & 3) ^ ((tid >> 4) & 3)) * 16));
    const int swv = (r32 >> 2) & 3, vA = r32 * 64 + ((2 * hi) ^ swv) * 16, vB = r32 * 64 + ((2 * hi + 1) ^ swv) * 16;
    const int swk = FULL ? (r32 >> 1) & 7 : (r32 >> 2) & 3;
    const int kA0 = FULL ? r32 * 128 + ((2 * hi) ^ swk) * 16 : r32 * 64 + ((2 * hi) ^ swk) * 16, kB0 = FULL ? r32 * 128 + ((2 * hi + 1) ^ swk) * 16 : r32 * 64 + ((2 * hi + 1) ^ swk) * 16;
    const int kA1 = r32 * 128 + ((4 + 2 * hi) ^ swk) * 16, kB1 = r32 * 128 + ((5 + 2 * hi) ^ swk) * 16;
#define DMA(st, k0) do { __builtin_amdgcn_global_load_lds((const unsigned*)((const char*)Vh + (size_t)((k0) >> 6) * 8192 + gV), (LAS unsigned*)((LAS char*)(uintptr_t)(unsigned)(uintptr_t)lds + (st) + wv_ * 1024), 16, 0, 0); \
      if constexpr (FULL) __builtin_amdgcn_global_load_lds((const unsigned*)((const char*)Kh + (size_t)(k0) * 256 + gK), (LAS unsigned*)((LAS char*)(uintptr_t)(unsigned)(uintptr_t)lds + (st) + FS_K + wv_ * 1024), 16, 0, 0); \
      else if (wv_ < 4) __builtin_amdgcn_global_load_lds((const unsigned*)((const char*)Kh + (size_t)(k0) * 2048 + gK), (LAS unsigned*)((LAS char*)(uintptr_t)(unsigned)(uintptr_t)lds + (st) + FS_K + wv_ * 1024), 16, 0, 0); } while (0)
#define LDV4(off) (*reinterpret_cast<const v4i_att*>(lds + (off)))
#define QKTS(P0, P1, st) do { const int kb_ = (st) + FS_K; \
      if constexpr (FULL) { const v4i_att a0 = LDV4(kb_ + kA0), a1 = LDV4(kb_ + kB0), b0 = LDV4(kb_ + 4096 + kA0), b1 = LDV4(kb_ + 4096 + kB0); \
        const v4i_att c0 = LDV4(kb_ + kA1), c1 = LDV4(kb_ + kB1), d0 = LDV4(kb_ + 4096 + kA1), d1 = LDV4(kb_ + 4096 + kB1); \
        P0 = __builtin_amdgcn_mfma_scale_f32_32x32x64_f8f6f4(__builtin_shufflevector(a0, a1, 0, 1, 2, 3, 4, 5, 6, 7), q8[0], nb, 0, 0, 0, 0x7f7f7f7f, 0, QSC8); \
        P1 = __builtin_amdgcn_mfma_scale_f32_32x32x64_f8f6f4(__builtin_shufflevector(b0, b1, 0, 1, 2, 3, 4, 5, 6, 7), q8[0], nb, 0, 0, 0, 0x7f7f7f7f, 0, QSC8); \
        P0 = __builtin_amdgcn_mfma_scale_f32_32x32x64_f8f6f4(__builtin_shufflevector(c0, c1, 0, 1, 2, 3, 4, 5, 6, 7), q8[1], P0, 0, 0, 0, 0x7f7f7f7f, 0, QSC8); \
        P1 = __builtin_amdgcn_mfma_scale_f32_32x32x64_f8f6f4(__builtin_shufflevector(d0, d1, 0, 1, 2, 3, 4, 5, 6, 7), q8[1], P1, 0, 0, 0, 0x7f7f7f7f, 0, QSC8); } \
      else { const v4i_att a0 = LDV4(kb_ + kA0), a1 = LDV4(kb_ + kB0), b0 = LDV4(kb_ + 2048 + kA0), b1 = LDV4(kb_ + 2048 + kB0); \
        P0 = __builtin_amdgcn_mfma_scale_f32_32x32x64_f8f6f4(__builtin_shufflevector(a0, a1, 0, 1, 2, 3, 4, 5, 6, 7), q8[0], nb, 0, 0, 0, 0x7f7f7f7f, 0, QSC8); \
        P1 = __builtin_amdgcn_mfma_scale_f32_32x32x64_f8f6f4(__builtin_shufflevector(b0, b1, 0, 1, 2, 3, 4, 5, 6, 7), q8[0], nb, 0, 0, 0, 0x7f7f7f7f, 0, QSC8); } } while (0)
#undef PVQ
#define PVQ(st, D) do { const v4i_att a_ = LDV4((st) + (D) * 2048 + vA), b_ = LDV4((st) + (D) * 2048 + vB); \
      o[D] = __builtin_amdgcn_mfma_scale_f32_32x32x64_f8f6f4(p8, __builtin_shufflevector(a_, b_, 0, 1, 2, 3, 4, 5, 6, 7), o[D], 0, 0, 0, 0x7f7f7f7f, 0, 0x7f7f7f7f); } while (0)
#define STEP_END() do { asm volatile("s_waitcnt vmcnt(0)" ::: "memory"); __syncthreads(); { const int t_ = oC; oC = oN; oN = oW; oW = t_; } } while (0)
    int oC = 0, oN = FS_STAGE, oW = 2 * FS_STAGE;
    DMA(0, 0); DMA(FS_STAGE, KVBLK); asm volatile("s_waitcnt vmcnt(0)" ::: "memory"); __syncthreads();
    QKTS(pA0, pA1, oC);
    { const float d = rowmax32(pA0, pA1); m_reg = d;
#pragma unroll
      for (int r = 0; r < 16; ++r) { pA0[r] = __builtin_amdgcn_exp2f(pA0[r] - d); pA1[r] = __builtin_amdgcn_exp2f(pA1[r] - d); nb[r] = -d; }
      asm volatile("" : "+v"(nb));
      if constexpr (FULL) {
#pragma unroll
        for (int r = 0; r < 16; ++r) psA += pA0[r] + pA1[r]; } }
    for (int j = 0; j + 2 < NT_; j += 2) {
      DMA(oW, (j + 2) * KVBLK); SBAR(); QKTS(pB0, pB1, oN);
      FIN(pA0, pA1, psA); SBAR();
      PVS(oC, pB0, pB1, psB);
      STEP_END();
      DMA(oW, (j + 3) * KVBLK); SBAR(); QKTS(pA0, pA1, oN);
      FIN(pB0, pB1, psB); SBAR();
      PVS(oC, pA0, pA1, psA);
      STEP_END();
    }
    SBAR(); QKTS(pB0, pB1, oN);
    FIN(pA0, pA1, psA); SBAR();
    PVS(oC, pB0, pB1, psB);
    FIN(pB0, pB1, psB); SBAR();
    LSUM(); PVQ(oN, 0); PVQ(oN, 1); PVQ(oN, 2); PVQ(oN, 3);
#undef DMA
#undef LDV4
#undef QKTS
#undef STEP_END
#undef LSUM
#undef SOFTQ
#undef PVQ
#undef PVS
#undef FIN
  } else {
  SLOAD(SE, 0); asm volatile("s_waitcnt vmcnt(0)" ::: "memory"); SWRITE(0, SE); __syncthreads();
  QKT(pA0, pA1, K_lds); partialSM<true>(pA0, pA1, m_reg, nb, alA, thr_s);
  SLOAD(SO, KVBLK); if constexpr (SDEPTH == 2) { if (2 < NT_) SLOAD(SE, 2 * KVBLK); }
  SWAIT(); SWRITE(1, SO); __syncthreads();
  for (int j = 1; j + 1 < NT_; j += 2) {
    SBAR(); QKT(pB0, pB1, K_lds + SHM_K);
    FSM(pA0, pA1, alA); SBAR();
    SLOAD(SO, (j + SDEPTH) * KVBLK); SBAR();
    PV(0); PSM(pB0, pB1, alB);
    __syncthreads(); SWAIT(); SWRITE(0, SE);
    RESC(alB); __syncthreads();
    SBAR(); QKT(pA0, pA1, K_lds);
    FSM(pB0, pB1, alB); SBAR();
    if (SDEPTH == 1 || j + 3 < NT_) SLOAD(SE, (j + 1 + SDEPTH) * KVBLK); SBAR();
    PV(1); PSM(pA0, pA1, alA);
    __syncthreads(); SWAIT(); SWRITE(1, SO);
    RESC(alA); __syncthreads();
  }
  SBAR(); QKT(pB0, pB1, K_lds + SHM_K);
  FSM(pA0, pA1, alA); SBAR();
  PV(0); PSM(pB0, pB1, alB);
  __syncthreads(); RESC(alB);
  FSM(pB0, pB1, alB); SBAR();
  PV(1);
  }
  if constexpr (FAST) {
    float lt_ = 0.f;
    if constexpr (!FULL) {
#pragma unroll
      for (int r = 0; r < 16; ++r) lt_ += lacc[r]; }
    int* badf = (int*)(lds + SHM_ATTN); const bool wbad = FULL ? !__all(psmax <= 256.f) : !__all(lt_ <= 3.0e38f);
    if (lane == 0) badf[wid] = wbad ? 1 : 0;
    __syncthreads();
    int anyb = 0;
#pragma unroll
    for (int w = 0; w < NW; ++w) anyb |= badf[w];
    if (__builtin_amdgcn_readfirstlane(anyb)) return true;
  }
  float rli[16];
  if constexpr (FAST && !FULL) {
#pragma unroll
    for (int r = 0; r < 16; ++r) rli[r] = __builtin_amdgcn_rcpf(lacc[r]);
  } else {
    if (hi == 0) li_l[r32] = l_reg; asm volatile("s_waitcnt lgkmcnt(0)" ::: "memory");
#pragma unroll
    for (int r = 0; r < 16; ++r) rli[r] = __builtin_amdgcn_rcpf(li_l[crow(r, hi)]);
  }
  bf16_t* Ow = Ob + (long)(wid * QBLK) * ldo;
#pragma unroll
  for (int r = 0; r < 16; ++r) { int orow = crow(r, hi);
#pragma unroll
    for (int d0 = 0; d0 < 4; ++d0) Ow[(long)orow * ldo + d0 * 32 + r32] = (bf16_t)f2bf(o[d0][r] * rli[r]); }
#undef SLOAD
#undef SWRITE
#undef SWAIT
#undef QKT
#undef RESC
#undef PSM
#undef FSM
#undef PV
  return false;
}
}

#define XB_TMO      128
#define XB_XCNT(j)  (256  + 64 * (j))
#define XB_XSUB(j)  (1280 + 64 * (j))
#define XB_XGEN(j)  (2304 + 64 * (j))
#define XB_TOP      3328
#define XB_TOPGEN   3392
#define XCD_BAR_WORDS 3456
#define XB_SPIN_CAP (1u << 21)
__device__ __forceinline__ unsigned xb_ld(unsigned* p)              { return __hip_atomic_load(p, __ATOMIC_RELAXED, __HIP_MEMORY_SCOPE_AGENT); }
__device__ __forceinline__ unsigned xb_add(unsigned* p, unsigned v) { return __hip_atomic_fetch_add(p, v, __ATOMIC_RELAXED, __HIP_MEMORY_SCOPE_AGENT); }
__device__ __forceinline__ unsigned xb_xcc_id() { return (unsigned)__builtin_amdgcn_s_getreg((3 << 11) | 20) & 0xFu; }
#define XB_SPIN(cond, bar) do { unsigned _sp = 0; while (cond) { __builtin_amdgcn_s_sleep(1); \
    if ((++_sp & 255u) == 0u) { if (xb_ld(&(bar)[XB_TMO])) break; if (_sp > XB_SPIN_CAP) { atomicAdd(&(bar)[XB_TMO], 1u); break; } } } } while (0)
struct XcdBarrier { unsigned* bar; unsigned x; volatile LAS unsigned* st; };
__device__ __forceinline__ XcdBarrier xcd_barrier_post(unsigned* bar, volatile LAS unsigned* st) {
    XcdBarrier b; b.bar = bar; b.x = (unsigned)__builtin_amdgcn_readfirstlane((int)xb_xcc_id()); b.st = st;
    if (threadIdx.x == 0) (void)xb_add(&bar[XB_XCNT(b.x)], 1u);
    return b;
}
__device__ __forceinline__ void xcd_barrier_complete(unsigned* bar, unsigned x, unsigned& nloc, unsigned& nx) {
    const unsigned G = gridDim.x * gridDim.y * gridDim.z;
    unsigned sum, cnt, mine, sp = 0u;
    for (;;) {
        sum = 0u; cnt = 0u; mine = 0u;
#pragma unroll
        for (unsigned j = 0; j < 16; ++j) { const unsigned c = xb_ld(&bar[XB_XCNT(j)]); sum += c; cnt += (c > 0u) ? 1u : 0u; mine = (j == x) ? c : mine; }
        if (sum == G) break;
        __builtin_amdgcn_s_sleep(1);
        if ((++sp & 255u) == 0u) { if (xb_ld(&bar[XB_TMO])) break; if (sp > XB_SPIN_CAP) { atomicAdd(&bar[XB_TMO], 1u); break; } }
    }
    nloc = mine > 0u ? mine : 1u; nx = cnt > 0u ? cnt : 1u;
}
__device__ __forceinline__ void xcd_barrier(const XcdBarrier& b) {
    asm volatile("s_waitcnt vmcnt(0)" ::: "memory");
    __syncthreads();
    if (threadIdx.x == 0) {
        unsigned* bar = b.bar;
        __builtin_amdgcn_s_waitcnt(0);
        unsigned nloc = b.st[0], nx = b.st[1];
        if (nloc == 0u) { xcd_barrier_complete(bar, b.x, nloc, nx); b.st[0] = nloc; b.st[1] = nx; }
        const unsigned old = xb_add(&bar[XB_XSUB(b.x)], 1u);
        const unsigned gen = old / nloc;
        if (old + 1u == (gen + 1u) * nloc) {
            __builtin_amdgcn_fence(__ATOMIC_RELEASE, "agent");
            asm volatile("s_waitcnt vmcnt(0)" ::: "memory");
            const unsigned og = xb_add(&bar[XB_TOP], 1u);
            const unsigned tg = og / nx;
            if (og + 1u == (tg + 1u) * nx) xb_add(&bar[XB_TOPGEN], 1u);
            else XB_SPIN(xb_ld(&bar[XB_TOPGEN]) == tg, bar);
            __builtin_amdgcn_fence(__ATOMIC_ACQUIRE, "agent");
            xb_add(&bar[XB_XGEN(b.x)], 1u);
            asm volatile("s_waitcnt vmcnt(0)" ::: "memory");
        } else {
            XB_SPIN(xb_ld(&bar[XB_XGEN(b.x)]) == gen, bar);
            __builtin_amdgcn_fence(__ATOMIC_ACQUIRE, "agent");
            asm volatile("s_waitcnt vmcnt(0)" ::: "memory");
        }
    }
    __syncthreads();
}

constexpr int RING_BYTES = 131072, MISC_OFF = RING_BYTES + 320, LDS_BYTES = 147456;

struct Args { const float* in[33]; float* out; unsigned char* ws; };
enum { I_X = 0, I_C, I_CTX, I_CCTX, I_WADA, I_BADA, I_WIN, I_LQ1, I_LK1, I_LQ2, I_LK2, I_SUBLN, I_WPA, I_QNORM, I_KNORM, I_WPB, I_ARE, I_AIM, I_LOGDT, I_BRE, I_BIM, I_CRE, I_CIM,
       I_S5D, I_WGLU, I_WO, I_LNMG, I_LNMB, I_WG, I_WU, I_WD, I_LNFG, I_LNFB };

typedef const float* cfp_t;
struct InTab {
    __device__ __forceinline__ cfp_t operator[](int i) const {
        const __attribute__((address_space(4))) unsigned char* k = (const __attribute__((address_space(4))) unsigned char*)__builtin_amdgcn_kernarg_segment_ptr();
        asm volatile("" : "+s"(k));
        return (cfp_t)(const GAS float*)(*(const __attribute__((address_space(4))) cfp_t*)(k + 8 * i));
    }
};
struct Frame {
    LAS unsigned char* lds; int tid, lane, wave, vcu, G, gw, NGW;
    InTab in; GAS float* out; GAS unsigned char* ws;
};

__device__ __forceinline__ void transpose_item(const float* W, int K, int N, bf16_t* WT, int k0, int n0, int out_row0, LAS float* scr, int lane, bool fp8 = false) {
    const float* src = W + (size_t)k0 * N + n0 + lane;
#pragma unroll
    for (int h = 0; h < 2; ++h) { float v[32];
#pragma unroll
        for (int i = 0; i < 32; ++i) v[i] = src[(size_t)(32 * h + i) * N];
#pragma unroll
        for (int i = 0; i < 32; ++i) scr[(32 * h + i) * 64 + (lane ^ (8 * ((32 * h + i) >> 3)))] = v[i]; }
    LDS_WAIT(); asm volatile("" ::: "memory");
    const int c = lane & 7;
#pragma unroll
    for (int j = 0; j < 8; ++j) { const int n = (lane >> 3) + 8 * j; const LAS float* s = scr + (8 * c) * 64 + (n ^ (8 * c));
        if (fp8) { u32x2 o8; o8.x = pk4_fp8(64.f * s[0 * 64], 64.f * s[1 * 64], 64.f * s[2 * 64], 64.f * s[3 * 64]); o8.y = pk4_fp8(64.f * s[4 * 64], 64.f * s[5 * 64], 64.f * s[6 * 64], 64.f * s[7 * 64]);
            *(u32x2*)((unsigned char*)WT + (size_t)(out_row0 + n) * K + k0 + 8 * c) = o8; }
        else { u32x4 o; o.x = pk2(s[0 * 64], s[1 * 64]); o.y = pk2(s[2 * 64], s[3 * 64]); o.z = pk2(s[4 * 64], s[5 * 64]); o.w = pk2(s[6 * 64], s[7 * 64]);
        *(u32x4*)(WT + (size_t)(out_row0 + n) * K + k0 + 8 * c) = o; } }
    LDS_WAIT(); asm volatile("" ::: "memory");
}
constexpr int IT_IN = (DM / 64) * (NIN / 64), IT_PA = (1024 / 64) * (DM / 64), IT_PB = IT_PA, IT_GLU = (1024 / 64) * (4096 / 64), IT_O = (DM / 64) * (DM / 64),
              IT_G = (DM / 64) * (FF / 64), IT_U = IT_G, IT_D = (FF / 64) * (DM / 64);
constexpr int IT_LAYER = IT_IN + IT_PA + IT_PB + IT_GLU + IT_O + IT_G + IT_U + IT_D;

__device__ __forceinline__ void convert_item(Frame& F, int it, LAS float* scr) {
    const int l = it / IT_LAYER; int r = it % IT_LAYER;
    GAS unsigned char* wl = F.ws + WS_W + (size_t)l * W_LAYER;
    const float* W; int K, N; bf16_t* WT; int mode;
    int rowoff = 0;
    if (r < IT_IN) { W = F.in[I_WIN] + (size_t)l * DM * NIN; K = DM; N = NIN; WT = (bf16_t*)(wl + W_IN); mode = 0; }
    else if ((r -= IT_IN) < IT_PA) { W = F.in[I_WPA] + (size_t)l * 1024 * DM; K = 1024; N = DM; WT = (bf16_t*)(wl + W_PAB); mode = 0; }
    else if ((r -= IT_PA) < IT_PB) { W = F.in[I_WPB] + (size_t)l * 1024 * DM; K = 1024; N = DM; WT = (bf16_t*)(wl + W_PAB); mode = 0; rowoff = 2048; }
    else if ((r -= IT_PB) < IT_GLU) { W = F.in[I_WGLU] + (size_t)l * 1024 * 4096; K = 1024; N = 4096; WT = (bf16_t*)(wl + W_GLU); mode = 1; }
    else if ((r -= IT_GLU) < IT_O) { W = F.in[I_WO] + (size_t)l * DM * DM; K = DM; N = DM; WT = (bf16_t*)(wl + W_O); mode = 0; }
    else if ((r -= IT_O) < IT_G) { W = F.in[I_WG] + (size_t)l * DM * FF; K = DM; N = FF; WT = (bf16_t*)(wl + W_GU); mode = 2; }
    else if ((r -= IT_G) < IT_U) { W = F.in[I_WU] + (size_t)l * DM * FF; K = DM; N = FF; WT = (bf16_t*)(wl + W_GU); mode = 3; }
    else { r -= IT_U; W = F.in[I_WD] + (size_t)l * FF * DM; K = FF; N = DM; WT = (bf16_t*)(wl + W_DN); mode = 0; }
    const int nblk = N / 64, kb = r / nblk, nb = r % nblk, k0 = 64 * kb, n0 = 64 * nb;
    int orow; bool fp8 = false;
    if (mode == 0 && N == NIN) { const int pt = n0 >> 8; orow = win_tile_slot(pt) * 256 + (n0 & 255);
        if (win_tile_fp8(pt)) { fp8 = true; WT = (bf16_t*)(wl + W_IN8); } }
    else if (mode == 0) orow = rowoff + n0;
    else if (mode == 1) orow = 256 * ((n0 % 2048) / 128) + 128 * (n0 / 2048) + (n0 % 128);
    else orow = 256 * (n0 / 128) + (mode == 3 ? 128 : 0) + (n0 % 128);
    transpose_item(W, K, N, WT, k0, n0, orow, scr, F.lane, fp8);
}

__device__ __forceinline__ void mod_item(Frame& F, int it) {
    const int cb = it % 48, slab = (it / 48) % MOD_SLABS, l = it / (48 * MOD_SLABS);
    const int col = cb * 256 + 4 * F.lane, k0 = slab * 64;
    const float* W = F.in[I_WADA] + ((size_t)l * DM + k0) * 12288 + col;
    const float* c = F.in[I_C] + k0; const float* cc = F.in[I_CCTX] + k0;
    f32x4 a0 = {0.f, 0.f, 0.f, 0.f}, a1 = a0;
#pragma unroll 8
    for (int k = 0; k < 64; ++k) { const f32x4 w = *(const f32x4*)(W + (size_t)k * 12288); const float s0 = siluf_(c[k]), s1 = siluf_(cc[k]); a0 += w * s0; a1 += w * s1; }
    float* P = (float*)(F.ws + WS_MODP) + (((size_t)slab * NL + l) * 2) * 12288 + col;
    *(f32x4*)P = a0; *(f32x4*)(P + 12288) = a1;
}

__device__ __forceinline__ void s5_param_item(Frame& F, int it) {
    const int p = it & 63, g = (it >> 6) & 63, dir = (it >> 12) & 1, l = it >> 13;
    const int gi = (l * 2 + dir) * 64 + g;
    double are = (double)F.in[I_ARE][gi * 64 + p]; if (are > -1e-4) are = (double)(-1e-4f);
    const double aim = (double)F.in[I_AIM][gi * 64 + p];
    const double dt = dexp((double)F.in[I_LOGDT][gi]);
    double s, c; dsincos(aim * dt, s, c);
    const double mag = dexp(are * dt), lr = mag * c, li = mag * s;
    const double den = are * are + aim * aim, nr = lr - 1.0;
    const double cr = (nr * are + li * aim) / den, ci = (li * are - nr * aim) / den;
    const float* bre = F.in[I_BRE] + ((size_t)gi * 64 + p) * 16; const float* bim = F.in[I_BIM] + ((size_t)gi * 64 + p) * 16;
    f32x2* BBF = (f32x2*)(F.ws + WS_BBF) + ((size_t)gi * 64 + p) * 16;
#pragma unroll
    for (int h = 0; h < 16; ++h) { const double br = bre[h], bi = bim[h];
        BBF[h] = (f32x2){(float)(cr * br - ci * bi), (float)(cr * bi + ci * br)}; }
    { f32x2* POW = (f32x2*)(F.ws + WS_POW) + (size_t)gi * 17 * 64 + p; double pr = 1.0, pi = 0.0;
      for (int k = 0; k <= 16; ++k) { POW[k * 64] = (f32x2){(float)pr, (float)pi}; const double nr = pr * lr - pi * li, ni = pr * li + pi * lr; pr = nr; pi = ni; } }
}

__device__ __forceinline__ void modulate_row(int lane, const float* xrow, float* xres, bf16_t* hrow, unsigned char* h8row, const float* sh, const float* sc) {
#pragma unroll
    for (int j = 0; j < 8; ++j) { const int c = 4 * lane + 256 * j; const f32x4 v = *(const f32x4*)(xrow + c), a = *(const f32x4*)(sc + c), b = *(const f32x4*)(sh + c);
        if (xres) *(f32x4*)(xres + c) = v;
        const f32x4 y = v * (a + 1.f) + b; u32x2 w; w.x = cvt_pk_bf16(y[0], y[1]); w.y = cvt_pk_bf16(y[2], y[3]); *(u32x2*)(hrow + c) = w;
        *(unsigned*)(h8row + c) = pk4_fp8(y[0], y[1], y[2], y[3]); }
}
__device__ __forceinline__ void ln_finish(int lane, f32x4 (&v)[8], float* xrow, bf16_t* hrow, const float* g, const float* b, const float* sh, const float* sc, unsigned char* h8row = nullptr, float* stats = nullptr) {
    float s = 0.f;
#pragma unroll
    for (int j = 0; j < 8; ++j) s += (v[j][0] + v[j][1]) + (v[j][2] + v[j][3]);
    const float mean = wave_sum(s) * (1.f / DM); float s2 = 0.f;
#pragma unroll
    for (int j = 0; j < 8; ++j) { v[j] = v[j] - mean; s2 += (v[j][0] * v[j][0] + v[j][1] * v[j][1]) + (v[j][2] * v[j][2] + v[j][3] * v[j][3]); }
    const float rstd = 1.f / sqrtf(wave_sum(s2) * (1.f / DM) + 1e-6f);
    if (stats && lane == 0) { f32x2 st = {mean, rstd}; *(f32x2*)stats = st; }
#pragma unroll
    for (int j = 0; j < 8; ++j) { const int c = 4 * lane + 256 * j; const f32x4 y = v[j] * rstd * *(const f32x4*)(g + c) + *(const f32x4*)(b + c);
        if (xrow) *(f32x4*)(xrow + c) = y;
        if (hrow) { const f32x4 z = y * (*(const f32x4*)(sc + c) + 1.f) + *(const f32x4*)(sh + c); u32x2 w; w.x = cvt_pk_bf16(z[0], z[1]); w.y = cvt_pk_bf16(z[2], z[3]); *(u32x2*)(hrow + c) = w;
            if (h8row) *(unsigned*)(h8row + c) = pk4_fp8(z[0], z[1], z[2], z[3]); } }
}
__device__ __forceinline__ void ln_row(int lane, const float* trow, float* xrow, bf16_t* hrow, const float* g, const float* b, const float* sh, const float* sc, unsigned char* h8row = nullptr, float* stats = nullptr) {
    f32x4 v[8];
#pragma unroll
    for (int j = 0; j < 8; ++j) v[j] = *(const f32x4*)(trow + 4 * lane + 256 * j);
    ln_finish(lane, v, xrow, hrow, g, b, sh, sc, h8row, stats);
}
__device__ __forceinline__ void ln_ctx_row(Frame& F, int r, const float* slab, int nslab, const float* gvec, const float* g, const float* b, const float* sh, const float* sc, bool h8) {
    const int lane = F.lane; LAS float* xb = (LAS float*)F.lds;
    f32x4 a[8];
#pragma unroll
    for (int j = 0; j < 8; ++j) a[j] = (f32x4){0.f, 0.f, 0.f, 0.f};
    for (int q = F.wave; q < nslab; q += NWAVES) { const float* sp = slab + ((size_t)q * NCTX + r) * DM + 4 * lane;
#pragma unroll
        for (int j = 0; j < 8; ++j) a[j] += *(const f32x4*)(sp + 256 * j); }
#pragma unroll
    for (int j = 0; j < 8; ++j) *(LAS f32x4*)(xb + F.wave * DM + 4 * lane + 256 * j) = a[j];
    __syncthreads();
    if (F.wave == 0) {
        float* xrow = (float*)(F.ws + WS_XRES) + (size_t)(NLAT + r) * DM; f32x4 v[8];
#pragma unroll
        for (int j = 0; j < 8; ++j) { const int c = 4 * lane + 256 * j; f32x4 t = *(const LAS f32x4*)(xb + c);
#pragma unroll
            for (int w = 1; w < NWAVES; ++w) t += *(const LAS f32x4*)(xb + w * DM + c);
            v[j] = *(const f32x4*)(xrow + c) * DN_ALPHA + *(const f32x4*)(gvec + c) * t; }
        ln_finish(lane, v, xrow, (bf16_t*)(F.ws + WS_H) + (size_t)(NLAT + r) * DM, g, b, sh, sc, h8 ? (unsigned char*)(F.ws + WS_H8) + (size_t)(NLAT + r) * DM : (unsigned char*)nullptr);
    }
    __syncthreads();
}

__device__ __forceinline__ void prep_row(Frame& F, int l, int t) {
    bf16_t* z = (bf16_t*)(F.ws + WS_Z) + (size_t)t * NIN;
    const bool lat = t < NLAT; const int prow = t >> 6, pcol = t & 63, lane = F.lane;
    const f32x2* RD = (const f32x2*)(F.ws + WS_ROPE_DA); const f32x2* RG = (const f32x2*)(F.ws + WS_ROPE_GQ);
    {
#pragma unroll
        for (int rep = 0; rep < 2; ++rep) { const int task = lane + 64 * rep, b = task >> 1, a = task & 1;
            const bf16_t* p = z + b * 32 + 8 * a; const int pos = (b & 1) ? pcol : prow;
            float x1[8], x2[8]; unpack8(*(const u32x4*)p, x1); unpack8(*(const u32x4*)(p + 16), x2);
            float o1[8], o2[8];
            if (lat) { const f32x2* cs = RD + pos * 16 + 8 * a;
#pragma unroll
                for (int j = 0; j < 8; ++j) { const f32x2 q = cs[j]; o1[j] = x1[j] * q[0] - x2[j] * q[1]; o2[j] = x2[j] * q[0] + x1[j] * q[1]; } }
            else {
#pragma unroll
                for (int j = 0; j < 8; ++j) { o1[j] = x1[j]; o2[j] = x2[j]; } }
            if (b < 32) {
#pragma unroll
                for (int j = 0; j < 8; ++j) { o1[j] *= 0.125f * 1.4426950408889634f * 8.f; o2[j] *= 0.125f * 1.4426950408889634f * 8.f; } }
            unsigned char* d8 = (unsigned char*)(F.ws + WS_QKA8) + (size_t)t * 2048 + b * 32 + 8 * a;
            u32x2 w1, w2; w1.x = pk4_fp8(o1[0], o1[1], o1[2], o1[3]); w1.y = pk4_fp8(o1[4], o1[5], o1[6], o1[7]); w2.x = pk4_fp8(o2[0], o2[1], o2[2], o2[3]); w2.y = pk4_fp8(o2[4], o2[5], o2[6], o2[7]);
            *(u32x2*)d8 = w1; *(u32x2*)(d8 + 16) = w2; }
    }
#pragma unroll
    for (int pass = 0; pass < 2; ++pass) {
        const int seg = lane >> 3, sub = lane & 7, axis = sub >> 2, a = sub & 3;
        const bool active = pass == 0 || seg < 2;
        bf16_t* p = z + (pass == 0 ? C_QB : C_KB) + (active ? seg : 0) * 128 + axis * 64 + 8 * a;
        const float* nw = F.in[pass == 0 ? I_QNORM : I_KNORM] + l * 128 + axis * 64 + 8 * a;
        float x1[8], x2[8]; unpack8(*(const u32x4*)p, x1); unpack8(*(const u32x4*)(p + 32), x2);
        float ss = 0.f;
#pragma unroll
        for (int j = 0; j < 8; ++j) ss += x1[j] * x1[j] + x2[j] * x2[j];
        ss += __shfl_xor(ss, 1); ss += __shfl_xor(ss, 2); ss += __shfl_xor(ss, 4);
        const float r = 1.f / sqrtf(ss * (1.f / 128.f) + 1e-6f);
        float o1[8], o2[8];
#pragma unroll
        for (int j = 0; j < 8; ++j) { x1[j] = x1[j] * r * nw[j]; x2[j] = x2[j] * r * nw[32 + j]; }
        if (lat) { const int pos = axis ? pcol : prow; const f32x2* cs = RG + pos * 32 + 8 * a;
#pragma unroll
            for (int j = 0; j < 8; ++j) { const f32x2 q = cs[j]; o1[j] = x1[j] * q[0] - x2[j] * q[1]; o2[j] = x2[j] * q[0] + x1[j] * q[1]; } }
        else {
#pragma unroll
            for (int j = 0; j < 8; ++j) { o1[j] = x1[j]; o2[j] = x2[j]; } }
        if (pass == 0) {
#pragma unroll
            for (int j = 0; j < 8; ++j) { o1[j] *= 0.088388347648318440f * 1.4426950408889634f * 8.f; o2[j] *= 0.088388347648318440f * 1.4426950408889634f * 8.f; } }
        if (active) { unsigned char* d8 = (pass == 0 ? (unsigned char*)(F.ws + WS_QB8) + (size_t)t * 1024 : (unsigned char*)(F.ws + WS_KB8) + (size_t)t * 256) + seg * 128 + axis * 64 + 8 * a;
            u32x2 w1, w2; w1.x = pk4_fp8(o1[0], o1[1], o1[2], o1[3]); w1.y = pk4_fp8(o1[4], o1[5], o1[6], o1[7]); w2.x = pk4_fp8(o2[0], o2[1], o2[2], o2[3]); w2.y = pk4_fp8(o2[4], o2[5], o2[6], o2[7]);
            *(u32x2*)d8 = w1; *(u32x2*)(d8 + 32) = w2; }
    }
}

__device__ __forceinline__ void vt8_task(Frame& F, int task, LAS unsigned char* scr) {
    const int dvq = task & 3, tile = (task >> 2) % 132, hh = task / (4 * 132), lane = F.lane; const bool da = hh >= 2; const int kvh = da ? hh - 2 : hh;
    const bf16_t* p = (const bf16_t*)(F.ws + WS_Z) + (size_t)(tile * 64 + lane) * NIN + (da ? C_VA : C_VB) + kvh * 128 + dvq * 32;
    const int kk = lane & 31, slot = ((kk >> 2) & 1) * 32 + (lane >> 5) * 16 + (kk & 3) + 4 * (kk >> 3);
#pragma unroll
    for (int q = 0; q < 4; ++q) { float x[8]; unpack8(*(const u32x4*)(p + 8 * q), x);
        const unsigned w0 = pk4_fp8(x[0], x[1], x[2], x[3]), w1 = pk4_fp8(x[4], x[5], x[6], x[7]);
#pragma unroll
        for (int j = 0; j < 4; ++j) { scr[(8 * q + j) * 80 + slot] = (unsigned char)(w0 >> (8 * j)); scr[(8 * q + 4 + j) * 80 + slot] = (unsigned char)(w1 >> (8 * j)); } }
    LDS_WAIT(); asm volatile("" ::: "memory");
    unsigned char* dst = (unsigned char*)(F.ws + (da ? WS_VA8T : WS_VB8T)) + ((size_t)(kvh * 132 + tile) * 128 + dvq * 32) * 64;
#pragma unroll
    for (int rep = 0; rep < 2; ++rep) { const int piece = lane + 64 * rep, row = piece >> 2, part = piece & 3;
        *(u32x4*)(dst + row * 64 + part * 16) = *(const LAS u32x4*)(scr + row * 80 + part * 16); }
    LDS_WAIT(); asm volatile("" ::: "memory");
}

__device__ __forceinline__ void da_combine_row(Frame& F, int l, int t, float lam, float one_m_li) {
    const int lane = F.lane, h = lane >> 3, d0 = (lane & 7) * 16;
    const bf16_t* o1p = (const bf16_t*)(F.ws + WS_ODA) + (size_t)t * DM + (2 * h) * 128 + d0; const bf16_t* o2p = o1p + 128;
    const float* w = F.in[I_SUBLN] + l * 128 + d0;
    float a[16], b[16]; unpack8(*(const u32x4*)o1p, *(float(*)[8])a); unpack8(*(const u32x4*)(o1p + 8), *(float(*)[8])(a + 8));
    unpack8(*(const u32x4*)o2p, *(float(*)[8])b); unpack8(*(const u32x4*)(o2p + 8), *(float(*)[8])(b + 8));
    float ss = 0.f;
#pragma unroll
    for (int j = 0; j < 16; ++j) { a[j] = a[j] - lam * b[j]; ss += a[j] * a[j]; }
    ss += __shfl_xor(ss, 1); ss += __shfl_xor(ss, 2); ss += __shfl_xor(ss, 4);
    const float r = one_m_li / sqrtf(ss * (1.f / 128.f) + 1e-5f);
#pragma unroll
    for (int j = 0; j < 16; ++j) a[j] = a[j] * r * w[j];
    bf16_t* out = (bf16_t*)(F.ws + WS_APB) + (size_t)t * 1024 + h * 128 + d0;
    *(u32x4*)out = pack8(*(float(*)[8])a); *(u32x4*)(out + 8) = pack8(*(float(*)[8])(a + 8));
}


__device__ __forceinline__ void s5_ktab_item(Frame& F, int idx) {
    const int hp = idx & 15, h = (idx >> 4) & 15, dir = (idx >> 8) & 1, g = (idx >> 9) & 63, l = idx >> 15;
    const int gi = (l * 2 + dir) * 64 + g;
    const float* cre = F.in[I_CRE] + ((size_t)gi * 16 + h) * 64; const float* cim = F.in[I_CIM] + ((size_t)gi * 16 + h) * 64;
    const f32x2* L1 = (const f32x2*)(F.ws + WS_POW) + ((size_t)gi * 17 + 1) * 64; const f32x2* BBF = (const f32x2*)(F.ws + WS_BBF) + (size_t)gi * 64 * 16 + hp;
    float acc[16];
#pragma unroll
    for (int k = 0; k < 16; ++k) acc[k] = 0.f;
#pragma unroll 4
    for (int p = 0; p < 64; ++p) { const float cr = cre[p], ci = cim[p]; const f32x2 L = L1[p], B = BBF[p * 16];
        float wr = cr * B[0] - ci * B[1], wi = cr * B[1] + ci * B[0];
#pragma unroll
        for (int k = 0; k < 16; ++k) { acc[k] += wr; const float nr = wr * L[0] - wi * L[1], ni = wr * L[1] + wi * L[0]; wr = nr; wi = ni; } }
    float* KT = (float*)(F.ws + WS_KTAB) + (size_t)((l * 64 + g) * 2 + dir) * 16 * 256 + h * 16 + hp;
#pragma unroll
    for (int k = 0; k < 16; ++k) KT[k * 256] = acc[k];
}
template <int NB>
__device__ __forceinline__ void s5_etab_items(Frame& F, int idx0, int stride, int nitems) {
    f32x2 L[NB], B[NB][8]; int im_[NB]; size_t dst[NB]; bool ok[NB];
#pragma unroll
    for (int b = 0; b < NB; ++b) { const int idx = idx0 + b * stride; ok[b] = idx < nitems; const int id = ok[b] ? idx : 0;
        const int k0 = (id & 31) * 8, n = (id >> 5) & 255, g = (id >> 13) & 63, l = id >> 19;
        const int dir = n >> 7, p = n & 63, tt = k0 >> 4, h0 = k0 & 15, e = dir == 0 ? 15 - tt : tt, gi = (l * 2 + dir) * 64 + g; im_[b] = (n >> 6) & 1;
        L[b] = ((const f32x2*)(F.ws + WS_POW))[((size_t)gi * 17 + e) * 64 + p]; const f32x2* BBF = (const f32x2*)(F.ws + WS_BBF) + ((size_t)gi * 64 + p) * 16 + h0;
#pragma unroll
        for (int j = 0; j < 8; ++j) B[b][j] = BBF[j];
        dst[b] = ((size_t)(l * 64 + g) * 256 + n) * 256 + k0; }
#pragma unroll
    for (int b = 0; b < NB; ++b) { float o[8];
#pragma unroll
        for (int j = 0; j < 8; ++j) o[j] = im_[b] ? L[b][0] * B[b][j][1] + L[b][1] * B[b][j][0] : L[b][0] * B[b][j][0] - L[b][1] * B[b][j][1];
        if (ok[b]) *(u32x4*)((bf16_t*)(F.ws + WS_ETAB) + dst[b]) = pack8(o); }
}
template <int NB>
__device__ __forceinline__ void s5_gtab_items(Frame& F, int idx0, int stride, int nitems) {
    f32x2 L[NB][8]; float cr[NB][8], ci[NB][8]; int im_[NB]; size_t dst[NB]; bool ok[NB];
#pragma unroll
    for (int b = 0; b < NB; ++b) { const int idx = idx0 + b * stride; ok[b] = idx < nitems; const int id = ok[b] ? idx : 0;
        const int k8 = id & 31, n = (id >> 5) & 255, g = (id >> 13) & 63, l = id >> 19;
        const int dir = k8 >> 4, comp0 = (k8 & 15) * 8, p0 = comp0 & 63, tt = n >> 4, h = n & 15, e = dir == 0 ? tt + 1 : 16 - tt, gi = (l * 2 + dir) * 64 + g; im_[b] = comp0 >> 6;
        const f32x2* POW = (const f32x2*)(F.ws + WS_POW) + ((size_t)gi * 17 + e) * 64 + p0;
        const float* cre = F.in[I_CRE] + ((size_t)gi * 16 + h) * 64 + p0; const float* cim = F.in[I_CIM] + ((size_t)gi * 16 + h) * 64 + p0;
#pragma unroll
        for (int j = 0; j < 8; ++j) { L[b][j] = POW[j]; cr[b][j] = cre[j]; ci[b][j] = cim[j]; }
        dst[b] = ((size_t)(l * 64 + g) * 256 + n) * 512 + 256 + 8 * k8; }
#pragma unroll
    for (int b = 0; b < NB; ++b) { float o[8];
#pragma unroll
        for (int j = 0; j < 8; ++j) o[j] = im_[b] ? -(cr[b][j] * L[b][j][1] + ci[b][j] * L[b][j][0]) : cr[b][j] * L[b][j][0] - ci[b][j] * L[b][j][1];
        if (ok[b]) *(u32x4*)((bf16_t*)(F.ws + WS_BTAB) + dst[b]) = pack8(o); }
}
template <int NB>
__device__ __forceinline__ void s5_ttab_items(Frame& F, int idx0, int stride, int nitems) {
    float o[NB][8]; size_t dst[NB]; bool ok[NB];
#pragma unroll
    for (int b = 0; b < NB; ++b) { const int idx = idx0 + b * stride; ok[b] = idx < nitems; const int id = ok[b] ? idx : 0;
        const int k0 = (id & 31) * 8, n = (id >> 5) & 255, g = (id >> 13) & 63, l = id >> 19;
        const int tp = k0 >> 4, hp0 = k0 & 15, tt = n >> 4, h = n & 15;
        const float* KT = (const float*)(F.ws + WS_KTAB) + (size_t)(l * 64 + g) * 2 * 16 * 256;
        const bool f = tp <= tt, r = tp >= tt;
        const float* kf = KT + (size_t)(f ? tt - tp : 0) * 256 + h * 16 + hp0; const float* kr = KT + (size_t)(16 + (r ? tp - tt : 0)) * 256 + h * 16 + hp0;
        const float dsk = F.in[I_S5D][l * 1024 + g * 16 + h];
#pragma unroll
        for (int j = 0; j < 8; ++j) o[b][j] = (f ? kf[j] : 0.f) + (r ? kr[j] : 0.f);
        if (tp == tt && (h >> 3) == (hp0 >> 3)) o[b][h & 7] += dsk;
        dst[b] = ((size_t)(l * 64 + g) * 256 + n) * 512 + k0; }
#pragma unroll
    for (int b = 0; b < NB; ++b) if (ok[b]) *(u32x4*)((bf16_t*)(F.ws + WS_BTAB) + dst[b]) = pack8(o[b]);
}
template <int PASS>
__device__ __forceinline__ void s5_scan_task(Frame& F, int l, int task) {
    const int run = task % 33, gd = task / 33, dir = gd & 1, g = gd >> 1, p = F.lane, gi = (l * 2 + dir) * 64 + g;
    const f32x2 L16 = ((const f32x2*)(F.ws + WS_POW))[((size_t)gi * 17 + 16) * 64 + p];
    const float* S = (const float*)(F.ws + WS_S) + (size_t)g * 768 * 256 + dir * 128 + p;
    f32x2* GF = (f32x2*)(F.ws + WS_F) + ((size_t)gd * 33) * 64 + p;
    float sr[16], si[16];
#pragma unroll
    for (int q = 0; q < 16; ++q) { const int s_ = run * 16 + q, c = dir == 0 ? (s_ < 16 ? 512 + s_ : s_ - 16) : 527 - s_; sr[q] = S[(size_t)c * 256]; si[q] = S[(size_t)c * 256 + 64]; }
    float xr = 0.f, xi = 0.f;
    if (PASS == 2) {
        float ar = L16[0], ai = L16[1];
#pragma unroll
        for (int q = 0; q < 4; ++q) { const float nr = ar * ar - ai * ai, ni = 2.f * ar * ai; ar = nr; ai = ni; }
        for (int r = 0; r < run; ++r) { const f32x2 f = GF[(size_t)r * 64]; const float nr = ar * xr - ai * xi + f[0], ni = ar * xi + ai * xr + f[1]; xr = nr; xi = ni; }
    }
    bf16_t* X = (bf16_t*)(F.ws + WS_AP) + (size_t)g * 768 * 512 + 256 + dir * 128 + p;
#pragma unroll
    for (int q = 0; q < 16; ++q) { const int s_ = run * 16 + q, c = dir == 0 ? (s_ < 16 ? 512 + s_ : s_ - 16) : 527 - s_;
        if (PASS == 2) { X[(size_t)c * 512] = (bf16_t)f2bf(xr); X[(size_t)c * 512 + 64] = (bf16_t)f2bf(xi); }
        const float nr = L16[0] * xr - L16[1] * xi + sr[q], ni = L16[0] * xi + L16[1] * xr + si[q]; xr = nr; xi = ni; }
    if (PASS == 1) GF[(size_t)run * 64] = (f32x2){xr, xi};
}

__global__ void __launch_bounds__(NTHR, 2) hyb_fwd(Args args) {
    extern __shared__ __attribute__((aligned(16))) unsigned char lds_raw[];
    Frame F;
    F.lds = (LAS unsigned char*)lds_raw;
    F.tid = threadIdx.x; F.lane = F.tid & 63; F.wave = __builtin_amdgcn_readfirstlane(F.tid >> 6);
    F.G = gridDim.x; { const int bx = blockIdx.x; F.vcu = (F.G % 8 == 0) ? (bx % 8) * (F.G / 8) + bx / 8 : bx; }
    F.gw = F.vcu * NWAVES + F.wave; F.NGW = F.G * NWAVES;
    F.out = (GAS float*)args.out; F.ws = (GAS unsigned char*)args.ws;
    volatile LAS unsigned* MISC = (volatile LAS unsigned*)(F.lds + MISC_OFF);
    for (int u = F.tid; u < (LDS_BYTES - RING_BYTES) / 4; u += NTHR) ((LAS unsigned*)(F.lds + RING_BYTES))[u] = 0u;
    __syncthreads();
    unsigned* ctl = (unsigned*)(F.ws + WS_CTL);
    XcdBarrier bar = xcd_barrier_post(ctl + CW_BAR, MISC + 8);
#define GRID_BAR() do { asm volatile("" : "+s"(bar.bar), "+s"(bar.x)); xcd_barrier(bar); F.tid = opaque_tid(); F.lane = F.tid & 63; asm volatile("" : "+s"(F.ws)); } while (0)
    LAS float* wscr = (LAS float*)(F.lds + F.wave * 16384);

    {
        for (int it = F.gw; it < NL * MOD_SLABS * 48; it += F.NGW) mod_item(F, it);
        for (int it = F.gw * 64 + F.lane; it < NL * 2 * 64 * 64; it += F.NGW * 64) s5_param_item(F, it);
        for (int it = F.gw * 64 + F.lane; it < 128 * 16 + 128 * 32; it += F.NGW * 64) {
            const bool da = it < 128 * 16; const int r = da ? it : it - 128 * 16, nf = da ? 16 : 32, pos = r / nf, i = r % nf;
            const float invf = (float)dexp(-(double)(2 * i) / (double)(2 * nf) * 9.210340371976184);
            const float ang = (float)pos * invf; double s, c; dsincos((double)ang, s, c);
            ((f32x2*)(F.ws + (da ? WS_ROPE_DA : WS_ROPE_GQ)))[r] = (f32x2){(float)c, (float)s};
        }
        if (F.gw < NL) { const int l = F.gw;
            const float a = wave_sum(F.in[I_LQ1][l * 64 + F.lane] * F.in[I_LK1][l * 64 + F.lane]), b = wave_sum(F.in[I_LQ2][l * 64 + F.lane] * F.in[I_LK2][l * 64 + F.lane]);
            const float lam_init = 0.8f - 0.6f * (float)dexp(-0.3 * (double)l);
            if (F.lane == 0) ((float*)(F.ws + WS_LAMV))[l] = (float)(dexp((double)a) - dexp((double)b)) + lam_init; }
    }
    GRID_BAR();
    for (int it = F.gw * 64 + F.lane; it < NL * 2 * 12288; it += F.NGW * 64) { const int j = it % 12288, ls = it / 12288, l = ls >> 1;
        float s = F.in[I_BADA][l * 12288 + j]; const float* P = (const float*)(F.ws + WS_MODP) + (size_t)ls * 12288 + j;
        for (int sl = 0; sl < MOD_SLABS; ++sl) s += P[(size_t)sl * NL * 2 * 12288];
        ((float*)(F.ws + WS_MOD))[it] = s; }
#pragma nounroll
    for (int pass_ = 0; pass_ < 2; ++pass_) {
        if ((pass_ == 0) == ((F.wave & 1) != 0)) {
            for (int it = F.gw * 64 + F.lane; it < NL * 64 * 2 * 256; it += F.NGW * 64) s5_ktab_item(F, it);
            for (int it = F.gw * 64 + F.lane; it < NL * 64 * 256 * 32; it += 4 * F.NGW * 64) { s5_etab_items<4>(F, it, F.NGW * 64, NL * 64 * 256 * 32); s5_gtab_items<4>(F, it, F.NGW * 64, NL * 64 * 256 * 32); }
        } else {
            for (int it = F.gw; it < NL * IT_LAYER; it += F.NGW) convert_item(F, it, wscr);
        }
    }
    GRID_BAR();
    for (int c = F.gw * 64 + F.lane; c < 2 * DM; c += F.NGW * 64) ((float*)(F.ws + WS_IDAFF))[c] = c < DM ? 1.f : 0.f;
#pragma nounroll
    for (int pass_ = 0; pass_ < 2; ++pass_) {
        if ((pass_ == 0) == ((F.wave & 1) != 0)) {
            for (int it = F.gw * 64 + F.lane; it < NL * 64 * 256 * 32; it += 4 * F.NGW * 64) s5_ttab_items<4>(F, it, F.NGW * 64, NL * 64 * 256 * 32);
        } else {
        for (int t = F.gw; t < NT; t += F.NGW) { const bool lat = t < NLAT; const float* md = (const float*)(F.ws + WS_MOD) + (lat ? 0 : 12288);
            const float* xr = lat ? F.in[I_X] + (size_t)t * DM : F.in[I_CTX] + (size_t)(t - NLAT) * DM;
            modulate_row(F.lane, xr, (lat ? (float*)(F.ws + WS_T) : (float*)(F.ws + WS_XRES)) + (size_t)t * DM, (bf16_t*)(F.ws + WS_H) + (size_t)t * DM, (unsigned char*)(F.ws + WS_H8) + (size_t)t * DM, md, md + DM);
            if (lat && F.lane == 0) { f32x2 st = {0.f, 1.f}; *(f32x2*)((float*)(F.ws + WS_STATS) + 2 * t) = st; } }
        }
    }
    GRID_BAR();

    for (int l = 0; l < NL; ++l) {
        GAS unsigned char* wl = F.ws + WS_W + (size_t)l * W_LAYER;
        const bool last = (l == NL - 1);
        const int Mrows = last ? NLAT : NT;
        const float* modl = (const float*)(F.ws + WS_MOD) + (size_t)l * 2 * 12288;
        { int k8_ = DM / 2; asm volatile("" : "+s"(k8_));
          pg8::Gemm g{(const bf16_t*)(F.ws + WS_H8), (const bf16_t*)(wl + W_IN8), NT, 9728, k8_, DM / 2, DM / 2}; pg8::WinOrder S; S.init(NT, 9728, F.G, (int)blockIdx.x);
          pg8::EpiIn E{(bf16_t*)(F.ws + WS_Z), (bf16_t*)(F.ws + WS_AP), 1, 1.f / 64.f};
          pg8::gemm_phase<pg8::EpiIn, pg8::WinOrder, true, true, true>(F.lds, g, S, E); }
        { pg8::Gemm g{(const bf16_t*)(F.ws + WS_H), (const bf16_t*)(wl + W_IN), NT, 2048, DM}; pg8::StaticOrder S; S.init(NT, 2048, F.G, ((int)blockIdx.x + 16) % F.G);
          pg8::EpiIn E{(bf16_t*)(F.ws + WS_Z), (bf16_t*)(F.ws + WS_AP), 0, 1.f};
          pg8::gemm_phase<pg8::EpiIn, pg8::StaticOrder, true, true, false>(F.lds, g, S, E); }
        GRID_BAR();
        for (int t = F.gw; t < NT; t += F.NGW) prep_row(F, l, t);
        for (int t = F.gw; t < 10 * 132 * 4; t += F.NGW) vt8_task(F, t, F.lds + F.wave * 16384);
        { __syncthreads(); int ks_ = 256; asm volatile("" : "+s"(ks_));
          pg8::Gemm g{(const bf16_t*)(F.ws + WS_AP), (const bf16_t*)(F.ws + WS_ETAB) + (size_t)l * 64 * 256 * 256, 64 * 768, 64 * 256, ks_, 512, 256}; pg8::S5Order S; S.init(3, F.G, (int)blockIdx.x);
          pg8::EpiS E{(float*)(F.ws + WS_S)};
          pg8::gemm_phase<pg8::EpiS, pg8::S5Order, true, true>(F.lds, g, S, E); }
        GRID_BAR();
        for (int t = F.gw; t < 128 * 33; t += F.NGW) s5_scan_task<1>(F, l, t);
        {
            const bf16_t* Z = (const bf16_t*)(F.ws + WS_Z);
#define GQ_UNIT(FAST_) att::attn_dense_body<true, FAST_>((const bf16_t*)((const unsigned char*)(F.ws + WS_QB8) + qrow * 1024 + h * 128), (const bf16_t*)((const unsigned char*)(F.ws + WS_KB8) + krow * 256 + (h >> 2) * 128), \
                (const bf16_t*)((const unsigned char*)(F.ws + WS_VB8T) + ((size_t)(h >> 2) * 132 + (krow >> 6)) * 8192), (bf16_t*)(F.ws + WS_APB) + ((size_t)NT + qrow) * 1024 + h * 128, 1024, seq, 0, 1.f, 8.f, (char*)lds_raw)
#define DA_UNIT(FAST_) att::attn_dense_body<false, FAST_>((const bf16_t*)((const unsigned char*)(F.ws + WS_QKA8) + qrow * 2048 + hs * 64), (const bf16_t*)((const unsigned char*)(F.ws + WS_QKA8) + krow * 2048 + 1024 + hs * 64), \
                (const bf16_t*)((const unsigned char*)(F.ws + WS_VA8T) + ((size_t)(hs >> 1) * 132 + (krow >> 6)) * 8192), (bf16_t*)(F.ws + WS_ODA) + qrow * DM + hs * 128, DM, seq, 0, 1.f, 8.f, (char*)lds_raw)
            unsigned redo = 0u, bit = 1u;
            for (int u = (int)blockIdx.x; u < 256 + (last ? 0 : 24); u += F.G, bit <<= 1) { if (u >= 256 && u < 272) continue;
                const bool cx = u >= 256; const int h = cx ? u - 272 : u >> 5, seq = cx ? NCTX : NT; const size_t qrow = cx ? (size_t)NLAT : (size_t)(u & 31) * 256, krow = cx ? (size_t)NLAT : 0;
                if (GQ_UNIT(true)) redo |= bit;
                __syncthreads();
            }
            bit = 1u << 8;
            for (int u = (int)blockIdx.x; u < 512 + (last ? 0 : 16); u += F.G, bit <<= 1) {
                const bool cx = u >= 512; const int hs = cx ? u - 512 : u >> 5, seq = cx ? NCTX : NT; const size_t qrow = cx ? (size_t)NLAT : (size_t)(u & 31) * 256, krow = cx ? (size_t)NLAT : 0;
                if (DA_UNIT(true)) redo |= bit;
                __syncthreads();
            }
            if (redo & 0xffu) { bit = 1u;
                for (int u = (int)blockIdx.x; u < 256 + (last ? 0 : 24); u += F.G, bit <<= 1) { if (!(redo & bit)) continue;
                    const bool cx = u >= 256; const int h = cx ? u - 272 : u >> 5, seq = cx ? NCTX : NT; const size_t qrow = cx ? (size_t)NLAT : (size_t)(u & 31) * 256, krow = cx ? (size_t)NLAT : 0;
                    GQ_UNIT(false); __syncthreads(); } }
            if (redo >> 8) { bit = 1u << 8;
                for (int u = (int)blockIdx.x; u < 512 + (last ? 0 : 16); u += F.G, bit <<= 1) { if (!(redo & bit)) continue;
                    const bool cx = u >= 512; const int hs = cx ? u - 512 : u >> 5, seq = cx ? NCTX : NT; const size_t qrow = cx ? (size_t)NLAT : (size_t)(u & 31) * 256, krow = cx ? (size_t)NLAT : 0;
                    DA_UNIT(false); __syncthreads(); } }
#undef GQ_UNIT
#undef DA_UNIT
        }
        GRID_BAR();
        { const float lam = ((const float*)(F.ws + WS_LAMV))[l]; const float lam_init = 0.8f - 0.6f * __expf(-0.3f * (float)l);
          for (int t = F.gw; t < 128 * 33; t += F.NGW) s5_scan_task<2>(F, l, t);
          for (int t = F.gw; t < Mrows; t += F.NGW) da_combine_row(F, l, t, lam, 1.f - lam_init); }
        GRID_BAR();
        { pg8::Gemm g{(const bf16_t*)(F.ws + WS_APB), (const bf16_t*)(wl + W_PAB), 2 * NT, 4096, 1024}; pg8::PairOrder S; S.init(Mrows / 256, F.G, (int)blockIdx.x);
          pg8::EpiGate E{(const bf16_t*)(F.ws + WS_Z), (bf16_t*)(F.ws + WS_PG)};
          pg8::gemm_phase<pg8::EpiGate, pg8::PairOrder, true, true>(F.lds, g, S, E); }
        {
          int ky_ = 512; asm volatile("" : "+s"(ky_));
          pg8::Gemm g{(const bf16_t*)(F.ws + WS_AP), (const bf16_t*)(F.ws + WS_BTAB) + (size_t)l * 64 * 256 * 512, 64 * 768, 64 * 256, ky_, 512, 512}; pg8::S5Order S;
          S.init(last ? 2 : 3, F.G, (!last && F.G == 256) ? (int)blockIdx.x - 16 : (int)blockIdx.x);
          pg8::EpiY E{(bf16_t*)(F.ws + WS_AGLU), last ? 512 : 528};
          pg8::gemm_phase<pg8::EpiY, pg8::S5Order, true, true>(F.lds, g, S, E); }
        GRID_BAR();
        { pg8::Gemm g{(const bf16_t*)(F.ws + WS_AGLU), (const bf16_t*)(wl + W_GLU), Mrows, 4096, 1024}; pg8::StaticOrder S; S.init(Mrows, 4096, F.G, (int)blockIdx.x);
          pg8::EpiGlu E{(const bf16_t*)(F.ws + WS_Z), (const bf16_t*)(F.ws + WS_PG), (bf16_t*)(F.ws + WS_MRG)};
          pg8::gemm_phase<pg8::EpiGlu, pg8::StaticOrder, true, true>(F.lds, g, S, E); }
        GRID_BAR();
        { pg8::Gemm g{(const bf16_t*)(F.ws + WS_MRG), (const bf16_t*)(wl + W_O), Mrows, DM, DM}; pg8::ResSplitOrder S; S.init(DM, F.G, (int)blockIdx.x, !last, SPLIT_O, (DM / 64) / SPLIT_O);
          const float* pg_ = l == 0 ? (const float*)(F.ws + WS_IDAFF) : F.in[I_LNFG] + (l - 1) * DM; const float* pb_ = l == 0 ? (const float*)(F.ws + WS_IDAFF) + DM : F.in[I_LNFB] + (l - 1) * DM;
          pg8::EpiRes E{(const float*)(F.ws + WS_STATS), pg_, pb_, (float*)(F.ws + WS_T), modl + 2 * DM, modl + 12288 + 2 * DM, (float*)(F.ws + WS_SLAB)};
          pg8::gemm_phase<pg8::EpiRes, pg8::ResSplitOrder, true, true>(F.lds, g, S, E); }
        GRID_BAR();
        {
        for (int t = F.gw; t < NLAT; t += F.NGW)
            ln_row(F.lane, (const float*)(F.ws + WS_T) + (size_t)t * DM, (float*)nullptr, (bf16_t*)(F.ws + WS_H) + (size_t)t * DM,
                   F.in[I_LNMG] + l * DM, F.in[I_LNMB] + l * DM, modl + 3 * DM, modl + 4 * DM, (unsigned char*)nullptr, (float*)(F.ws + WS_STATS) + 2 * t);
        if (!last) for (int r = (int)blockIdx.x; r < NCTX; r += F.G) { const float* md = modl + 12288;
            ln_ctx_row(F, r, (const float*)(F.ws + WS_SLAB), SPLIT_O, md + 2 * DM, F.in[I_LNMG] + l * DM, F.in[I_LNMB] + l * DM, md + 3 * DM, md + 4 * DM, false); }
        }
        GRID_BAR();
        { pg8::Gemm g{(const bf16_t*)(F.ws + WS_H), (const bf16_t*)(wl + W_GU), Mrows, 2 * FF, DM}; pg8::StaticOrder S; S.init(Mrows, 2 * FF, F.G, (int)blockIdx.x);
          pg8::EpiSwi E{(bf16_t*)(F.ws + WS_ACT)};
          pg8::gemm_phase<pg8::EpiSwi, pg8::StaticOrder, true, true>(F.lds, g, S, E); }
        GRID_BAR();
        { pg8::Gemm g{(const bf16_t*)(F.ws + WS_ACT), (const bf16_t*)(wl + W_DN), Mrows, DM, FF}; pg8::ResSplitOrder S; S.init(DM, F.G, (int)blockIdx.x, !last, SPLIT_D, (FF / 64) / SPLIT_D);
          pg8::EpiRes E{(const float*)(F.ws + WS_STATS), F.in[I_LNMG] + l * DM, F.in[I_LNMB] + l * DM, (float*)(F.ws + WS_T), modl + 5 * DM, modl + 12288 + 5 * DM, (float*)(F.ws + WS_SLAB)};
          pg8::gemm_phase<pg8::EpiRes, pg8::ResSplitOrder, true, true>(F.lds, g, S, E); }
        GRID_BAR();
        {
        for (int t = F.gw; t < NLAT; t += F.NGW) { const float* mdn = modl + 2 * 12288;
            float* dst = last ? (float*)(F.out + (size_t)t * DM) : (float*)nullptr;
            ln_row(F.lane, (const float*)(F.ws + WS_T) + (size_t)t * DM, dst, last ? (bf16_t*)nullptr : (bf16_t*)(F.ws + WS_H) + (size_t)t * DM,
                   F.in[I_LNFG] + l * DM, F.in[I_LNFB] + l * DM, mdn, mdn + DM, last ? (unsigned char*)nullptr : (unsigned char*)(F.ws + WS_H8) + (size_t)t * DM, (float*)(F.ws + WS_STATS) + 2 * t); }
        if (!last) for (int r = (int)blockIdx.x; r < NCTX; r += F.G) { const float* mdn = modl + 3 * 12288;
            ln_ctx_row(F, r, (const float*)(F.ws + WS_SLAB), SPLIT_D, modl + 12288 + 5 * DM, F.in[I_LNFG] + l * DM, F.in[I_LNFB] + l * DM, mdn, mdn + DM, true); }
        }
        if (!last) GRID_BAR();
    }
}

extern "C" void kernel_launch(void* const* d_in, const int* in_sizes, int n_in, void* d_out, int out_size, void* d_ws, size_t ws_size, hipStream_t stream) {
    static int grid = 0;
    if (grid == 0) {
        if (n_in != 33 || out_size != NLAT * DM || ws_size < WS_END) { fprintf(stderr, "kernel_launch: built for 33 inputs, out %d, ws >= %zu; got n_in %d out %d ws %zu\n", NLAT * DM, (size_t)WS_END, n_in, out_size, ws_size); grid = -1; return; }
        int dev = 0, cus = 0;
        if (hipGetDevice(&dev) != hipSuccess || hipDeviceGetAttribute(&cus, hipDeviceAttributeMultiprocessorCount, dev) != hipSuccess) { grid = -1; return; }
        if (hipFuncSetAttribute((const void*)hyb_fwd, hipFuncAttributeMaxDynamicSharedMemorySize, LDS_BYTES) != hipSuccess) { fprintf(stderr, "kernel_launch: hipFuncSetAttribute failed\n"); grid = -1; return; }
        int per_cu = 0;
        if (hipOccupancyMaxActiveBlocksPerMultiprocessor(&per_cu, (const void*)hyb_fwd, NTHR, LDS_BYTES) != hipSuccess || per_cu < 1) { fprintf(stderr, "kernel_launch: occupancy query says %d\n", per_cu); }
        (void)hipGetLastError();
        grid = cus;
    }
    if (grid < 0) return;
    (void)hipMemsetAsync((char*)d_ws + WS_CTL, 0, CTL_ZERO_BYTES, stream);
    Args a{};
    for (int i = 0; i < 33; ++i) a.in[i] = (const float*)d_in[i];
    a.out = (float*)d_out; a.ws = (unsigned char*)d_ws;
    hipLaunchKernelGGL(hyb_fwd, dim3(grid), dim3(NTHR), LDS_BYTES, stream, a);
}
```

```cpp
#include <hip/hip_runtime.h>
#include <cstdio>
#include <cstdint>

#define LAS __attribute__((address_space(3)))
#define GAS __attribute__((address_space(1)))
typedef unsigned short bf16_t;
typedef short bf16x8 __attribute__((ext_vector_type(8)));
typedef short s16x4 __attribute__((ext_vector_type(4)));
typedef float f32x4 __attribute__((ext_vector_type(4)));
typedef float f32x2 __attribute__((ext_vector_type(2)));
typedef float f32x16 __attribute__((ext_vector_type(16)));
typedef unsigned u32x4 __attribute__((ext_vector_type(4)));
typedef unsigned u32x2 __attribute__((ext_vector_type(2)));

constexpr int NT = 8448, NLAT = 8192, NCTX = 256, DM = 2048, NIN = 11776, FF = 5632, NL = 4;
constexpr int C_QA = 0, C_KA = 1024, C_VA = 2048, C_QB = 3072, C_KB = 4096, C_VB = 4352, C_U = 4608, C_G = 5632;
constexpr float DN_ALPHA = 1.6817928305074290f;
constexpr int NWAVES = 8, NTHR = 512;
constexpr int MOD_SLABS = 32;

constexpr size_t al256(size_t x) { return (x + 255) & ~(size_t)255; }
constexpr size_t WS_CTL = 0, CTL_ZERO_BYTES = 1u << 20;
constexpr size_t WS_MODP = CTL_ZERO_BYTES;
constexpr size_t WS_MOD = WS_MODP + al256((size_t)MOD_SLABS * NL * 2 * 12288 * 4);
constexpr size_t WS_LAMV = WS_MOD + al256((size_t)NL * 2 * 12288 * 4);
constexpr size_t WS_ROPE_DA = WS_LAMV + 256;
constexpr size_t WS_ROPE_GQ = WS_ROPE_DA + 128 * 16 * 8;
constexpr size_t WS_LAM = WS_ROPE_GQ + 128 * 32 * 8;
constexpr size_t WS_BB = WS_LAM + (size_t)NL * 2 * 64 * 64 * 16;
constexpr size_t WS_CC = WS_BB + (size_t)NL * 2 * 64 * 128 * 16 * 2;
constexpr size_t WS_F = WS_CC + (size_t)NL * 64 * 16 * 256 * 2;
constexpr size_t WS_W = al256(WS_F + (size_t)2 * 66 * 64 * 64 * 8);
__host__ __device__ constexpr bool win_tile_fp8(int pt) { return !((pt >= 8 && pt < 12) || (pt >= 18 && pt < 22)); }
__host__ __device__ constexpr int win_tile_slot(int pt) { return pt < 8 ? pt : pt < 12 ? pt - 8 : pt < 18 ? pt - 4 : pt < 22 ? pt - 14 : pt - 8; }
__host__ __device__ constexpr int win_fp8_tile(int j) { return j < 8 ? j : j < 14 ? j + 4 : j + 8; }
__host__ __device__ constexpr int win_bf16_tile(int j) { return j < 4 ? j + 8 : j + 14; }
constexpr size_t W_IN = 0;
constexpr size_t W_PAB = W_IN + (size_t)2048 * DM * 2;
constexpr size_t W_GLU = W_PAB + (size_t)4096 * 1024 * 2;
constexpr size_t W_O = W_GLU + (size_t)4096 * 1024 * 2;
constexpr size_t W_GU = W_O + (size_t)DM * DM * 2;
constexpr size_t W_DN = W_GU + (size_t)2 * FF * DM * 2;
constexpr size_t W_IN8 = W_DN + (size_t)DM * FF * 2;
constexpr size_t W_LAYER = W_IN8 + (size_t)9728 * DM;
constexpr size_t WS_XRES = al256(WS_W + NL * W_LAYER);
constexpr size_t WS_H = WS_XRES + (size_t)NT * DM * 4;
constexpr size_t WS_Z = WS_H + (size_t)NT * DM * 2;
constexpr size_t WS_ODA = WS_Z + (size_t)NT * NIN * 2;
constexpr size_t WS_APB = WS_ODA + (size_t)NT * DM * 2;
constexpr size_t WS_AGLU = WS_APB + (size_t)2 * NT * 1024 * 2;
constexpr size_t WS_PG = WS_AGLU + (size_t)NT * 1024 * 2;
constexpr size_t WS_MRG = WS_PG + (size_t)2 * NT * DM * 2;
constexpr size_t WS_T = WS_MRG + (size_t)NT * DM * 2;
constexpr size_t WS_ACT = WS_T + (size_t)NT * DM * 4;
constexpr size_t WS_SLAB = WS_ACT + (size_t)NT * FF * 2;
constexpr int SPLIT_O = 16, SPLIT_D = 22;
constexpr size_t WS_POW = WS_SLAB + (size_t)SPLIT_D * NCTX * DM * 4;
constexpr size_t WS_BBF = WS_POW + (size_t)NL * 2 * 64 * 17 * 64 * 8;
constexpr size_t WS_KTAB = WS_BBF + (size_t)NL * 2 * 64 * 64 * 16 * 8;
constexpr size_t WS_ETAB = WS_KTAB + (size_t)NL * 64 * 2 * 16 * 256 * 4;
constexpr size_t WS_BTAB = WS_ETAB + (size_t)NL * 64 * 256 * 256 * 2;
constexpr size_t WS_AP = WS_BTAB + (size_t)NL * 64 * 256 * 512 * 2;
constexpr size_t WS_S = WS_AP + (size_t)64 * 768 * 512 * 2;
constexpr size_t WS_H8 = WS_S + (size_t)64 * 768 * 256 * 4;
constexpr size_t WS_QB8 = WS_H8 + (size_t)NT * DM;
constexpr size_t WS_KB8 = WS_QB8 + (size_t)NT * 1024;
constexpr size_t WS_QKA8 = WS_KB8 + (size_t)NT * 256;
constexpr size_t WS_VB8T = WS_QKA8 + (size_t)NT * 2048;
constexpr size_t WS_VA8T = WS_VB8T + (size_t)2 * 132 * 128 * 64;
constexpr size_t WS_STATS = WS_VA8T + (size_t)8 * 132 * 128 * 64;
constexpr size_t WS_IDAFF = WS_STATS + (size_t)NLAT * 8;
constexpr size_t WS_END = WS_IDAFF + (size_t)2 * DM * 4;

constexpr int CW_TMO = 0, CW_BAR = 4096;

__device__ __forceinline__ unsigned f2bf(float f) { unsigned u = __builtin_bit_cast(unsigned, f); return (u + 0x7fffu + ((u >> 16) & 1u)) >> 16; }
__device__ __forceinline__ unsigned pk2(float lo, float hi) { return f2bf(lo) | (f2bf(hi) << 16); }
typedef float f32x2_ __attribute__((ext_vector_type(2))); typedef __bf16 bf16x2_ __attribute__((ext_vector_type(2)));
__device__ __forceinline__ unsigned cvt_pk_bf16(float lo, float hi) { const f32x2_ v = {lo, hi}; return __builtin_bit_cast(unsigned, __builtin_convertvector(v, bf16x2_)); }
__device__ __forceinline__ float bflo(unsigned w) { return __builtin_bit_cast(float, w << 16); }
__device__ __forceinline__ float bfhi(unsigned w) { return __builtin_bit_cast(float, w & 0xffff0000u); }
__device__ __forceinline__ void unpack8(u32x4 w, float (&f)[8]) { f[0] = bflo(w.x); f[1] = bfhi(w.x); f[2] = bflo(w.y); f[3] = bfhi(w.y); f[4] = bflo(w.z); f[5] = bfhi(w.z); f[6] = bflo(w.w); f[7] = bfhi(w.w); }
__device__ __forceinline__ u32x4 pack8(const float (&f)[8]) { u32x4 w; w.x = cvt_pk_bf16(f[0], f[1]); w.y = cvt_pk_bf16(f[2], f[3]); w.z = cvt_pk_bf16(f[4], f[5]); w.w = cvt_pk_bf16(f[6], f[7]); return w; }
__device__ __forceinline__ unsigned pk4_fp8(float a, float b, float c, float d) { int w = __builtin_amdgcn_cvt_pk_fp8_f32(a, b, 0, false); w = __builtin_amdgcn_cvt_pk_fp8_f32(c, d, w, true); return (unsigned)w; }
__device__ __forceinline__ float sigmoidf_(float x) { return __builtin_amdgcn_rcpf(1.f + __builtin_amdgcn_exp2f(-1.4426950408889634f * x)); }
__device__ __forceinline__ float siluf_(float x) { return x * sigmoidf_(x); }
__device__ __forceinline__ float gelu_tanh(float x) { const float z = 0.7978845608028654f * (x + 0.044715f * x * x * x); return x * sigmoidf_(2.f * z); }
__device__ __forceinline__ float wave_sum(float v) {
#pragma unroll
    for (int o = 1; o < 64; o <<= 1) v += __shfl_xor(v, o);
    return v;
}
__device__ __forceinline__ int opaque_tid() { int t = threadIdx.x; asm volatile("" : "+v"(t)); return t; }
#define LDS_WAIT() asm volatile("s_waitcnt lgkmcnt(0)" ::: "memory")
#define VM_WAIT() asm volatile("s_waitcnt vmcnt(0)" ::: "memory")

__device__ __forceinline__ void dsincos(double x, double& s, double& c) {
    const double inv2pi = 0.15915494309189533577, twopi = 6.283185307179586476925;
    double r = x * inv2pi; r = r - __builtin_rint(r); r *= twopi;
    double sg = 1.0;
    if (r > 1.5707963267948966) { r = 3.141592653589793 - r; sg = -1.0; } else if (r < -1.5707963267948966) { r = -3.141592653589793 - r; sg = -1.0; }
    const double r2 = r * r;
    double ss = 1.0, cc = 1.0, ts = 1.0, tc = 1.0;
#pragma unroll
    for (int k = 1; k <= 12; ++k) { tc *= -r2 / (double)((2 * k - 1) * (2 * k)); ts *= -r2 / (double)((2 * k) * (2 * k + 1)); cc += tc; ss += ts; }
    s = ss * r; c = sg * cc;
}
__device__ __forceinline__ double dexp(double x) {
    const double n = __builtin_rint(x * 1.4426950408889634);
    const double r = x - n * 0.6931471805599453094;
    double t = 1.0, sum = 1.0;
#pragma unroll
    for (int k = 1; k <= 14; ++k) { t *= r / (double)k; sum += t; }
    return __builtin_ldexp(sum, (int)n);
}

namespace pg8 {
constexpr int BM = 256, BK = 64, HALF = 128, HTB = HALF * BK * 2, STAGE_BYTES = 8 * HTB, NXCD = 8, WGM = 8;
__host__ __device__ __forceinline__ int lds_byte(int r, int c) { const int st = (r >> 4) * 2 + (c >> 5), rr = r & 15, cc = c & 31, ob = rr * 64 + cc * 2; return st * 1024 + (ob ^ (((ob >> 9) & 1) << 5)); }
__host__ __device__ __forceinline__ void stage_rc(int b, int& R, int& C) { const int st = b / 1024, sb = b % 1024, swz = sb ^ (((sb >> 9) & 1) << 5); R = (st >> 1) * 16 + swz / 64; C = (st & 1) * 32 + (swz % 64) / 2; }
__host__ __device__ __forceinline__ int perm32(int rho) { const int n = rho >> 4, i = rho & 15; return 8 * (i >> 2) + 4 * n + (i & 3); }
struct Unit { int pm, pn, kt0, nt; };
struct Gemm { const bf16_t* A; const bf16_t* Bt; int M, N, K, lda, ldb; };
struct StaticOrder {
    int nM, nN, nwg, G, c;
    __host__ __device__ void init(int M, int N, int G_, int c_) { nM = M / BM; nN = N / BM; nwg = nM * nN; G = G_; c = c_; }
    __host__ __device__ bool next(int i, Unit& u) const { const long L = (long)i * G + c; if (L >= nwg) return false; unit((int)L, u); return true; }
    __host__ __device__ void unit(int L, Unit& u) const {
        int wgid = L; { const int q = nwg / NXCD, r = nwg % NXCD, xcd = wgid % NXCD, off = wgid / NXCD; wgid = (xcd < r ? xcd * (q + 1) : r * (q + 1) + (xcd - r) * q) + off; }
        const int nig = WGM * nN, gid = wgid / nig, fm = gid * WGM, gsz = (nM - fm) < WGM ? (nM - fm) : WGM;
        u.pm = fm + ((wgid % nig) % gsz); u.pn = (wgid % nig) / gsz; u.kt0 = 0; u.nt = 0;
    }
    __device__ __forceinline__ void a_ready(const Unit&) const {}
    __device__ __forceinline__ void done(const Unit&) const {}
};
struct WinOrder {
    StaticOrder b;
    __host__ __device__ void init(int M, int N, int G_, int c_) { b.init(M, N, G_, c_); }
    __host__ __device__ bool next(int i, Unit& u) const {
        if (b.G != 256) return b.next(i, u);
        const int c = b.c; int L;
        if (i < 3) L = i * 256 + c;
        else if (i == 3) { if (c >= 240 && c < 248) return false; L = 768 + c; }
        else if (i == 4) { if (c < 230) L = 1024 + c; else if (c < 238) L = 768 + c + 10; else return false; }
        else return false;
        b.unit(L, u); return true;
    }
    __device__ __forceinline__ void a_ready(const Unit&) const {}
    __device__ __forceinline__ void done(const Unit&) const {}
};
struct PairOrder {
    int nM, nwg, G, c;
    __host__ __device__ void init(int nM_, int G_, int c_) { nM = nM_; nwg = 2 * nM_ * 8; G = G_; c = c_; }
    __host__ __device__ bool next(int i, Unit& u) const {
        if (nM == 33 && G == 256) {
            if (i < 2) { const int L = i * 256 + c, which = L >> 8, r = L & 255; u.pm = 33 * which + (r & 31); u.pn = 8 * which + (r >> 5); u.kt0 = 0; u.nt = 0; return true; }
            if (i == 2 && c < 16) { const int which = c >> 3; u.pm = 33 * which + 32; u.pn = 8 * which + (c & 7); u.kt0 = 0; u.nt = 0; return true; }
            return false;
        }
        const long L = (long)i * G + c; if (L >= nwg) return false;
        const int per = nM * 8, which = (int)L / per, r = (int)L % per;
        u.pm = 33 * which + (r % nM); u.pn = 8 * which + (r / nM); u.kt0 = 0; u.nt = 0; return true;
    }
    __device__ __forceinline__ void a_ready(const Unit&) const {}
    __device__ __forceinline__ void done(const Unit&) const {}
};

struct ResSplitOrder {
    StaticOrder lat; int G, c, S, ntS; bool ctx;
    __host__ __device__ void init(int N, int G_, int c_, bool ctx_, int S_, int ntS_) { lat.init(8192, N, G_, c_); G = G_; c = c_; ctx = ctx_; S = S_; ntS = ntS_; }
    __host__ __device__ bool next(int i, Unit& u) const {
        const long L = (long)i * G + c;
        if (L < lat.nwg) return lat.next(i, u);
        const int j = (int)(L - lat.nwg); if (!ctx || j >= 8 * S) return false;
        u.pm = 32; u.pn = j & 7; u.kt0 = (j >> 3) * ntS; u.nt = ntS; return true;
    }
    __device__ __forceinline__ void a_ready(const Unit&) const {}
    __device__ __forceinline__ void done(const Unit&) const {}
};
struct S5Order {
    int nmt, G, c;
    __host__ __device__ void init(int nmt_, int G_, int c_) { nmt = nmt_; G = G_; c = c_; }
    __host__ __device__ bool next(int i, Unit& u) const {
        const long L = (long)i * G + c; if (c < 0 || L >= 64 * nmt) return false;
        const int g = (int)L / nmt, mt = (int)L % nmt; u.pm = 3 * g + mt; u.pn = g; u.kt0 = 0; u.nt = 0; return true;
    }
    __device__ __forceinline__ void a_ready(const Unit&) const {}
    __device__ __forceinline__ void done(const Unit&) const {}
};
template <class Epi, class Sched, bool ALIGN_EPI = false, bool SP2 = false, bool FP8 = false>
__device__ __forceinline__ void gemm_phase(LAS unsigned char* lds, const Gemm g, const Sched& S, const Epi& E) {
    const int tid = opaque_tid(), wid = __builtin_amdgcn_readfirstlane(tid >> 6), lane = tid & 63, wr = wid >> 2, wc = wid & 3, fr = lane & 15, fq = lane >> 4;
    const int K = g.K, nt = K / BK, lda = g.lda ? g.lda : K, ldb = g.ldb ? g.ldb : K;
    unsigned voffA[2], voffB[2];
#pragma unroll
    for (int i = 0; i < 2; ++i) { int R, C; stage_rc(tid * 16 + i * 8192, R, C); const int Rb = Epi::PERM ? ((R & ~31) + perm32(R & 31)) : R;
        voffA[i] = (unsigned)(R * lda + C) * 2u; voffB[i] = (unsigned)(Rb * ldb + C) * 2u; }
    const size_t kstep = (size_t)(BK * 2);
    const size_t hstepA = (size_t)HALF * lda * 2, hstepB = (size_t)HALF * ldb * 2;
    const size_t tstepA = 2 * hstepA, tstepB = 2 * hstepB;
    const unsigned ldsw = (unsigned)wid * 1024u;
    const int aoff = lds_byte(wr * 64 + fr, fq * 8), boff = lds_byte(wc * 32 + fr, fq * 8);
#define PG8_SA(b, h) (((b) * 2 + (h)) * HTB)
#define PG8_SB(b, h) ((4 + (b) * 2 + (h)) * HTB)
#define PG8_STAGE(bufoff, gbase, voff) do { _Pragma("unroll") for (int _i = 0; _i < 2; ++_i) \
        __builtin_amdgcn_global_load_lds((const unsigned*)((const char*)(gbase) + (voff)[_i]), (LAS unsigned*)(lds + (bufoff) + ldsw + _i * 8192), 16, 0, 0); } while (0)
    typedef int v8i_ __attribute__((ext_vector_type(8))); typedef int v4i_ __attribute__((ext_vector_type(4)));
#define PG8_LDA(dst, b, h) do { _Pragma("unroll") for (int m = 0; m < 4; ++m) { const v4i_ lo_ = *(const LAS v4i_*)(lds + PG8_SA(b, h) + aoff + m * 2048), hi_ = *(const LAS v4i_*)(lds + PG8_SA(b, h) + aoff + m * 2048 + 1024); \
        dst[m] = __builtin_shufflevector(lo_, hi_, 0, 1, 2, 3, 4, 5, 6, 7); } } while (0)
#define PG8_LDB(dst, b, h) do { _Pragma("unroll") for (int n = 0; n < 2; ++n) { const v4i_ lo_ = *(const LAS v4i_*)(lds + PG8_SB(b, h) + boff + n * 2048), hi_ = *(const LAS v4i_*)(lds + PG8_SB(b, h) + boff + n * 2048 + 1024); \
        dst[n] = __builtin_shufflevector(lo_, hi_, 0, 1, 2, 3, 4, 5, 6, 7); } } while (0)
#define PG8_HALF(v, k) __builtin_bit_cast(bf16x8, (k) == 0 ? __builtin_shufflevector(v, v, 0, 1, 2, 3) : __builtin_shufflevector(v, v, 4, 5, 6, 7))
#define PG8_MMA(ai, bj, At, Bt) do { __builtin_amdgcn_s_setprio(1); _Pragma("unroll") for (int m = 0; m < 4; ++m) _Pragma("unroll") for (int n = 0; n < 2; ++n) { \
        if constexpr (FP8) asm volatile("v_mfma_scale_f32_16x16x128_f8f6f4 %0, %1, %2, %0, %3, %3 op_sel_hi:[0,0,0]" : "+v"(acc[ai][bj][m][n]) : "v"(Bt[n]), "v"(At[m]), "v"(one_scale));   \
        else { acc[ai][bj][m][n] = __builtin_amdgcn_mfma_f32_16x16x32_bf16(PG8_HALF(Bt[n], 0), PG8_HALF(At[m], 0), acc[ai][bj][m][n], 0, 0, 0); \
               acc[ai][bj][m][n] = __builtin_amdgcn_mfma_f32_16x16x32_bf16(PG8_HALF(Bt[n], 1), PG8_HALF(At[m], 1), acc[ai][bj][m][n], 0, 0, 0); } } \
        __builtin_amdgcn_s_setprio(0); } while (0)
#define PG8_WAIT_V(n) asm volatile("s_waitcnt vmcnt(" #n ")" ::: "memory")
#define PG8_WAIT_L(n) asm volatile("s_waitcnt lgkmcnt(" #n ")" ::: "memory")
#define PG8_BAR __builtin_amdgcn_s_barrier()
#define PG8_SCHED __builtin_amdgcn_sched_barrier(0)
    Unit cur, nxt; int ui = 0;
    if (!S.next(0, cur)) return;
    f32x4 acc[2][2][4][2];
#pragma unroll
    for (int a = 0; a < 2; ++a)
#pragma unroll
        for (int b = 0; b < 2; ++b)
#pragma unroll
            for (int m = 0; m < 4; ++m)
#pragma unroll
                for (int n = 0; n < 2; ++n) acc[a][b][m][n] = (f32x4){0.f, 0.f, 0.f, 0.f};
    v8i_ At[4], B0[2], B1[2]; const int one_scale = 0x7f7f7f7f; (void)one_scale;
    const char* cA = (const char*)g.A + (size_t)cur.pm * tstepA + (size_t)cur.kt0 * kstep; const char* cB = (const char*)g.Bt + (size_t)cur.pn * tstepB + (size_t)cur.kt0 * kstep;
    S.a_ready(cur);
    if constexpr (SP2) {
        PG8_STAGE(PG8_SB(0, 0), cB, voffB); PG8_STAGE(PG8_SB(0, 1), cB + hstepB, voffB); PG8_STAGE(PG8_SA(0, 0), cA, voffA); PG8_STAGE(PG8_SA(0, 1), cA + hstepA, voffA);
        if (wr == 1) PG8_BAR;
        PG8_WAIT_V(2); PG8_BAR;
        PG8_STAGE(PG8_SB(1, 0), cB + kstep, voffB); PG8_STAGE(PG8_SA(1, 0), cA + kstep, voffA); PG8_STAGE(PG8_SB(1, 1), cB + hstepB + kstep, voffB);
        PG8_WAIT_V(6); PG8_BAR;
    } else {
        PG8_STAGE(PG8_SB(0, 0), cB, voffB); PG8_STAGE(PG8_SA(0, 0), cA, voffA); PG8_STAGE(PG8_SB(0, 1), cB + hstepB, voffB); PG8_STAGE(PG8_SA(0, 1), cA + hstepA, voffA);
        if (wr == 1) PG8_BAR;
        PG8_WAIT_V(4); PG8_BAR;
        PG8_STAGE(PG8_SB(1, 0), cB + kstep, voffB); PG8_STAGE(PG8_SA(1, 0), cA + kstep, voffA); PG8_STAGE(PG8_SB(1, 1), cB + hstepB + kstep, voffB);
        PG8_WAIT_V(6); PG8_BAR;
    }
    for (;;) {
        const bool has_next = S.next(ui + 1, nxt);
        const char* nA = has_next ? (const char*)g.A + (size_t)nxt.pm * tstepA + (size_t)nxt.kt0 * kstep : cA; const char* nB = has_next ? (const char*)g.Bt + (size_t)nxt.pn * tstepB + (size_t)nxt.kt0 * kstep : cB;
        const int ntu = cur.nt ? cur.nt : nt;
        for (int t = 0; t < ntu; t += 2) {
            const bool last = (t == ntu - 2);
            const char* a1 = cA + (size_t)(t + 1) * kstep;
            const char* a2 = last ? nA : cA + (size_t)(t + 2) * kstep; const char* b2 = last ? nB : cB + (size_t)(t + 2) * kstep;
            const char* a3 = a2 + kstep; const char* b3 = b2 + kstep;
            if (last && has_next) S.a_ready(nxt);
            if constexpr (SP2) {
            PG8_LDB(B0, 0, 0); PG8_LDB(B1, 0, 1); PG8_SCHED; PG8_LDA(At, 0, 0); PG8_STAGE(PG8_SA(1, 1), a1 + hstepA, voffA);
            PG8_WAIT_V(8); PG8_WAIT_L(0); PG8_BAR; PG8_MMA(0, 0, At, B0); PG8_MMA(0, 1, At, B1); PG8_BAR; PG8_SCHED;
            PG8_LDA(At, 0, 1); PG8_STAGE(PG8_SB(0, 0), b2, voffB); PG8_STAGE(PG8_SB(0, 1), b2 + hstepB, voffB); PG8_STAGE(PG8_SA(0, 0), a2, voffA);
            PG8_WAIT_V(8); PG8_WAIT_L(0); PG8_BAR; PG8_MMA(1, 0, At, B0); PG8_MMA(1, 1, At, B1); PG8_BAR; PG8_SCHED;
            PG8_LDB(B0, 1, 0); PG8_LDB(B1, 1, 1); PG8_SCHED; PG8_LDA(At, 1, 0); PG8_STAGE(PG8_SA(0, 1), a2 + hstepA, voffA);
            PG8_WAIT_V(8); PG8_WAIT_L(0); PG8_BAR; PG8_MMA(0, 0, At, B0); PG8_MMA(0, 1, At, B1); PG8_BAR; PG8_SCHED;
            PG8_LDA(At, 1, 1); PG8_STAGE(PG8_SB(1, 0), b3, voffB); PG8_STAGE(PG8_SB(1, 1), b3 + hstepB, voffB); PG8_STAGE(PG8_SA(1, 0), a3, voffA);
            PG8_WAIT_V(8); PG8_WAIT_L(0); PG8_BAR; PG8_MMA(1, 0, At, B0); PG8_MMA(1, 1, At, B1); PG8_BAR; PG8_SCHED;
            } else {
            PG8_LDB(B0, 0, 0); PG8_SCHED; PG8_LDA(At, 0, 0); PG8_STAGE(PG8_SA(1, 1), a1 + hstepA, voffA);
            PG8_WAIT_L(8); PG8_BAR; PG8_WAIT_L(0); PG8_MMA(0, 0, At, B0); PG8_BAR; PG8_SCHED;
            PG8_LDB(B1, 0, 1); PG8_STAGE(PG8_SB(0, 0), b2, voffB);
            PG8_BAR; PG8_WAIT_L(0); PG8_MMA(0, 1, At, B1); PG8_BAR;
            PG8_LDA(At, 0, 1); PG8_STAGE(PG8_SA(0, 0), a2, voffA);
            PG8_BAR; PG8_WAIT_L(0); PG8_MMA(1, 0, At, B0); PG8_BAR; PG8_SCHED;
            PG8_STAGE(PG8_SB(0, 1), b2 + hstepB, voffB);
            PG8_WAIT_V(6); PG8_BAR; PG8_MMA(1, 1, At, B1); PG8_BAR;
            PG8_LDB(B0, 1, 0); PG8_SCHED; PG8_LDA(At, 1, 0); PG8_STAGE(PG8_SA(0, 1), a2 + hstepA, voffA);
            PG8_WAIT_L(8); PG8_BAR; PG8_WAIT_L(0); PG8_MMA(0, 0, At, B0); PG8_BAR; PG8_SCHED;
            PG8_LDB(B1, 1, 1); PG8_STAGE(PG8_SB(1, 0), b3, voffB);
            PG8_BAR; PG8_WAIT_L(0); PG8_MMA(0, 1, At, B1); PG8_BAR;
            PG8_LDA(At, 1, 1); PG8_STAGE(PG8_SA(1, 0), a3, voffA);
            PG8_BAR; PG8_WAIT_L(0); PG8_MMA(1, 0, At, B0); PG8_BAR; PG8_SCHED;
            PG8_STAGE(PG8_SB(1, 1), b3 + hstepB, voffB);
            PG8_WAIT_V(6); PG8_BAR; PG8_MMA(1, 1, At, B1); PG8_BAR;
            }
        }
        if constexpr (FP8) asm volatile("s_nop 15\n\ts_nop 15" ::: "memory");
        if constexpr (ALIGN_EPI) { if (wr == 0) PG8_BAR; }
        E(acc, cur, wr, wc, fr, fq); S.done(cur);
        if (!has_next) break;
#pragma unroll
        for (int a = 0; a < 2; ++a)
#pragma unroll
            for (int b = 0; b < 2; ++b)
#pragma unroll
                for (int m = 0; m < 4; ++m)
#pragma unroll
                    for (int n = 0; n < 2; ++n) acc[a][b][m][n] = (f32x4){0.f, 0.f, 0.f, 0.f};
        cur = nxt; cA = nA; cB = nB; ++ui;
        if constexpr (ALIGN_EPI) { if (wr == 1) PG8_BAR; }
    }
    PG8_WAIT_V(0);
    if constexpr (!ALIGN_EPI) { if (wr == 0) PG8_BAR; }
    PG8_BAR;
#undef PG8_SA
#undef PG8_SB
#undef PG8_STAGE
#undef PG8_LDA
#undef PG8_LDB
#undef PG8_MMA
#undef PG8_WAIT_V
#undef PG8_WAIT_L
#undef PG8_BAR
#undef PG8_SCHED
}

typedef f32x4 Acc[2][2][4][2];
struct EpiIn {
    static constexpr bool PERM = true;
    bf16_t* Z; bf16_t* AP; int f8; float scale;
    __device__ __forceinline__ void operator()(const Acc& acc, const Unit& u, int wr, int wc, int fr, int fq) const {
        const int pt = f8 ? win_fp8_tile(u.pn) : win_bf16_tile(u.pn), row0 = u.pm * BM + wr * 64 + fr, col0 = pt * BM + wc * 32 + 8 * fq; const bool sg = pt >= 22, s5 = pt >= 18 && pt < 22;
#pragma unroll
        for (int ai = 0; ai < 2; ++ai)
#pragma unroll
            for (int m = 0; m < 4; ++m) { const int row = row0 + ai * HALF + m * 16; bf16_t* rowp = Z + (size_t)row * NIN + col0;
#pragma unroll
                for (int bj = 0; bj < 2; ++bj) { f32x4 v0 = acc[ai][bj][m][0], v1 = acc[ai][bj][m][1];
                    if (sg) {
#pragma unroll
                        for (int j = 0; j < 4; ++j) { v0[j] = sigmoidf_(v0[j] * scale); v1[j] = sigmoidf_(v1[j] * scale); } }
                    else { v0 *= scale; v1 *= scale; }
                    u32x4 w; w.x = cvt_pk_bf16(v0[0], v0[1]); w.y = cvt_pk_bf16(v0[2], v0[3]); w.z = cvt_pk_bf16(v1[0], v1[1]); w.w = cvt_pk_bf16(v1[2], v1[3]);
                    if (s5) { const int cu = col0 + bj * HALF - C_U, g = cu >> 4, h0 = cu & 15;
                        *(u32x4*)(AP + ((size_t)(g * 768 + (row >> 4)) * 512 + (row & 15) * 16 + h0)) = w; }
                    else *(u32x4*)(rowp + bj * HALF) = w; } }
    }
};
struct EpiS {
    static constexpr bool PERM = true;
    float* S;
    __device__ __forceinline__ void operator()(const Acc& acc, const Unit& u, int wr, int wc, int fr, int fq) const {
        const int row0 = u.pm * BM + wr * 64 + fr, col0 = wc * 32 + 8 * fq;
#pragma unroll
        for (int ai = 0; ai < 2; ++ai)
#pragma unroll
            for (int m = 0; m < 4; ++m) { float* p = S + (size_t)(row0 + ai * HALF + m * 16) * 256 + col0;
#pragma unroll
                for (int bj = 0; bj < 2; ++bj) { *(f32x4*)(p + bj * HALF) = acc[ai][bj][m][0]; *(f32x4*)(p + bj * HALF + 4) = acc[ai][bj][m][1]; } }
    }
};
struct EpiY {
    static constexpr bool PERM = true;
    bf16_t* AG; int nchunk;
    __device__ __forceinline__ void operator()(const Acc& acc, const Unit& u, int wr, int wc, int fr, int fq) const {
        const int g = u.pn, c0 = (u.pm - 3 * g) * BM + wr * 64 + fr, n0 = wc * 32 + 8 * fq;
#pragma unroll
        for (int ai = 0; ai < 2; ++ai)
#pragma unroll
            for (int m = 0; m < 4; ++m) { const int c = c0 + ai * HALF + m * 16;
                if (c < nchunk) {
#pragma unroll
                    for (int bj = 0; bj < 2; ++bj) { const int n = n0 + bj * HALF, tt = n >> 4, h0 = n & 15; const f32x4 v0 = acc[ai][bj][m][0], v1 = acc[ai][bj][m][1];
                        u32x4 w; w.x = cvt_pk_bf16(gelu_tanh(v0[0]), gelu_tanh(v0[1])); w.y = cvt_pk_bf16(gelu_tanh(v0[2]), gelu_tanh(v0[3]));
                        w.z = cvt_pk_bf16(gelu_tanh(v1[0]), gelu_tanh(v1[1])); w.w = cvt_pk_bf16(gelu_tanh(v1[2]), gelu_tanh(v1[3]));
                        *(u32x4*)(AG + (size_t)(16 * c + tt) * 1024 + g * 16 + h0) = w; } } }
    }
};
struct EpiGate {
    static constexpr bool PERM = true;
    const bf16_t* Z; bf16_t* PG;
    __device__ __forceinline__ void operator()(const Acc& acc, const Unit& u, int wr, int wc, int fr, int fq) const {
        const int which = u.pm >= 33 ? 1 : 0, pm = u.pm - 33 * which, pn = u.pn - 8 * which;
        const int row0 = pm * BM + wr * 64 + fr, col0 = pn * BM + wc * 32 + 8 * fq;
        const bf16_t* gz = Z + C_G + which * DM + col0; bf16_t* out = PG + (size_t)which * NT * DM + col0;
#pragma unroll
        for (int ai = 0; ai < 2; ++ai)
#pragma unroll
            for (int m = 0; m < 4; ++m) { const size_t row = (size_t)(row0 + ai * HALF + m * 16);
#pragma unroll
                for (int bj = 0; bj < 2; ++bj) { float gt[8]; unpack8(*(const u32x4*)(gz + row * NIN + bj * HALF), gt);
                    const f32x4 v0 = acc[ai][bj][m][0], v1 = acc[ai][bj][m][1];
                    u32x4 w; w.x = cvt_pk_bf16(v0[0] * gt[0], v0[1] * gt[1]); w.y = cvt_pk_bf16(v0[2] * gt[2], v0[3] * gt[3]); w.z = cvt_pk_bf16(v1[0] * gt[4], v1[1] * gt[5]); w.w = cvt_pk_bf16(v1[2] * gt[6], v1[3] * gt[7]);
                    *(u32x4*)(out + row * DM + bj * HALF) = w; } }
    }
};
struct EpiGlu {
    static constexpr bool PERM = true;
    const bf16_t* Z; const bf16_t* PG; bf16_t* MRG;
    __device__ __forceinline__ void operator()(const Acc& acc, const Unit& u, int wr, int wc, int fr, int fq) const {
        const int row0 = u.pm * BM + wr * 64 + fr, mc0 = u.pn * HALF + wc * 32 + 8 * fq;
#pragma unroll
        for (int ai = 0; ai < 2; ++ai)
#pragma unroll
            for (int m = 0; m < 4; ++m) { const size_t row = (size_t)(row0 + ai * HALF + m * 16);
                float g2[8], pa[8], pb[8], o[8];
                unpack8(*(const u32x4*)(Z + row * NIN + C_G + 2 * DM + mc0), g2);
                unpack8(*(const u32x4*)(PG + row * DM + mc0), pa);
                unpack8(*(const u32x4*)(PG + (size_t)NT * DM + row * DM + mc0), pb);
                const f32x4 a0 = acc[ai][0][m][0], a1 = acc[ai][0][m][1], q0 = acc[ai][1][m][0], q1 = acc[ai][1][m][1];
#pragma unroll
                for (int j = 0; j < 4; ++j) { o[j] = pa[j] + pb[j] + g2[j] * a0[j] * sigmoidf_(q0[j]); o[4 + j] = pa[4 + j] + pb[4 + j] + g2[4 + j] * a1[j] * sigmoidf_(q1[j]); }
                *(u32x4*)(MRG + row * DM + mc0) = pack8(o); }
    }
};
struct EpiRes {
    static constexpr bool PERM = true;
    const float* ST; const float* lg; const float* lb; float* T; const float* gv_lat; const float* gv_ctx; float* SLAB;
    __device__ __forceinline__ void operator()(const Acc& acc, const Unit& u, int wr, int wc, int fr, int fq) const {
        const int row0 = u.pm * BM + wr * 64 + fr, col0 = u.pn * BM + wc * 32 + 8 * fq;
        if (u.nt != 0) {
            float* sl = SLAB + ((size_t)(u.kt0 / u.nt) * NCTX + (row0 - NLAT)) * DM + col0;
#pragma unroll
            for (int ai = 0; ai < 2; ++ai)
#pragma unroll
                for (int m = 0; m < 4; ++m) { const size_t off = (size_t)(ai * HALF + m * 16) * DM;
#pragma unroll
                    for (int bj = 0; bj < 2; ++bj) { *(f32x4*)(sl + off + bj * HALF) = acc[ai][bj][m][0]; *(f32x4*)(sl + off + bj * HALF + 4) = acc[ai][bj][m][1]; } }
            return;
        }
        const float* gv = (u.pm == 32 ? gv_ctx : gv_lat) + col0;
#pragma unroll
        for (int bj = 0; bj < 2; ++bj) {
            const f32x4 g0 = *(const f32x4*)(gv + bj * HALF), g1 = *(const f32x4*)(gv + bj * HALF + 4);
            const f32x4 a0 = *(const f32x4*)(lg + col0 + bj * HALF) * DN_ALPHA, a1 = *(const f32x4*)(lg + col0 + bj * HALF + 4) * DN_ALPHA;
            const f32x4 b0 = *(const f32x4*)(lb + col0 + bj * HALF) * DN_ALPHA, b1 = *(const f32x4*)(lb + col0 + bj * HALF + 4) * DN_ALPHA;
#pragma unroll
            for (int ai = 0; ai < 2; ++ai)
#pragma unroll
                for (int m = 0; m < 4; ++m) { const int row = row0 + ai * HALF + m * 16; const size_t off = (size_t)row * DM + col0 + bj * HALF;
                    const f32x2 st = *(const f32x2*)(ST + 2 * row);
                    const f32x4 x0 = *(const f32x4*)(T + off), x1 = *(const f32x4*)(T + off + 4);
                    *(f32x4*)(T + off) = ((x0 - st[0]) * st[1]) * a0 + b0 + g0 * acc[ai][bj][m][0];
                    *(f32x4*)(T + off + 4) = ((x1 - st[0]) * st[1]) * a1 + b1 + g1 * acc[ai][bj][m][1]; } }
    }
};
struct EpiSwi {
    static constexpr bool PERM = true;
    bf16_t* ACT;
    __device__ __forceinline__ void operator()(const Acc& acc, const Unit& u, int wr, int wc, int fr, int fq) const {
        const int row0 = u.pm * BM + wr * 64 + fr, c0 = u.pn * HALF + wc * 32 + 8 * fq;
#pragma unroll
        for (int ai = 0; ai < 2; ++ai)
#pragma unroll
            for (int m = 0; m < 4; ++m) { const size_t row = (size_t)(row0 + ai * HALF + m * 16);
                const f32x4 a0 = acc[ai][0][m][0], a1 = acc[ai][0][m][1], q0 = acc[ai][1][m][0], q1 = acc[ai][1][m][1]; float o[8];
#pragma unroll
                for (int j = 0; j < 4; ++j) { o[j] = siluf_(a0[j]) * q0[j]; o[4 + j] = siluf_(a1[j]) * q1[j]; }
                *(u32x4*)(ACT + row * FF + c0) = pack8(o); }
    }
};
}

namespace att {
constexpr int NW = 8, QBLK = 32, KVBLK = 64;
constexpr int LDQK = NIN;
constexpr size_t SHM_V = KVBLK * 128 * 2, SHM_K = KVBLK * 128 * 2, SHM_ATTN = 2 * SHM_V + 2 * SHM_K + NW * 64 * 4;
#define KSWZ(row, colB) ((row) * 256 + ((colB) ^ (((row) & 7) << 4)))
#define SBAR() __builtin_amdgcn_sched_barrier(0)
__device__ __forceinline__ int crow(int r, int hi) { return (r & 3) + 8 * (r >> 2) + 4 * hi; }
__device__ __forceinline__ unsigned cvtpk(float lo, float hi) { return cvt_pk_bf16(lo, hi); }

__device__ __forceinline__ float max3f(float a, float b, float c) { return __builtin_fmaxf(__builtin_fmaxf(a, b), c); }
template <bool FIRST>
__device__ __forceinline__ void partialSM(f32x16& p0, f32x16& p1, float& m_reg, f32x16& nb, float& alpha, const float thr) {
  float pmax;
  { float a0 = max3f(p0[0], p0[1], p0[2]), a1 = max3f(p0[3], p0[4], p0[5]), a2 = max3f(p0[6], p0[7], p0[8]), a3 = max3f(p0[9], p0[10], p0[11]);
    float a4 = max3f(p0[12], p0[13], p0[14]), a5 = max3f(p0[15], p1[0], p1[1]), a6 = max3f(p1[2], p1[3], p1[4]), a7 = max3f(p1[5], p1[6], p1[7]);
    float a8 = max3f(p1[8], p1[9], p1[10]), a9 = max3f(p1[11], p1[12], p1[13]);
    a0 = max3f(a0, a1, a2); a3 = max3f(a3, a4, a5); a6 = max3f(a6, a7, a8); a9 = max3f(a9, p1[14], p1[15]);
    a0 = max3f(a0, a3, a6); pmax = fmaxf(a0, a9); }
  { auto rr = __builtin_amdgcn_permlane32_swap(__float_as_uint(pmax), __float_as_uint(pmax), false, false);
    pmax = fmaxf(__uint_as_float(rr[0]), __uint_as_float(rr[1])); }
  if (!FIRST && __builtin_expect(__all(pmax <= thr), 1)) { alpha = 1.f; }
  else { const float d = FIRST ? pmax : fmaxf(pmax, 0.f); alpha = FIRST ? 1.f : __builtin_amdgcn_exp2f(-d); m_reg += d;
#pragma unroll
    for (int r = 0; r < 16; ++r) { p0[r] -= d; p1[r] -= d; nb[r] = -m_reg; }
    asm volatile("" : "+v"(nb)); }
#pragma unroll
  for (int r = 0; r < 16; ++r) p0[r] = __builtin_amdgcn_exp2f(p0[r]);
}
template <bool PACK = true>
__device__ __forceinline__ void finishSM(f32x16& p0, f32x16& p1, float alpha, float& l_reg, bf16x8& pa0, bf16x8& pa1, bf16x8& pa2, bf16x8& pa3) {
#pragma unroll
  for (int r = 0; r < 16; ++r) p1[r] = __builtin_amdgcn_exp2f(p1[r]);
  float ps = 0;
#pragma unroll
  for (int r = 0; r < 16; ++r) ps += p0[r];
#pragma unroll
  for (int r = 0; r < 16; ++r) ps += p1[r];
  { auto rr = __builtin_amdgcn_permlane32_swap(__float_as_uint(ps), __float_as_uint(ps), false, false);
    ps = __uint_as_float(rr[0]) + __uint_as_float(rr[1]); }
  l_reg = l_reg * alpha + ps;
#define PK4(P, BASE, OUT) do { u32x4 w = {cvtpk(P[BASE + 0], P[BASE + 1]), cvtpk(P[BASE + 2], P[BASE + 3]), cvtpk(P[BASE + 4], P[BASE + 5]), cvtpk(P[BASE + 6], P[BASE + 7])}; \
    OUT = *reinterpret_cast<bf16x8*>(&w); } while (0)
  if constexpr (PACK) { PK4(p0, 0, pa0); PK4(p0, 8, pa1); PK4(p1, 0, pa2); PK4(p1, 8, pa3); }
#undef PK4
}
__device__ __forceinline__ float rowmax32(const f32x16& p0, const f32x16& p1) {
  float a0 = max3f(p0[0], p0[1], p0[2]), a1 = max3f(p0[3], p0[4], p0[5]), a2 = max3f(p0[6], p0[7], p0[8]), a3 = max3f(p0[9], p0[10], p0[11]);
  float a4 = max3f(p0[12], p0[13], p0[14]), a5 = max3f(p0[15], p1[0], p1[1]), a6 = max3f(p1[2], p1[3], p1[4]), a7 = max3f(p1[5], p1[6], p1[7]);
  float a8 = max3f(p1[8], p1[9], p1[10]), a9 = max3f(p1[11], p1[12], p1[13]);
  a0 = max3f(a0, a1, a2); a3 = max3f(a3, a4, a5); a6 = max3f(a6, a7, a8); a9 = max3f(a9, p1[14], p1[15]);
  a0 = max3f(a0, a3, a6); float pmax = fmaxf(a0, a9);
  auto rr = __builtin_amdgcn_permlane32_swap(__float_as_uint(pmax), __float_as_uint(pmax), false, false);
  return fmaxf(__uint_as_float(rr[0]), __uint_as_float(rr[1]));
}
__device__ __forceinline__ void packP(const f32x16& p0, const f32x16& p1, bf16x8& pa0, bf16x8& pa1, bf16x8& pa2, bf16x8& pa3) {
#define PK4(P, BASE, OUT) do { u32x4 w = {cvtpk(P[BASE + 0], P[BASE + 1]), cvtpk(P[BASE + 2], P[BASE + 3]), cvtpk(P[BASE + 4], P[BASE + 5]), cvtpk(P[BASE + 6], P[BASE + 7])}; \
    OUT = *reinterpret_cast<bf16x8*>(&w); } while (0)
  PK4(p0, 0, pa0); PK4(p0, 8, pa1); PK4(p1, 0, pa2); PK4(p1, 8, pa3);
#undef PK4
}
constexpr float PS_BIG = 4096.f;
__device__ __forceinline__ void halfexp(f32x16& p0) {
#pragma unroll
  for (int r = 0; r < 16; ++r) p0[r] = __builtin_amdgcn_exp2f(p0[r]);
}
template <bool PACK = true>
__device__ __forceinline__ void finishFast(f32x16& p0, f32x16& p1, float& l_reg, float& psmax, bf16x8& pa0, bf16x8& pa1, bf16x8& pa2, bf16x8& pa3) {
  float dummy = 0.f; finishSM<PACK>(p0, p1, 0.f, dummy, pa0, pa1, pa2, pa3);
  l_reg += dummy; psmax = fmaxf(psmax, dummy);
}
typedef int v8i_att __attribute__((ext_vector_type(8)));
typedef int v4i_att __attribute__((ext_vector_type(4)));
__device__ __forceinline__ void packP8(const f32x16& p0, const f32x16& p1, v8i_att& p8) {
#pragma unroll
  for (int w = 0; w < 4; ++w) { p8[w] = (int)pk4_fp8(p0[4 * w], p0[4 * w + 1], p0[4 * w + 2], p0[4 * w + 3]); p8[4 + w] = (int)pk4_fp8(p1[4 * w], p1[4 * w + 1], p1[4 * w + 2], p1[4 * w + 3]); }
}
template <int D0> __device__ __forceinline__ void pv8_one(f32x16& od, const char* Vs, const v8i_att& p8, int r32, int hi) {
  const char* p = Vs + (D0 * 32 + r32) * 80 + 32 * hi;
  const v4i_att a = *reinterpret_cast<const v4i_att*>(p), b = *reinterpret_cast<const v4i_att*>(p + 16);
  od = __builtin_amdgcn_mfma_scale_f32_32x32x64_f8f6f4(p8, __builtin_shufflevector(a, b, 0, 1, 2, 3, 4, 5, 6, 7), od, 0, 0, 0, 0x7f7f7f7f, 0, 0x7f7f7f7f);
}
__device__ __forceinline__ void pv8(f32x16* o, const char* Vs, const v8i_att& p8, int r32, int hi) {
  pv8_one<0>(o[0], Vs, p8, r32, hi); pv8_one<1>(o[1], Vs, p8, r32, hi); pv8_one<2>(o[2], Vs, p8, r32, hi); pv8_one<3>(o[3], Vs, p8, r32, hi);
}
template <bool FULL>
__device__ __forceinline__ void qkt(f32x16& p0, f32x16& p1, const char* Ks, const bf16x8* qr, int r32, int hi, int kd0) {
  p0 = f32x16{}; p1 = f32x16{};
#pragma unroll
  for (int d0 = 0; d0 < (FULL ? 8 : 4); ++d0) { int cb = ((kd0 + d0) * 16 + hi * 8) * 2;
    bf16x8 b0 = *reinterpret_cast<const bf16x8*>(Ks + KSWZ(r32, cb));
    bf16x8 b1 = *reinterpret_cast<const bf16x8*>(Ks + KSWZ(32 + r32, cb));
    p0 = __builtin_amdgcn_mfma_f32_32x32x16_bf16(b0, qr[d0], p0, 0, 0, 0);
    p1 = __builtin_amdgcn_mfma_f32_32x32x16_bf16(b1, qr[d0], p1, 0, 0, 0); }
}
constexpr int QSC8 = 0x7c7c7c7c;
__device__ __forceinline__ void qkt8(f32x16& p0, f32x16& p1, const f32x16& nb, const char* Ks, const v8i_att* q8, int r32, int hi) {
#pragma unroll
  for (int s_ = 0; s_ < 2; ++s_) { const char* k0p = Ks + r32 * 144 + 64 * s_ + 32 * hi; const char* k1p = k0p + 32 * 144;
    const v4i_att a0 = *reinterpret_cast<const v4i_att*>(k0p), a1 = *reinterpret_cast<const v4i_att*>(k0p + 16), b0 = *reinterpret_cast<const v4i_att*>(k1p), b1 = *reinterpret_cast<const v4i_att*>(k1p + 16);
    p0 = __builtin_amdgcn_mfma_scale_f32_32x32x64_f8f6f4(__builtin_shufflevector(a0, a1, 0, 1, 2, 3, 4, 5, 6, 7), q8[s_], s_ == 0 ? nb : p0, 0, 0, 0, 0x7f7f7f7f, 0, QSC8);
    p1 = __builtin_amdgcn_mfma_scale_f32_32x32x64_f8f6f4(__builtin_shufflevector(b0, b1, 0, 1, 2, 3, 4, 5, 6, 7), q8[s_], s_ == 0 ? nb : p1, 0, 0, 0, 0x7f7f7f7f, 0, QSC8); }
}
__device__ __forceinline__ void qkt8d(f32x16& p0, f32x16& p1, const f32x16& nb, const char* Ks, const v8i_att& q8, int r32, int hi) {
  const char* k0p = Ks + r32 * 80 + 32 * hi; const char* k1p = k0p + 32 * 80;
  const v4i_att a0 = *reinterpret_cast<const v4i_att*>(k0p), a1 = *reinterpret_cast<const v4i_att*>(k0p + 16), b0 = *reinterpret_cast<const v4i_att*>(k1p), b1 = *reinterpret_cast<const v4i_att*>(k1p + 16);
  p0 = __builtin_amdgcn_mfma_scale_f32_32x32x64_f8f6f4(__builtin_shufflevector(a0, a1, 0, 1, 2, 3, 4, 5, 6, 7), q8, nb, 0, 0, 0, 0x7f7f7f7f, 0, QSC8);
  p1 = __builtin_amdgcn_mfma_scale_f32_32x32x64_f8f6f4(__builtin_shufflevector(b0, b1, 0, 1, 2, 3, 4, 5, 6, 7), q8, nb, 0, 0, 0, 0x7f7f7f7f, 0, QSC8);
}
__device__ __forceinline__ int v_st(int k, int c) { const int kk = k; return ((kk >> 3) * 4 + (c >> 5)) * 512 + ((kk & 7) * 32 + (c & 31)) * 2; }
__device__ __forceinline__ int v_rd_base(int lane) { return ((lane & 3) << 3) | (((lane >> 2) & 3) << 6) | (((lane >> 4) & 1) << 5) | (((lane >> 5) & 1) << 8); }
constexpr int v_rd_off(int d0, int ks, int half) { return d0 * 512 + ks * 4096 + half * 2048; }
template <int OFF> __device__ __forceinline__ s16x4 tr_read(int vb) {
  s16x4 r; asm volatile("ds_read_b64_tr_b16 %0, %1 offset:%2" : "=&v"(r) : "v"(vb), "i"(OFF) : "memory"); return r;
}
template <int D0> __device__ __forceinline__ void pv_one(f32x16& od, int vb, bf16x8 pa0, bf16x8 pa1, bf16x8 pa2, bf16x8 pa3) {
  const s16x4 l0 = tr_read<v_rd_off(D0, 0, 0)>(vb), h0 = tr_read<v_rd_off(D0, 0, 1)>(vb), l1 = tr_read<v_rd_off(D0, 1, 0)>(vb), h1 = tr_read<v_rd_off(D0, 1, 1)>(vb);
  const s16x4 l2 = tr_read<v_rd_off(D0, 2, 0)>(vb), h2 = tr_read<v_rd_off(D0, 2, 1)>(vb), l3 = tr_read<v_rd_off(D0, 3, 0)>(vb), h3 = tr_read<v_rd_off(D0, 3, 1)>(vb);
  asm volatile("s_waitcnt lgkmcnt(0)" ::: "memory"); SBAR();
#define PK(L, H) (bf16x8){L[0], L[1], L[2], L[3], H[0], H[1], H[2], H[3]}
  od = __builtin_amdgcn_mfma_f32_32x32x16_bf16(pa0, PK(l0, h0), od, 0, 0, 0);
  od = __builtin_amdgcn_mfma_f32_32x32x16_bf16(pa1, PK(l1, h1), od, 0, 0, 0);
  od = __builtin_amdgcn_mfma_f32_32x32x16_bf16(pa2, PK(l2, h2), od, 0, 0, 0);
  od = __builtin_amdgcn_mfma_f32_32x32x16_bf16(pa3, PK(l3, h3), od, 0, 0, 0);
#undef PK
}
__device__ __forceinline__ void pv_d0(f32x16* o, int vb, bf16x8 pa0, bf16x8 pa1, bf16x8 pa2, bf16x8 pa3) {
  pv_one<0>(o[0], vb, pa0, pa1, pa2, pa3); pv_one<1>(o[1], vb, pa0, pa1, pa2, pa3); pv_one<2>(o[2], vb, pa0, pa1, pa2, pa3); pv_one<3>(o[3], vb, pa0, pa1, pa2, pa3);
}


template <bool FULL, bool FAST>
__device__ __forceinline__ bool attn_dense_body(const bf16_t* __restrict__ Qb, const bf16_t* __restrict__ Kh, const bf16_t* __restrict__ Vh,
                                                bf16_t* __restrict__ Ob, const int ldo, const int seq, const int kd0, const float C, const float thr_s, char* lds) {
  const int tid = opaque_tid(), wid = tid >> 6, lane = tid & 63, r32 = lane & 31, hi = lane >> 5;
  char* V_lds = lds; char* K_lds = lds + 2 * SHM_V;
  float* ws = (float*)(lds + 2 * SHM_V + 2 * SHM_K) + wid * 64; float* li_l = ws; float* al_l = ws + 32;
  float m_reg = 0.f, l_reg = 0, psmax = 0.f; f32x16 o[4] = {}; f32x16 nb = {}; v8i_att q8[2]; (void)psmax; (void)l_reg;
  f32x16 lacc = {};
  if constexpr (FULL) {
    const char* Q8w = (const char*)Qb + (long)(wid * QBLK + r32) * 1024 + 32 * hi;
#pragma unroll
    for (int s_ = 0; s_ < 2; ++s_) { const v4i_att x0 = *reinterpret_cast<const v4i_att*>(Q8w + 64 * s_), x1 = *reinterpret_cast<const v4i_att*>(Q8w + 64 * s_ + 16); q8[s_] = __builtin_shufflevector(x0, x1, 0, 1, 2, 3, 4, 5, 6, 7); }
  } else {
    const char* Q8w = (const char*)Qb + (long)(wid * QBLK + r32) * 2048 + 32 * hi;
    const v4i_att x0 = *reinterpret_cast<const v4i_att*>(Q8w), x1 = *reinterpret_cast<const v4i_att*>(Q8w + 16); q8[0] = __builtin_shufflevector(x0, x1, 0, 1, 2, 3, 4, 5, 6, 7);
  }
  const int sr = tid >> 4, sc = (tid & 15) * 8, vst0 = v_st(sr, sc), vst1 = v_st(32 + sr, sc);
  const int vb0 = (int)(uintptr_t)V_lds + v_rd_base(lane);
  constexpr int SDEPTH = 1;
  struct { bf16x8 vs0, vs1, ks0; } sr_[SDEPTH]; u32x2 kd8 = {0u, 0u}; v8i_att p8 = {}; (void)p8;
  const unsigned goff0 = (unsigned)(sr * LDQK + sc) * 2u, goff1 = goff0 + 32u * LDQK * 2u;
  const unsigned goffk = (unsigned)((tid >> 3) * LDQK + (tid & 7) * 8) * 2u;
#define SLOAD(i, k0) do { sr_[i].vs0 = *reinterpret_cast<const bf16x8*>((const char*)Vh + (size_t)((k0) >> 6) * 8192 + tid * 16); \
    if constexpr (FULL) sr_[i].ks0 = *reinterpret_cast<const bf16x8*>((const char*)Kh + (size_t)((k0) + (tid >> 3)) * 256 + (tid & 7) * 16); \
    else kd8 = *reinterpret_cast<const u32x2*>((const char*)Kh + (size_t)((k0) + (tid >> 3)) * 2048 + (tid & 7) * 8); } while (0)
#define SWRITE(b, i) do { *(bf16x8*)(V_lds + (b) * SHM_V + (tid >> 2) * 80 + (tid & 3) * 16) = sr_[i].vs0; \
    if constexpr (FULL) *(bf16x8*)(K_lds + (b) * SHM_K + (tid >> 3) * 144 + (tid & 7) * 16) = sr_[i].ks0; \
    else *(u32x2*)(K_lds + (b) * SHM_K + (tid >> 3) * 80 + (tid & 7) * 8) = kd8; } while (0)
#define PV(b) do { pv8(o, V_lds + (b) * SHM_V, p8, r32, hi); } while (0)
#define QKT(P0, P1, KS) do { if constexpr (FULL) qkt8(P0, P1, nb, KS, q8, r32, hi); else qkt8d(P0, P1, nb, KS, q8[0], r32, hi); } while (0)
#define SWAIT() do { if constexpr (SDEPTH == 2) asm volatile("s_waitcnt vmcnt(4)" ::: "memory"); else asm volatile("s_waitcnt vmcnt(0)" ::: "memory"); } while (0)
#define RESC(a) do { if constexpr (!FAST) if (__any((a) < 1.f)) { if (hi == 0) al_l[r32] = (a); asm volatile("s_waitcnt lgkmcnt(0)" ::: "memory"); \
    _Pragma("unroll") for (int d = 0; d < 4; ++d) _Pragma("unroll") for (int r = 0; r < 16; ++r) o[d][r] *= al_l[crow(r, hi)]; } } while (0)
#define PSM(P0, P1, AL) do { if constexpr (FAST) halfexp(P0); else partialSM<false>(P0, P1, m_reg, nb, AL, thr_s); } while (0)
#define FSM(P0, P1, AL) do { if constexpr (FAST) finishFast<false>(P0, P1, l_reg, psmax, pa0, pa1, pa2, pa3); else finishSM<false>(P0, P1, AL, l_reg, pa0, pa1, pa2, pa3); \
    packP8(P0, P1, p8); } while (0)
  f32x16 pA0, pA1, pB0, pB1; float alA = 1.f, alB = 1.f; bf16x8 pa0, pa1, pa2, pa3; const int NT_ = seq / KVBLK; (void)C;
  constexpr int SE = 0, SO = SDEPTH - 1;
  if constexpr (FAST) {
    constexpr bool LM = true;
    v8i_att ones8 = {0x38383838, 0x38383838, 0x38383838, 0x38383838, 0x38383838, 0x38383838, 0x38383838, 0x38383838}; if constexpr (LM) asm volatile("" : "+v"(ones8));
    float psA = 0.f, psB = 0.f; (void)psA; (void)psB;
#define SOFTQ(N0, N1, PSN, q) do { _Pragma("unroll") for (int r = 0; r < 8; ++r) { if constexpr ((q) < 2) { N0[8 * (q) + r] = __builtin_amdgcn_exp2f(N0[8 * (q) + r]); if constexpr (!LM) PSN += N0[8 * (q) + r]; } \
      else { N1[8 * ((q) - 2) + r] = __builtin_amdgcn_exp2f(N1[8 * ((q) - 2) + r]); if constexpr (!LM) PSN += N1[8 * ((q) - 2) + r]; } } } while (0)
#define PVQ(b, D) do { pv8_one<D>(o[D], V_lds + (b) * SHM_V, p8, r32, hi); } while (0)
#define LSUM() do { if constexpr (LM) lacc = __builtin_amdgcn_mfma_scale_f32_32x32x64_f8f6f4(p8, ones8, lacc, 0, 0, 0, 0x7f7f7f7f, 0, 0x7f7f7f7f); } while (0)
#define PVS(b, N0, N1, PSN) do { if constexpr (!LM) PSN = 0.f; LSUM(); SOFTQ(N0, N1, PSN, 0); PVQ(b, 0); SOFTQ(N0, N1, PSN, 1); PVQ(b, 1); SOFTQ(N0, N1, PSN, 2); PVQ(b, 2); SOFTQ(N0, N1, PSN, 3); PVQ(b, 3); } while (0)
#define FIN(P0, P1, PS) do { if constexpr (!LM) { { auto rr_ = __builtin_amdgcn_permlane32_swap(__float_as_uint(PS), __float_as_uint(PS), false, false); PS = __uint_as_float(rr_[0]) + __uint_as_float(rr_[1]); } \
      l_reg += PS; psmax = fmaxf(psmax, PS); } packP8(P0, P1, p8); } while (0)
    constexpr int FS_K = 8192, FS_STAGE = 16384;
    const int wv_ = __builtin_amdgcn_readfirstlane(wid);
    const unsigned gV = (unsigned)((tid >> 2) * 64 + (((tid & 3) ^ ((tid >> 4) & 3)) * 16));
    const unsigned gK = FULL ? (unsigned)((tid >> 3) * 256 + (((tid & 7) ^ ((tid >> 4) & 7)) * 16))
                             : (unsigned)((tid >> 2) * 2048 + (((tid & 3) ^ ((tid >> 4) & 3)) * 16));
    const int swv = (r32 >> 2) & 3, vA = r32 * 64 + ((2 * hi) ^ swv) * 16, vB = r32 * 64 + ((2 * hi + 1) ^ swv) * 16;
    const int swk = FULL ? (r32 >> 1) & 7 : (r32 >> 2) & 3;
    const int kA0 = FULL ? r32 * 128 + ((2 * hi) ^ swk) * 16 : r32 * 64 + ((2 * hi) ^ swk) * 16, kB0 = FULL ? r32 * 128 + ((2 * hi + 1) ^ swk) * 16 : r32 * 64 + ((2 * hi + 1) ^ swk) * 16;
    const int kA1 = r32 * 128 + ((4 + 2 * hi) ^ swk) * 16, kB1 = r32 * 128 + ((5 + 2 * hi) ^ swk) * 16;
#define DMA(st, k0) do { __builtin_amdgcn_global_load_lds((const unsigned*)((const char*)Vh + (size_t)((k0) >> 6) * 8192 + gV), (LAS unsigned*)((LAS char*)(uintptr_t)(unsigned)(uintptr_t)lds + (st) + wv_ * 1024), 16, 0, 0); \
      if constexpr (FULL) __builtin_amdgcn_global_load_lds((const unsigned*)((const char*)Kh + (size_t)(k0) * 256 + gK), (LAS unsigned*)((LAS char*)(uintptr_t)(unsigned)(uintptr_t)lds + (st) + FS_K + wv_ * 1024), 16, 0, 0); \
      else if (wv_ < 4) __builtin_amdgcn_global_load_lds((const unsigned*)((const char*)Kh + (size_t)(k0) * 2048 + gK), (LAS unsigned*)((LAS char*)(uintptr_t)(unsigned)(uintptr_t)lds + (st) + FS_K + wv_ * 1024), 16, 0, 0); } while (0)
#define LDV4(off) (*reinterpret_cast<const v4i_att*>(lds + (off)))
#define QKTS(P0, P1, st) do { const int kb_ = (st) + FS_K; \
      if constexpr (FULL) { { const v4i_att a0 = LDV4(kb_ + kA0), a1 = LDV4(kb_ + kB0), b0 = LDV4(kb_ + 4096 + kA0), b1 = LDV4(kb_ + 4096 + kB0); \
        P0 = __builtin_amdgcn_mfma_scale_f32_32x32x64_f8f6f4(__builtin_shufflevector(a0, a1, 0, 1, 2, 3, 4, 5, 6, 7), q8[0], nb, 0, 0, 0, 0x7f7f7f7f, 0, QSC8); \
        P1 = __builtin_amdgcn_mfma_scale_f32_32x32x64_f8f6f4(__builtin_shufflevector(b0, b1, 0, 1, 2, 3, 4, 5, 6, 7), q8[0], nb, 0, 0, 0, 0x7f7f7f7f, 0, QSC8); } SBAR(); \
        { const v4i_att c0 = LDV4(kb_ + kA1), c1 = LDV4(kb_ + kB1), d0 = LDV4(kb_ + 4096 + kA1), d1 = LDV4(kb_ + 4096 + kB1); \
        P0 = __builtin_amdgcn_mfma_scale_f32_32x32x64_f8f6f4(__builtin_shufflevector(c0, c1, 0, 1, 2, 3, 4, 5, 6, 7), q8[1], P0, 0, 0, 0, 0x7f7f7f7f, 0, QSC8); \
        P1 = __builtin_amdgcn_mfma_scale_f32_32x32x64_f8f6f4(__builtin_shufflevector(d0, d1, 0, 1, 2, 3, 4, 5, 6, 7), q8[1], P1, 0, 0, 0, 0x7f7f7f7f, 0, QSC8); } } \
      else { const v4i_att a0 = LDV4(kb_ + kA0), a1 = LDV4(kb_ + kB0), b0 = LDV4(kb_ + 2048 + kA0), b1 = LDV4(kb_ + 2048 + kB0); \
        P0 = __builtin_amdgcn_mfma_scale_f32_32x32x64_f8f6f4(__builtin_shufflevector(a0, a1, 0, 1, 2, 3, 4, 5, 6, 7), q8[0], nb, 0, 0, 0, 0x7f7f7f7f, 0, QSC8); \
        P1 = __builtin_amdgcn_mfma_scale_f32_32x32x64_f8f6f4(__builtin_shufflevector(b0, b1, 0, 1, 2, 3, 4, 5, 6, 7), q8[0], nb, 0, 0, 0, 0x7f7f7f7f, 0, QSC8); } } while (0)
#undef PVQ
#define PVQ(st, D) do { const v4i_att a_ = LDV4((st) + (D) * 2048 + vA), b_ = LDV4((st) + (D) * 2048 + vB); \
      o[D] = __builtin_amdgcn_mfma_scale_f32_32x32x64_f8f6f4(p8, __builtin_shufflevector(a_, b_, 0, 1, 2, 3, 4, 5, 6, 7), o[D], 0, 0, 0, 0x7f7f7f7f, 0, 0x7f7f7f7f); } while (0)
#define STEP_END() do { asm volatile("s_waitcnt vmcnt(0)" ::: "memory"); __syncthreads(); { const int t_ = oC; oC = oN; oN = oW; oW = t_; } } while (0)
    int oC = 0, oN = FS_STAGE, oW = 2 * FS_STAGE;
    DMA(0, 0); DMA(FS_STAGE, KVBLK); asm volatile("s_waitcnt vmcnt(0)" ::: "memory"); __syncthreads();
    QKTS(pA0, pA1, oC);
    { const float d = rowmax32(pA0, pA1); m_reg = d;
#pragma unroll
      for (int r = 0; r < 16; ++r) { pA0[r] = __builtin_amdgcn_exp2f(pA0[r] - d); pA1[r] = __builtin_amdgcn_exp2f(pA1[r] - d); nb[r] = -d; }
      asm volatile("" : "+v"(nb));
    }
    for (int j = 0; j + 2 < NT_; j += 2) {
      DMA(oW, (j + 2) * KVBLK); SBAR(); QKTS(pB0, pB1, oN);
      FIN(pA0, pA1, psA); SBAR();
      PVS(oC, pB0, pB1, psB);
      STEP_END();
      DMA(oW, (j + 3) * KVBLK); SBAR(); QKTS(pA0, pA1, oN);
      FIN(pB0, pB1, psB); SBAR();
      PVS(oC, pA0, pA1, psA);
      STEP_END();
    }
    SBAR(); QKTS(pB0, pB1, oN);
    FIN(pA0, pA1, psA); SBAR();
    PVS(oC, pB0, pB1, psB);
    FIN(pB0, pB1, psB); SBAR();
    LSUM(); PVQ(oN, 0); PVQ(oN, 1); PVQ(oN, 2); PVQ(oN, 3);
#undef DMA
#undef LDV4
#undef QKTS
#undef STEP_END
#undef LSUM
#undef SOFTQ
#undef PVQ
#undef PVS
#undef FIN
  } else {
  SLOAD(SE, 0); asm volatile("s_waitcnt vmcnt(0)" ::: "memory"); SWRITE(0, SE); __syncthreads();
  QKT(pA0, pA1, K_lds); partialSM<true>(pA0, pA1, m_reg, nb, alA, thr_s);
  SLOAD(SO, KVBLK); if constexpr (SDEPTH == 2) { if (2 < NT_) SLOAD(SE, 2 * KVBLK); }
  SWAIT(); SWRITE(1, SO); __syncthreads();
  for (int j = 1; j + 1 < NT_; j += 2) {
    SBAR(); QKT(pB0, pB1, K_lds + SHM_K);
    FSM(pA0, pA1, alA); SBAR();
    SLOAD(SO, (j + SDEPTH) * KVBLK); SBAR();
    PV(0); PSM(pB0, pB1, alB);
    __syncthreads(); SWAIT(); SWRITE(0, SE);
    RESC(alB); __syncthreads();
    SBAR(); QKT(pA0, pA1, K_lds);
    FSM(pB0, pB1, alB); SBAR();
    if (SDEPTH == 1 || j + 3 < NT_) SLOAD(SE, (j + 1 + SDEPTH) * KVBLK); SBAR();
    PV(1); PSM(pA0, pA1, alA);
    __syncthreads(); SWAIT(); SWRITE(1, SO);
    RESC(alA); __syncthreads();
  }
  SBAR(); QKT(pB0, pB1, K_lds + SHM_K);
  FSM(pA0, pA1, alA); SBAR();
  PV(0); PSM(pB0, pB1, alB);
  __syncthreads(); RESC(alB);
  FSM(pB0, pB1, alB); SBAR();
  PV(1);
  }
  if constexpr (FAST) {
    float lt_ = 0.f;
    {
#pragma unroll
      for (int r = 0; r < 16; ++r) lt_ += lacc[r]; }
    int* badf = (int*)(lds + SHM_ATTN); const bool wbad = !__all(lt_ <= 3.0e38f);
    if (lane == 0) badf[wid] = wbad ? 1 : 0;
    __syncthreads();
    int anyb = 0;
#pragma unroll
    for (int w = 0; w < NW; ++w) anyb |= badf[w];
    if (__builtin_amdgcn_readfirstlane(anyb)) return true;
  }
  float rli[16];
  if constexpr (FAST) {
#pragma unroll
    for (int r = 0; r < 16; ++r) rli[r] = __builtin_amdgcn_rcpf(lacc[r]);
  } else {
    if (hi == 0) li_l[r32] = l_reg; asm volatile("s_waitcnt lgkmcnt(0)" ::: "memory");
#pragma unroll
    for (int r = 0; r < 16; ++r) rli[r] = __builtin_amdgcn_rcpf(li_l[crow(r, hi)]);
  }
  bf16_t* Ow = Ob + (long)(wid * QBLK) * ldo;
#pragma unroll
  for (int r = 0; r < 16; ++r) { int orow = crow(r, hi);
#pragma unroll
    for (int d0 = 0; d0 < 4; ++d0) Ow[(long)orow * ldo + d0 * 32 + r32] = (bf16_t)f2bf(o[d0][r] * rli[r]); }
#undef SLOAD
#undef SWRITE
#undef SWAIT
#undef QKT
#undef RESC
#undef PSM
#undef FSM
#undef PV
  return false;
}
}

#define XB_TMO      128
#define XB_XCNT(j)  (256  + 64 * (j))
#define XB_XSUB(j)  (1280 + 64 * (j))
#define XB_XGEN(j)  (2304 + 64 * (j))
#define XB_TOP      3328
#define XB_TOPGEN   3392
#define XCD_BAR_WORDS 3456
#define XB_SPIN_CAP (1u << 21)
__device__ __forceinline__ unsigned xb_ld(unsigned* p)              { return __hip_atomic_load(p, __ATOMIC_RELAXED, __HIP_MEMORY_SCOPE_AGENT); }
__device__ __forceinline__ unsigned xb_add(unsigned* p, unsigned v) { return __hip_atomic_fetch_add(p, v, __ATOMIC_RELAXED, __HIP_MEMORY_SCOPE_AGENT); }
__device__ __forceinline__ unsigned xb_xcc_id() { return (unsigned)__builtin_amdgcn_s_getreg((3 << 11) | 20) & 0xFu; }
#define XB_SPIN(cond, bar) do { unsigned _sp = 0; while (cond) { __builtin_amdgcn_s_sleep(1); \
    if ((++_sp & 255u) == 0u) { if (xb_ld(&(bar)[XB_TMO])) break; if (_sp > XB_SPIN_CAP) { atomicAdd(&(bar)[XB_TMO], 1u); break; } } } } while (0)
struct XcdBarrier { unsigned* bar; unsigned x; volatile LAS unsigned* st; };
__device__ __forceinline__ XcdBarrier xcd_barrier_post(unsigned* bar, volatile LAS unsigned* st) {
    XcdBarrier b; b.bar = bar; b.x = (unsigned)__builtin_amdgcn_readfirstlane((int)xb_xcc_id()); b.st = st;
    if (threadIdx.x == 0) (void)xb_add(&bar[XB_XCNT(b.x)], 1u);
    return b;
}
__device__ __forceinline__ void xcd_barrier_complete(unsigned* bar, unsigned x, unsigned& nloc, unsigned& nx) {
    const unsigned G = gridDim.x * gridDim.y * gridDim.z;
    unsigned sum, cnt, mine, sp = 0u;
    for (;;) {
        sum = 0u; cnt = 0u; mine = 0u;
#pragma unroll
        for (unsigned j = 0; j < 16; ++j) { const unsigned c = xb_ld(&bar[XB_XCNT(j)]); sum += c; cnt += (c > 0u) ? 1u : 0u; mine = (j == x) ? c : mine; }
        if (sum == G) break;
        __builtin_amdgcn_s_sleep(1);
        if ((++sp & 255u) == 0u) { if (xb_ld(&bar[XB_TMO])) break; if (sp > XB_SPIN_CAP) { atomicAdd(&bar[XB_TMO], 1u); break; } }
    }
    nloc = mine > 0u ? mine : 1u; nx = cnt > 0u ? cnt : 1u;
}
__device__ __forceinline__ void xcd_barrier(const XcdBarrier& b) {
    asm volatile("s_waitcnt vmcnt(0)" ::: "memory");
    __syncthreads();
    if (threadIdx.x == 0) {
        unsigned* bar = b.bar;
        __builtin_amdgcn_s_waitcnt(0);
        unsigned nloc = b.st[0], nx = b.st[1];
        if (nloc == 0u) { xcd_barrier_complete(bar, b.x, nloc, nx); b.st[0] = nloc; b.st[1] = nx; }
        const unsigned old = xb_add(&bar[XB_XSUB(b.x)], 1u);
        const unsigned gen = old / nloc;
        if (old + 1u == (gen + 1u) * nloc) {
            __builtin_amdgcn_fence(__ATOMIC_RELEASE, "agent");
            asm volatile("s_waitcnt vmcnt(0)" ::: "memory");
            const unsigned og = xb_add(&bar[XB_TOP], 1u);
            const unsigned tg = og / nx;
            if (og + 1u == (tg + 1u) * nx) xb_add(&bar[XB_TOPGEN], 1u);
            else XB_SPIN(xb_ld(&bar[XB_TOPGEN]) == tg, bar);
            __builtin_amdgcn_fence(__ATOMIC_ACQUIRE, "agent");
            xb_add(&bar[XB_XGEN(b.x)], 1u);
            asm volatile("s_waitcnt vmcnt(0)" ::: "memory");
        } else {
            XB_SPIN(xb_ld(&bar[XB_XGEN(b.x)]) == gen, bar);
            __builtin_amdgcn_fence(__ATOMIC_ACQUIRE, "agent");
            asm volatile("s_waitcnt vmcnt(0)" ::: "memory");
        }
    }
    __syncthreads();
}

constexpr int RING_BYTES = 131072, MISC_OFF = RING_BYTES + 320, LDS_BYTES = 147456;

struct Args { const float* in[33]; float* out; unsigned char* ws; };
enum { I_X = 0, I_C, I_CTX, I_CCTX, I_WADA, I_BADA, I_WIN, I_LQ1, I_LK1, I_LQ2, I_LK2, I_SUBLN, I_WPA, I_QNORM, I_KNORM, I_WPB, I_ARE, I_AIM, I_LOGDT, I_BRE, I_BIM, I_CRE, I_CIM,
       I_S5D, I_WGLU, I_WO, I_LNMG, I_LNMB, I_WG, I_WU, I_WD, I_LNFG, I_LNFB };

typedef const float* cfp_t;
struct InTab {
    __device__ __forceinline__ cfp_t operator[](int i) const {
        const __attribute__((address_space(4))) unsigned char* k = (const __attribute__((address_space(4))) unsigned char*)__builtin_amdgcn_kernarg_segment_ptr();
        asm volatile("" : "+s"(k));
        return (cfp_t)(const GAS float*)(*(const __attribute__((address_space(4))) cfp_t*)(k + 8 * i));
    }
};
struct Frame {
    LAS unsigned char* lds; int tid, lane, wave, vcu, G, gw, NGW;
    InTab in; GAS float* out; GAS unsigned char* ws;
};

__device__ __forceinline__ void transpose_item(const float* W, int K, int N, bf16_t* WT, int k0, int n0, int out_row0, LAS float* scr, int lane, bool fp8 = false) {
    const float* src = W + (size_t)k0 * N + n0 + lane;
#pragma unroll
    for (int h = 0; h < 2; ++h) { float v[32];
#pragma unroll
        for (int i = 0; i < 32; ++i) v[i] = src[(size_t)(32 * h + i) * N];
#pragma unroll
        for (int i = 0; i < 32; ++i) scr[(32 * h + i) * 64 + (lane ^ (8 * ((32 * h + i) >> 3)))] = v[i]; }
    LDS_WAIT(); asm volatile("" ::: "memory");
    const int c = lane & 7;
#pragma unroll
    for (int j = 0; j < 8; ++j) { const int n = (lane >> 3) + 8 * j; const LAS float* s = scr + (8 * c) * 64 + (n ^ (8 * c));
        if (fp8) { u32x2 o8; o8.x = pk4_fp8(64.f * s[0 * 64], 64.f * s[1 * 64], 64.f * s[2 * 64], 64.f * s[3 * 64]); o8.y = pk4_fp8(64.f * s[4 * 64], 64.f * s[5 * 64], 64.f * s[6 * 64], 64.f * s[7 * 64]);
            *(u32x2*)((unsigned char*)WT + (size_t)(out_row0 + n) * K + k0 + 8 * c) = o8; }
        else { u32x4 o; o.x = pk2(s[0 * 64], s[1 * 64]); o.y = pk2(s[2 * 64], s[3 * 64]); o.z = pk2(s[4 * 64], s[5 * 64]); o.w = pk2(s[6 * 64], s[7 * 64]);
        *(u32x4*)(WT + (size_t)(out_row0 + n) * K + k0 + 8 * c) = o; } }
    LDS_WAIT(); asm volatile("" ::: "memory");
}
constexpr int IT_IN = (DM / 64) * (NIN / 64), IT_PA = (1024 / 64) * (DM / 64), IT_PB = IT_PA, IT_GLU = (1024 / 64) * (4096 / 64), IT_O = (DM / 64) * (DM / 64),
              IT_G = (DM / 64) * (FF / 64), IT_U = IT_G, IT_D = (FF / 64) * (DM / 64);
constexpr int IT_LAYER = IT_IN + IT_PA + IT_PB + IT_GLU + IT_O + IT_G + IT_U + IT_D;

__device__ __forceinline__ void convert_item(Frame& F, int it, LAS float* scr) {
    const int l = it / IT_LAYER; int r = it % IT_LAYER;
    GAS unsigned char* wl = F.ws + WS_W + (size_t)l * W_LAYER;
    const float* W; int K, N; bf16_t* WT; int mode;
    int rowoff = 0;
    if (r < IT_IN) { W = F.in[I_WIN] + (size_t)l * DM * NIN; K = DM; N = NIN; WT = (bf16_t*)(wl + W_IN); mode = 0; }
    else if ((r -= IT_IN) < IT_PA) { W = F.in[I_WPA] + (size_t)l * 1024 * DM; K = 1024; N = DM; WT = (bf16_t*)(wl + W_PAB); mode = 0; }
    else if ((r -= IT_PA) < IT_PB) { W = F.in[I_WPB] + (size_t)l * 1024 * DM; K = 1024; N = DM; WT = (bf16_t*)(wl + W_PAB); mode = 0; rowoff = 2048; }
    else if ((r -= IT_PB) < IT_GLU) { W = F.in[I_WGLU] + (size_t)l * 1024 * 4096; K = 1024; N = 4096; WT = (bf16_t*)(wl + W_GLU); mode = 1; }
    else if ((r -= IT_GLU) < IT_O) { W = F.in[I_WO] + (size_t)l * DM * DM; K = DM; N = DM; WT = (bf16_t*)(wl + W_O); mode = 0; }
    else if ((r -= IT_O) < IT_G) { W = F.in[I_WG] + (size_t)l * DM * FF; K = DM; N = FF; WT = (bf16_t*)(wl + W_GU); mode = 2; }
    else if ((r -= IT_G) < IT_U) { W = F.in[I_WU] + (size_t)l * DM * FF; K = DM; N = FF; WT = (bf16_t*)(wl + W_GU); mode = 3; }
    else { r -= IT_U; W = F.in[I_WD] + (size_t)l * FF * DM; K = FF; N = DM; WT = (bf16_t*)(wl + W_DN); mode = 0; }
    const int nblk = N / 64, kb = r / nblk, nb = r % nblk, k0 = 64 * kb, n0 = 64 * nb;
    int orow; bool fp8 = false;
    if (mode == 0 && N == NIN) { const int pt = n0 >> 8; orow = win_tile_slot(pt) * 256 + (n0 & 255);
        if (win_tile_fp8(pt)) { fp8 = true; WT = (bf16_t*)(wl + W_IN8); } }
    else if (mode == 0) orow = rowoff + n0;
    else if (mode == 1) orow = 256 * ((n0 % 2048) / 128) + 128 * (n0 / 2048) + (n0 % 128);
    else orow = 256 * (n0 / 128) + (mode == 3 ? 128 : 0) + (n0 % 128);
    transpose_item(W, K, N, WT, k0, n0, orow, scr, F.lane, fp8);
}

__device__ __forceinline__ void mod_item(Frame& F, int it) {
    const int cb = it % 48, slab = (it / 48) % MOD_SLABS, l = it / (48 * MOD_SLABS);
    const int col = cb * 256 + 4 * F.lane, k0 = slab * 64;
    const float* W = F.in[I_WADA] + ((size_t)l * DM + k0) * 12288 + col;
    const float* c = F.in[I_C] + k0; const float* cc = F.in[I_CCTX] + k0;
    f32x4 a0 = {0.f, 0.f, 0.f, 0.f}, a1 = a0;
#pragma unroll 8
    for (int k = 0; k < 64; ++k) { const f32x4 w = *(const f32x4*)(W + (size_t)k * 12288); const float s0 = siluf_(c[k]), s1 = siluf_(cc[k]); a0 += w * s0; a1 += w * s1; }
    float* P = (float*)(F.ws + WS_MODP) + (((size_t)slab * NL + l) * 2) * 12288 + col;
    *(f32x4*)P = a0; *(f32x4*)(P + 12288) = a1;
}

__device__ __forceinline__ void s5_param_item(Frame& F, int it) {
    const int p = it & 63, g = (it >> 6) & 63, dir = (it >> 12) & 1, l = it >> 13;
    const int gi = (l * 2 + dir) * 64 + g;
    double are = (double)F.in[I_ARE][gi * 64 + p]; if (are > -1e-4) are = (double)(-1e-4f);
    const double aim = (double)F.in[I_AIM][gi * 64 + p];
    const double dt = dexp((double)F.in[I_LOGDT][gi]);
    double s, c; dsincos(aim * dt, s, c);
    const double mag = dexp(are * dt), lr = mag * c, li = mag * s;
    const double den = are * are + aim * aim, nr = lr - 1.0;
    const double cr = (nr * are + li * aim) / den, ci = (li * are - nr * aim) / den;
    const float* bre = F.in[I_BRE] + ((size_t)gi * 64 + p) * 16; const float* bim = F.in[I_BIM] + ((size_t)gi * 64 + p) * 16;
    f32x2* BBF = (f32x2*)(F.ws + WS_BBF) + ((size_t)gi * 64 + p) * 16;
#pragma unroll
    for (int h = 0; h < 16; ++h) { const double br = bre[h], bi = bim[h];
        BBF[h] = (f32x2){(float)(cr * br - ci * bi), (float)(cr * bi + ci * br)}; }
    { f32x2* POW = (f32x2*)(F.ws + WS_POW) + (size_t)gi * 17 * 64 + p; double pr = 1.0, pi = 0.0;
      for (int k = 0; k <= 16; ++k) { POW[k * 64] = (f32x2){(float)pr, (float)pi}; const double nr = pr * lr - pi * li, ni = pr * li + pi * lr; pr = nr; pi = ni; } }
}

__device__ __forceinline__ void modulate_row(int lane, const float* xrow, float* xres, bf16_t* hrow, unsigned char* h8row, const float* sh, const float* sc) {
#pragma unroll
    for (int j = 0; j < 8; ++j) { const int c = 4 * lane + 256 * j; const f32x4 v = *(const f32x4*)(xrow + c), a = *(const f32x4*)(sc + c), b = *(const f32x4*)(sh + c);
        if (xres) *(f32x4*)(xres + c) = v;
        const f32x4 y = v * (a + 1.f) + b; u32x2 w; w.x = cvt_pk_bf16(y[0], y[1]); w.y = cvt_pk_bf16(y[2], y[3]); *(u32x2*)(hrow + c) = w;
        *(unsigned*)(h8row + c) = pk4_fp8(y[0], y[1], y[2], y[3]); }
}
__device__ __forceinline__ void ln_finish(int lane, f32x4 (&v)[8], float* xrow, bf16_t* hrow, const float* g, const float* b, const float* sh, const float* sc, unsigned char* h8row = nullptr, float* stats = nullptr) {
    float s = 0.f;
#pragma unroll
    for (int j = 0; j < 8; ++j) s += (v[j][0] + v[j][1]) + (v[j][2] + v[j][3]);
    const float mean = wave_sum(s) * (1.f / DM); float s2 = 0.f;
#pragma unroll
    for (int j = 0; j < 8; ++j) { v[j] = v[j] - mean; s2 += (v[j][0] * v[j][0] + v[j][1] * v[j][1]) + (v[j][2] * v[j][2] + v[j][3] * v[j][3]); }
    const float rstd = 1.f / sqrtf(wave_sum(s2) * (1.f / DM) + 1e-6f);
    if (stats && lane == 0) { f32x2 st = {mean, rstd}; *(f32x2*)stats = st; }
#pragma unroll
    for (int j = 0; j < 8; ++j) { const int c = 4 * lane + 256 * j; const f32x4 y = v[j] * rstd * *(const f32x4*)(g + c) + *(const f32x4*)(b + c);
        if (xrow) *(f32x4*)(xrow + c) = y;
        if (hrow) { const f32x4 z = y * (*(const f32x4*)(sc + c) + 1.f) + *(const f32x4*)(sh + c); u32x2 w; w.x = cvt_pk_bf16(z[0], z[1]); w.y = cvt_pk_bf16(z[2], z[3]); *(u32x2*)(hrow + c) = w;
            if (h8row) *(unsigned*)(h8row + c) = pk4_fp8(z[0], z[1], z[2], z[3]); } }
}
__device__ __forceinline__ void ln_row(int lane, const float* trow, float* xrow, bf16_t* hrow, const float* g, const float* b, const float* sh, const float* sc, unsigned char* h8row = nullptr, float* stats = nullptr) {
    f32x4 v[8];
#pragma unroll
    for (int j = 0; j < 8; ++j) v[j] = *(const f32x4*)(trow + 4 * lane + 256 * j);
    ln_finish(lane, v, xrow, hrow, g, b, sh, sc, h8row, stats);
}
__device__ __forceinline__ void ln_ctx_row(Frame& F, int r, const float* slab, int nslab, const float* gvec, const float* g, const float* b, const float* sh, const float* sc, bool h8) {
    const int lane = F.lane; LAS float* xb = (LAS float*)F.lds;
    f32x4 a[8];
#pragma unroll
    for (int j = 0; j < 8; ++j) a[j] = (f32x4){0.f, 0.f, 0.f, 0.f};
    for (int q = F.wave; q < nslab; q += NWAVES) { const float* sp = slab + ((size_t)q * NCTX + r) * DM + 4 * lane;
#pragma unroll
        for (int j = 0; j < 8; ++j) a[j] += *(const f32x4*)(sp + 256 * j); }
#pragma unroll
    for (int j = 0; j < 8; ++j) *(LAS f32x4*)(xb + F.wave * DM + 4 * lane + 256 * j) = a[j];
    __syncthreads();
    if (F.wave == 0) {
        float* xrow = (float*)(F.ws + WS_XRES) + (size_t)(NLAT + r) * DM; f32x4 v[8];
#pragma unroll
        for (int j = 0; j < 8; ++j) { const int c = 4 * lane + 256 * j; f32x4 t = *(const LAS f32x4*)(xb + c);
#pragma unroll
            for (int w = 1; w < NWAVES; ++w) t += *(const LAS f32x4*)(xb + w * DM + c);
            v[j] = *(const f32x4*)(xrow + c) * DN_ALPHA + *(const f32x4*)(gvec + c) * t; }
        ln_finish(lane, v, xrow, (bf16_t*)(F.ws + WS_H) + (size_t)(NLAT + r) * DM, g, b, sh, sc, h8 ? (unsigned char*)(F.ws + WS_H8) + (size_t)(NLAT + r) * DM : (unsigned char*)nullptr);
    }
    __syncthreads();
}

__device__ __forceinline__ void prep_row(Frame& F, int l, int t) {
    bf16_t* z = (bf16_t*)(F.ws + WS_Z) + (size_t)t * NIN;
    const bool lat = t < NLAT; const int prow = t >> 6, pcol = t & 63, lane = F.lane;
    const f32x2* RD = (const f32x2*)(F.ws + WS_ROPE_DA); const f32x2* RG = (const f32x2*)(F.ws + WS_ROPE_GQ);
    {
#pragma unroll
        for (int rep = 0; rep < 2; ++rep) { const int task = lane + 64 * rep, b = task >> 1, a = task & 1;
            const bf16_t* p = z + b * 32 + 8 * a; const int pos = (b & 1) ? pcol : prow;
            float x1[8], x2[8]; unpack8(*(const u32x4*)p, x1); unpack8(*(const u32x4*)(p + 16), x2);
            float o1[8], o2[8];
            if (lat) { const f32x2* cs = RD + pos * 16 + 8 * a;
#pragma unroll
                for (int j = 0; j < 8; ++j) { const f32x2 q = cs[j]; o1[j] = x1[j] * q[0] - x2[j] * q[1]; o2[j] = x2[j] * q[0] + x1[j] * q[1]; } }
            else {
#pragma unroll
                for (int j = 0; j < 8; ++j) { o1[j] = x1[j]; o2[j] = x2[j]; } }
            if (b < 32) {
#pragma unroll
                for (int j = 0; j < 8; ++j) { o1[j] *= 0.125f * 1.4426950408889634f * 8.f; o2[j] *= 0.125f * 1.4426950408889634f * 8.f; } }
            unsigned char* d8 = (unsigned char*)(F.ws + WS_QKA8) + (size_t)t * 2048 + b * 32 + 8 * a;
            u32x2 w1, w2; w1.x = pk4_fp8(o1[0], o1[1], o1[2], o1[3]); w1.y = pk4_fp8(o1[4], o1[5], o1[6], o1[7]); w2.x = pk4_fp8(o2[0], o2[1], o2[2], o2[3]); w2.y = pk4_fp8(o2[4], o2[5], o2[6], o2[7]);
            *(u32x2*)d8 = w1; *(u32x2*)(d8 + 16) = w2; }
    }
#pragma unroll
    for (int pass = 0; pass < 2; ++pass) {
        const int seg = lane >> 3, sub = lane & 7, axis = sub >> 2, a = sub & 3;
        const bool active = pass == 0 || seg < 2;
        bf16_t* p = z + (pass == 0 ? C_QB : C_KB) + (active ? seg : 0) * 128 + axis * 64 + 8 * a;
        const float* nw = F.in[pass == 0 ? I_QNORM : I_KNORM] + l * 128 + axis * 64 + 8 * a;
        float x1[8], x2[8]; unpack8(*(const u32x4*)p, x1); unpack8(*(const u32x4*)(p + 32), x2);
        float ss = 0.f;
#pragma unroll
        for (int j = 0; j < 8; ++j) ss += x1[j] * x1[j] + x2[j] * x2[j];
        ss += __shfl_xor(ss, 1); ss += __shfl_xor(ss, 2); ss += __shfl_xor(ss, 4);
        const float r = 1.f / sqrtf(ss * (1.f / 128.f) + 1e-6f);
        float o1[8], o2[8];
#pragma unroll
        for (int j = 0; j < 8; ++j) { x1[j] = x1[j] * r * nw[j]; x2[j] = x2[j] * r * nw[32 + j]; }
        if (lat) { const int pos = axis ? pcol : prow; const f32x2* cs = RG + pos * 32 + 8 * a;
#pragma unroll
            for (int j = 0; j < 8; ++j) { const f32x2 q = cs[j]; o1[j] = x1[j] * q[0] - x2[j] * q[1]; o2[j] = x2[j] * q[0] + x1[j] * q[1]; } }
        else {
#pragma unroll
            for (int j = 0; j < 8; ++j) { o1[j] = x1[j]; o2[j] = x2[j]; } }
        if (pass == 0) {
#pragma unroll
            for (int j = 0; j < 8; ++j) { o1[j] *= 0.088388347648318440f * 1.4426950408889634f * 8.f; o2[j] *= 0.088388347648318440f * 1.4426950408889634f * 8.f; } }
        if (active) { unsigned char* d8 = (pass == 0 ? (unsigned char*)(F.ws + WS_QB8) + (size_t)t * 1024 : (unsigned char*)(F.ws + WS_KB8) + (size_t)t * 256) + seg * 128 + axis * 64 + 8 * a;
            u32x2 w1, w2; w1.x = pk4_fp8(o1[0], o1[1], o1[2], o1[3]); w1.y = pk4_fp8(o1[4], o1[5], o1[6], o1[7]); w2.x = pk4_fp8(o2[0], o2[1], o2[2], o2[3]); w2.y = pk4_fp8(o2[4], o2[5], o2[6], o2[7]);
            *(u32x2*)d8 = w1; *(u32x2*)(d8 + 32) = w2; }
    }
}

__device__ __forceinline__ void vt8_task(Frame& F, int task, LAS unsigned char* scr) {
    const int dvq = task & 3, tile = (task >> 2) % 132, hh = task / (4 * 132), lane = F.lane; const bool da = hh >= 2; const int kvh = da ? hh - 2 : hh;
    const bf16_t* p = (const bf16_t*)(F.ws + WS_Z) + (size_t)(tile * 64 + lane) * NIN + (da ? C_VA : C_VB) + kvh * 128 + dvq * 32;
    const int kk = lane & 31, slot = ((kk >> 2) & 1) * 32 + (lane >> 5) * 16 + (kk & 3) + 4 * (kk >> 3);
#pragma unroll
    for (int q = 0; q < 4; ++q) { float x[8]; unpack8(*(const u32x4*)(p + 8 * q), x);
        const unsigned w0 = pk4_fp8(x[0], x[1], x[2], x[3]), w1 = pk4_fp8(x[4], x[5], x[6], x[7]);
#pragma unroll
        for (int j = 0; j < 4; ++j) { scr[(8 * q + j) * 80 + slot] = (unsigned char)(w0 >> (8 * j)); scr[(8 * q + 4 + j) * 80 + slot] = (unsigned char)(w1 >> (8 * j)); } }
    LDS_WAIT(); asm volatile("" ::: "memory");
    unsigned char* dst = (unsigned char*)(F.ws + (da ? WS_VA8T : WS_VB8T)) + ((size_t)(kvh * 132 + tile) * 128 + dvq * 32) * 64;
#pragma unroll
    for (int rep = 0; rep < 2; ++rep) { const int piece = lane + 64 * rep, row = piece >> 2, part = piece & 3;
        *(u32x4*)(dst + row * 64 + part * 16) = *(const LAS u32x4*)(scr + row * 80 + part * 16); }
    LDS_WAIT(); asm volatile("" ::: "memory");
}

__device__ __forceinline__ void da_combine_row(Frame& F, int l, int t, float lam, float one_m_li) {
    const int lane = F.lane, h = lane >> 3, d0 = (lane & 7) * 16;
    const bf16_t* o1p = (const bf16_t*)(F.ws + WS_ODA) + (size_t)t * DM + (2 * h) * 128 + d0; const bf16_t* o2p = o1p + 128;
    const float* w = F.in[I_SUBLN] + l * 128 + d0;
    float a[16], b[16]; unpack8(*(const u32x4*)o1p, *(float(*)[8])a); unpack8(*(const u32x4*)(o1p + 8), *(float(*)[8])(a + 8));
    unpack8(*(const u32x4*)o2p, *(float(*)[8])b); unpack8(*(const u32x4*)(o2p + 8), *(float(*)[8])(b + 8));
    float ss = 0.f;
#pragma unroll
    for (int j = 0; j < 16; ++j) { a[j] = a[j] - lam * b[j]; ss += a[j] * a[j]; }
    ss += __shfl_xor(ss, 1); ss += __shfl_xor(ss, 2); ss += __shfl_xor(ss, 4);
    const float r = one_m_li / sqrtf(ss * (1.f / 128.f) + 1e-5f);
#pragma unroll
    for (int j = 0; j < 16; ++j) a[j] = a[j] * r * w[j];
    bf16_t* out = (bf16_t*)(F.ws + WS_APB) + (size_t)t * 1024 + h * 128 + d0;
    *(u32x4*)out = pack8(*(float(*)[8])a); *(u32x4*)(out + 8) = pack8(*(float(*)[8])(a + 8));
}


__device__ __forceinline__ void s5_ktab_item(Frame& F, int idx) {
    const int hp = idx & 15, h = (idx >> 4) & 15, dir = (idx >> 8) & 1, g = (idx >> 9) & 63, l = idx >> 15;
    const int gi = (l * 2 + dir) * 64 + g;
    const float* cre = F.in[I_CRE] + ((size_t)gi * 16 + h) * 64; const float* cim = F.in[I_CIM] + ((size_t)gi * 16 + h) * 64;
    const f32x2* L1 = (const f32x2*)(F.ws + WS_POW) + ((size_t)gi * 17 + 1) * 64; const f32x2* BBF = (const f32x2*)(F.ws + WS_BBF) + (size_t)gi * 64 * 16 + hp;
    float acc[16];
#pragma unroll
    for (int k = 0; k < 16; ++k) acc[k] = 0.f;
#pragma unroll 4
    for (int p = 0; p < 64; ++p) { const float cr = cre[p], ci = cim[p]; const f32x2 L = L1[p], B = BBF[p * 16];
        float wr = cr * B[0] - ci * B[1], wi = cr * B[1] + ci * B[0];
#pragma unroll
        for (int k = 0; k < 16; ++k) { acc[k] += wr; const float nr = wr * L[0] - wi * L[1], ni = wr * L[1] + wi * L[0]; wr = nr; wi = ni; } }
    float* KT = (float*)(F.ws + WS_KTAB) + (size_t)((l * 64 + g) * 2 + dir) * 16 * 256 + h * 16 + hp;
#pragma unroll
    for (int k = 0; k < 16; ++k) KT[k * 256] = acc[k];
}
template <int NB>
__device__ __forceinline__ void s5_etab_items(Frame& F, int idx0, int stride, int nitems) {
    f32x2 L[NB], B[NB][8]; int im_[NB]; size_t dst[NB]; bool ok[NB];
#pragma unroll
    for (int b = 0; b < NB; ++b) { const int idx = idx0 + b * stride; ok[b] = idx < nitems; const int id = ok[b] ? idx : 0;
        const int k0 = (id & 31) * 8, n = (id >> 5) & 255, g = (id >> 13) & 63, l = id >> 19;
        const int dir = n >> 7, p = n & 63, tt = k0 >> 4, h0 = k0 & 15, e = dir == 0 ? 15 - tt : tt, gi = (l * 2 + dir) * 64 + g; im_[b] = (n >> 6) & 1;
        L[b] = ((const f32x2*)(F.ws + WS_POW))[((size_t)gi * 17 + e) * 64 + p]; const f32x2* BBF = (const f32x2*)(F.ws + WS_BBF) + ((size_t)gi * 64 + p) * 16 + h0;
#pragma unroll
        for (int j = 0; j < 8; ++j) B[b][j] = BBF[j];
        dst[b] = ((size_t)(l * 64 + g) * 256 + n) * 256 + k0; }
#pragma unroll
    for (int b = 0; b < NB; ++b) { float o[8];
#pragma unroll
        for (int j = 0; j < 8; ++j) o[j] = im_[b] ? L[b][0] * B[b][j][1] + L[b][1] * B[b][j][0] : L[b][0] * B[b][j][0] - L[b][1] * B[b][j][1];
        if (ok[b]) *(u32x4*)((bf16_t*)(F.ws + WS_ETAB) + dst[b]) = pack8(o); }
}
template <int NB>
__device__ __forceinline__ void s5_gtab_items(Frame& F, int idx0, int stride, int nitems) {
    f32x2 L[NB][8]; float cr[NB][8], ci[NB][8]; int im_[NB]; size_t dst[NB]; bool ok[NB];
#pragma unroll
    for (int b = 0; b < NB; ++b) { const int idx = idx0 + b * stride; ok[b] = idx < nitems; const int id = ok[b] ? idx : 0;
        const int k8 = id & 31, n = (id >> 5) & 255, g = (id >> 13) & 63, l = id >> 19;
        const int dir = k8 >> 4, comp0 = (k8 & 15) * 8, p0 = comp0 & 63, tt = n >> 4, h = n & 15, e = dir == 0 ? tt + 1 : 16 - tt, gi = (l * 2 + dir) * 64 + g; im_[b] = comp0 >> 6;
        const f32x2* POW = (const f32x2*)(F.ws + WS_POW) + ((size_t)gi * 17 + e) * 64 + p0;
        const float* cre = F.in[I_CRE] + ((size_t)gi * 16 + h) * 64 + p0; const float* cim = F.in[I_CIM] + ((size_t)gi * 16 + h) * 64 + p0;
#pragma unroll
        for (int j = 0; j < 8; ++j) { L[b][j] = POW[j]; cr[b][j] = cre[j]; ci[b][j] = cim[j]; }
        dst[b] = ((size_t)(l * 64 + g) * 256 + n) * 512 + 256 + 8 * k8; }
#pragma unroll
    for (int b = 0; b < NB; ++b) { float o[8];
#pragma unroll
        for (int j = 0; j < 8; ++j) o[j] = im_[b] ? -(cr[b][j] * L[b][j][1] + ci[b][j] * L[b][j][0]) : cr[b][j] * L[b][j][0] - ci[b][j] * L[b][j][1];
        if (ok[b]) *(u32x4*)((bf16_t*)(F.ws + WS_BTAB) + dst[b]) = pack8(o); }
}
template <int NB>
__device__ __forceinline__ void s5_ttab_items(Frame& F, int idx0, int stride, int nitems) {
    float o[NB][8]; size_t dst[NB]; bool ok[NB];
#pragma unroll
    for (int b = 0; b < NB; ++b) { const int idx = idx0 + b * stride; ok[b] = idx < nitems; const int id = ok[b] ? idx : 0;
        const int k0 = (id & 31) * 8, n = (id >> 5) & 255, g = (id >> 13) & 63, l = id >> 19;
        const int tp = k0 >> 4, hp0 = k0 & 15, tt = n >> 4, h = n & 15;
        const float* KT = (const float*)(F.ws + WS_KTAB) + (size_t)(l * 64 + g) * 2 * 16 * 256;
        const bool f = tp <= tt, r = tp >= tt;
        const float* kf = KT + (size_t)(f ? tt - tp : 0) * 256 + h * 16 + hp0; const float* kr = KT + (size_t)(16 + (r ? tp - tt : 0)) * 256 + h * 16 + hp0;
        const float dsk = F.in[I_S5D][l * 1024 + g * 16 + h];
#pragma unroll
        for (int j = 0; j < 8; ++j) o[b][j] = (f ? kf[j] : 0.f) + (r ? kr[j] : 0.f);
        if (tp == tt && (h >> 3) == (hp0 >> 3)) o[b][h & 7] += dsk;
        dst[b] = ((size_t)(l * 64 + g) * 256 + n) * 512 + k0; }
#pragma unroll
    for (int b = 0; b < NB; ++b) if (ok[b]) *(u32x4*)((bf16_t*)(F.ws + WS_BTAB) + dst[b]) = pack8(o[b]);
}
template <int PASS>
__device__ __forceinline__ void s5_scan_task(Frame& F, int l, int task) {
    const int run = task % 33, gd = task / 33, dir = gd & 1, g = gd >> 1, p = F.lane, gi = (l * 2 + dir) * 64 + g;
    const f32x2 L16 = ((const f32x2*)(F.ws + WS_POW))[((size_t)gi * 17 + 16) * 64 + p];
    const float* S = (const float*)(F.ws + WS_S) + (size_t)g * 768 * 256 + dir * 128 + p;
    f32x2* GF = (f32x2*)(F.ws + WS_F) + ((size_t)gd * 33) * 64 + p;
    float sr[16], si[16];
#pragma unroll
    for (int q = 0; q < 16; ++q) { const int s_ = run * 16 + q, c = dir == 0 ? (s_ < 16 ? 512 + s_ : s_ - 16) : 527 - s_; sr[q] = S[(size_t)c * 256]; si[q] = S[(size_t)c * 256 + 64]; }
    float xr = 0.f, xi = 0.f;
    if (PASS == 2) {
        float ar = L16[0], ai = L16[1];
#pragma unroll
        for (int q = 0; q < 4; ++q) { const float nr = ar * ar - ai * ai, ni = 2.f * ar * ai; ar = nr; ai = ni; }
        for (int r = 0; r < run; ++r) { const f32x2 f = GF[(size_t)r * 64]; const float nr = ar * xr - ai * xi + f[0], ni = ar * xi + ai * xr + f[1]; xr = nr; xi = ni; }
    }
    bf16_t* X = (bf16_t*)(F.ws + WS_AP) + (size_t)g * 768 * 512 + 256 + dir * 128 + p;
#pragma unroll
    for (int q = 0; q < 16; ++q) { const int s_ = run * 16 + q, c = dir == 0 ? (s_ < 16 ? 512 + s_ : s_ - 16) : 527 - s_;
        if (PASS == 2) { X[(size_t)c * 512] = (bf16_t)f2bf(xr); X[(size_t)c * 512 + 64] = (bf16_t)f2bf(xi); }
        const float nr = L16[0] * xr - L16[1] * xi + sr[q], ni = L16[0] * xi + L16[1] * xr + si[q]; xr = nr; xi = ni; }
    if (PASS == 1) GF[(size_t)run * 64] = (f32x2){xr, xi};
}

__global__ void __launch_bounds__(NTHR, 2) hyb_fwd(Args args) {
    extern __shared__ __attribute__((aligned(16))) unsigned char lds_raw[];
    Frame F;
    F.lds = (LAS unsigned char*)lds_raw;
    F.tid = threadIdx.x; F.lane = F.tid & 63; F.wave = __builtin_amdgcn_readfirstlane(F.tid >> 6);
    F.G = gridDim.x; { const int bx = blockIdx.x; F.vcu = (F.G % 8 == 0) ? (bx % 8) * (F.G / 8) + bx / 8 : bx; }
    F.gw = F.vcu * NWAVES + F.wave; F.NGW = F.G * NWAVES;
    F.out = (GAS float*)args.out; F.ws = (GAS unsigned char*)args.ws;
    volatile LAS unsigned* MISC = (volatile LAS unsigned*)(F.lds + MISC_OFF);
    for (int u = F.tid; u < (LDS_BYTES - RING_BYTES) / 4; u += NTHR) ((LAS unsigned*)(F.lds + RING_BYTES))[u] = 0u;
    __syncthreads();
    unsigned* ctl = (unsigned*)(F.ws + WS_CTL);
    XcdBarrier bar = xcd_barrier_post(ctl + CW_BAR, MISC + 8);
#define GRID_BAR() do { asm volatile("" : "+s"(bar.bar), "+s"(bar.x)); xcd_barrier(bar); F.tid = opaque_tid(); F.lane = F.tid & 63; asm volatile("" : "+s"(F.ws)); } while (0)
    LAS float* wscr = (LAS float*)(F.lds + F.wave * 16384);

    {
        for (int it = F.gw; it < NL * MOD_SLABS * 48; it += F.NGW) mod_item(F, it);
        for (int it = F.gw * 64 + F.lane; it < NL * 2 * 64 * 64; it += F.NGW * 64) s5_param_item(F, it);
        for (int it = F.gw * 64 + F.lane; it < 128 * 16 + 128 * 32; it += F.NGW * 64) {
            const bool da = it < 128 * 16; const int r = da ? it : it - 128 * 16, nf = da ? 16 : 32, pos = r / nf, i = r % nf;
            const float invf = (float)dexp(-(double)(2 * i) / (double)(2 * nf) * 9.210340371976184);
            const float ang = (float)pos * invf; double s, c; dsincos((double)ang, s, c);
            ((f32x2*)(F.ws + (da ? WS_ROPE_DA : WS_ROPE_GQ)))[r] = (f32x2){(float)c, (float)s};
        }
        if (F.gw < NL) { const int l = F.gw;
            const float a = wave_sum(F.in[I_LQ1][l * 64 + F.lane] * F.in[I_LK1][l * 64 + F.lane]), b = wave_sum(F.in[I_LQ2][l * 64 + F.lane] * F.in[I_LK2][l * 64 + F.lane]);
            const float lam_init = 0.8f - 0.6f * (float)dexp(-0.3 * (double)l);
            if (F.lane == 0) ((float*)(F.ws + WS_LAMV))[l] = (float)(dexp((double)a) - dexp((double)b)) + lam_init; }
    }
    GRID_BAR();
    for (int it = F.gw * 64 + F.lane; it < NL * 2 * 12288; it += F.NGW * 64) { const int j = it % 12288, ls = it / 12288, l = ls >> 1;
        float s = F.in[I_BADA][l * 12288 + j]; const float* P = (const float*)(F.ws + WS_MODP) + (size_t)ls * 12288 + j;
        for (int sl = 0; sl < MOD_SLABS; ++sl) s += P[(size_t)sl * NL * 2 * 12288];
        ((float*)(F.ws + WS_MOD))[it] = s; }
#pragma nounroll
    for (int pass_ = 0; pass_ < 2; ++pass_) {
        if ((pass_ == 0) == ((F.wave & 1) != 0)) {
            for (int it = F.gw * 64 + F.lane; it < NL * 64 * 2 * 256; it += F.NGW * 64) s5_ktab_item(F, it);
            for (int it = F.gw * 64 + F.lane; it < NL * 64 * 256 * 32; it += 4 * F.NGW * 64) { s5_etab_items<4>(F, it, F.NGW * 64, NL * 64 * 256 * 32); s5_gtab_items<4>(F, it, F.NGW * 64, NL * 64 * 256 * 32); }
        } else {
            for (int it = F.gw; it < NL * IT_LAYER; it += F.NGW) convert_item(F, it, wscr);
        }
    }
    GRID_BAR();
    for (int c = F.gw * 64 + F.lane; c < 2 * DM; c += F.NGW * 64) ((float*)(F.ws + WS_IDAFF))[c] = c < DM ? 1.f : 0.f;
#pragma nounroll
    for (int pass_ = 0; pass_ < 2; ++pass_) {
        if ((pass_ == 0) == ((F.wave & 1) != 0)) {
            for (int it = F.gw * 64 + F.lane; it < NL * 64 * 256 * 32; it += 4 * F.NGW * 64) s5_ttab_items<4>(F, it, F.NGW * 64, NL * 64 * 256 * 32);
        } else {
        for (int t = F.gw; t < NT; t += F.NGW) { const bool lat = t < NLAT; const float* md = (const float*)(F.ws + WS_MOD) + (lat ? 0 : 12288);
            const float* xr = lat ? F.in[I_X] + (size_t)t * DM : F.in[I_CTX] + (size_t)(t - NLAT) * DM;
            modulate_row(F.lane, xr, (lat ? (float*)(F.ws + WS_T) : (float*)(F.ws + WS_XRES)) + (size_t)t * DM, (bf16_t*)(F.ws + WS_H) + (size_t)t * DM, (unsigned char*)(F.ws + WS_H8) + (size_t)t * DM, md, md + DM);
            if (lat && F.lane == 0) { f32x2 st = {0.f, 1.f}; *(f32x2*)((float*)(F.ws + WS_STATS) + 2 * t) = st; } }
        }
    }
    GRID_BAR();

    for (int l = 0; l < NL; ++l) {
        GAS unsigned char* wl = F.ws + WS_W + (size_t)l * W_LAYER;
        const bool last = (l == NL - 1);
        const int Mrows = last ? NLAT : NT;
        const float* modl = (const float*)(F.ws + WS_MOD) + (size_t)l * 2 * 12288;
        { int k8_ = DM / 2; asm volatile("" : "+s"(k8_));
          pg8::Gemm g{(const bf16_t*)(F.ws + WS_H8), (const bf16_t*)(wl + W_IN8), NT, 9728, k8_, DM / 2, DM / 2}; pg8::WinOrder S; S.init(NT, 9728, F.G, (int)blockIdx.x);
          pg8::EpiIn E{(bf16_t*)(F.ws + WS_Z), (bf16_t*)(F.ws + WS_AP), 1, 1.f / 64.f};
          pg8::gemm_phase<pg8::EpiIn, pg8::WinOrder, true, true, true>(F.lds, g, S, E); }
        { pg8::Gemm g{(const bf16_t*)(F.ws + WS_H), (const bf16_t*)(wl + W_IN), NT, 2048, DM}; pg8::StaticOrder S; S.init(NT, 2048, F.G, ((int)blockIdx.x + 16) % F.G);
          pg8::EpiIn E{(bf16_t*)(F.ws + WS_Z), (bf16_t*)(F.ws + WS_AP), 0, 1.f};
          pg8::gemm_phase<pg8::EpiIn, pg8::StaticOrder, true, true, false>(F.lds, g, S, E); }
        GRID_BAR();
        for (int t = F.gw; t < NT; t += F.NGW) prep_row(F, l, t);
        for (int t = F.gw; t < 10 * 132 * 4; t += F.NGW) vt8_task(F, t, F.lds + F.wave * 16384);
        { __syncthreads(); int ks_ = 256; asm volatile("" : "+s"(ks_));
          pg8::Gemm g{(const bf16_t*)(F.ws + WS_AP), (const bf16_t*)(F.ws + WS_ETAB) + (size_t)l * 64 * 256 * 256, 64 * 768, 64 * 256, ks_, 512, 256}; pg8::S5Order S; S.init(3, F.G, (int)blockIdx.x);
          pg8::EpiS E{(float*)(F.ws + WS_S)};
          pg8::gemm_phase<pg8::EpiS, pg8::S5Order, true, true>(F.lds, g, S, E); }
        GRID_BAR();
        for (int t = F.gw; t < 128 * 33; t += F.NGW) s5_scan_task<1>(F, l, t);
        {
            const bf16_t* Z = (const bf16_t*)(F.ws + WS_Z);
#define GQ_UNIT(FAST_) att::attn_dense_body<true, FAST_>((const bf16_t*)((const unsigned char*)(F.ws + WS_QB8) + qrow * 1024 + h * 128), (const bf16_t*)((const unsigned char*)(F.ws + WS_KB8) + krow * 256 + (h >> 2) * 128), \
                (const bf16_t*)((const unsigned char*)(F.ws + WS_VB8T) + ((size_t)(h >> 2) * 132 + (krow >> 6)) * 8192), (bf16_t*)(F.ws + WS_APB) + ((size_t)NT + qrow) * 1024 + h * 128, 1024, seq, 0, 1.f, 8.f, (char*)lds_raw)
#define DA_UNIT(FAST_) att::attn_dense_body<false, FAST_>((const bf16_t*)((const unsigned char*)(F.ws + WS_QKA8) + qrow * 2048 + hs * 64), (const bf16_t*)((const unsigned char*)(F.ws + WS_QKA8) + krow * 2048 + 1024 + hs * 64), \
                (const bf16_t*)((const unsigned char*)(F.ws + WS_VA8T) + ((size_t)(hs >> 1) * 132 + (krow >> 6)) * 8192), (bf16_t*)(F.ws + WS_ODA) + qrow * DM + hs * 128, DM, seq, 0, 1.f, 8.f, (char*)lds_raw)
            unsigned redo = 0u, bit = 1u;
            for (int u = (int)blockIdx.x; u < 256 + (last ? 0 : 24); u += F.G, bit <<= 1) { if (u >= 256 && u < 272) continue;
                const bool cx = u >= 256; const int h = cx ? u - 272 : u >> 5, seq = cx ? NCTX : NT; const size_t qrow = cx ? (size_t)NLAT : (size_t)(u & 31) * 256, krow = cx ? (size_t)NLAT : 0;
                if (GQ_UNIT(true)) redo |= bit;
                __syncthreads();
            }
            bit = 1u << 8;
            for (int u = (int)blockIdx.x; u < 512 + (last ? 0 : 16); u += F.G, bit <<= 1) {
                const bool cx = u >= 512; const int hs = cx ? u - 512 : u >> 5, seq = cx ? NCTX : NT; const size_t qrow = cx ? (size_t)NLAT : (size_t)(u & 31) * 256, krow = cx ? (size_t)NLAT : 0;
                if (DA_UNIT(true)) redo |= bit;
                __syncthreads();
            }
            if (redo & 0xffu) { bit = 1u;
                for (int u = (int)blockIdx.x; u < 256 + (last ? 0 : 24); u += F.G, bit <<= 1) { if (!(redo & bit)) continue;
                    const bool cx = u >= 256; const int h = cx ? u - 272 : u >> 5, seq = cx ? NCTX : NT; const size_t qrow = cx ? (size_t)NLAT : (size_t)(u & 31) * 256, krow = cx ? (size_t)NLAT : 0;
                    GQ_UNIT(false); __syncthreads(); } }
            if (redo >> 8) { bit = 1u << 8;
                for (int u = (int)blockIdx.x; u < 512 + (last ? 0 : 16); u += F.G, bit <<= 1) { if (!(redo & bit)) continue;
                    const bool cx = u >= 512; const int hs = cx ? u - 512 : u >> 5, seq = cx ? NCTX : NT; const size_t qrow = cx ? (size_t)NLAT : (size_t)(u & 31) * 256, krow = cx ? (size_t)NLAT : 0;
                    DA_UNIT(false); __syncthreads(); } }
#undef GQ_UNIT
#undef DA_UNIT
        }
        GRID_BAR();
        { const float lam = ((const float*)(F.ws + WS_LAMV))[l]; const float lam_init = 0.8f - 0.6f * __expf(-0.3f * (float)l);
          for (int t = F.gw; t < 128 * 33; t += F.NGW) s5_scan_task<2>(F, l, t);
          for (int t = F.gw; t < Mrows; t += F.NGW) da_combine_row(F, l, t, lam, 1.f - lam_init); }
        GRID_BAR();
        { pg8::Gemm g{(const bf16_t*)(F.ws + WS_APB), (const bf16_t*)(wl + W_PAB), 2 * NT, 4096, 1024}; pg8::PairOrder S; S.init(Mrows / 256, F.G, (int)blockIdx.x);
          pg8::EpiGate E{(const bf16_t*)(F.ws + WS_Z), (bf16_t*)(F.ws + WS_PG)};
          pg8::gemm_phase<pg8::EpiGate, pg8::PairOrder, true, true>(F.lds, g, S, E); }
        {
          int ky_ = 512; asm volatile("" : "+s"(ky_));
          pg8::Gemm g{(const bf16_t*)(F.ws + WS_AP), (const bf16_t*)(F.ws + WS_BTAB) + (size_t)l * 64 * 256 * 512, 64 * 768, 64 * 256, ky_, 512, 512}; pg8::S5Order S;
          S.init(last ? 2 : 3, F.G, (!last && F.G == 256) ? (int)blockIdx.x - 16 : (int)blockIdx.x);
          pg8::EpiY E{(bf16_t*)(F.ws + WS_AGLU), last ? 512 : 528};
          pg8::gemm_phase<pg8::EpiY, pg8::S5Order, true, true>(F.lds, g, S, E); }
        GRID_BAR();
        { pg8::Gemm g{(const bf16_t*)(F.ws + WS_AGLU), (const bf16_t*)(wl + W_GLU), Mrows, 4096, 1024}; pg8::StaticOrder S; S.init(Mrows, 4096, F.G, (int)blockIdx.x);
          pg8::EpiGlu E{(const bf16_t*)(F.ws + WS_Z), (const bf16_t*)(F.ws + WS_PG), (bf16_t*)(F.ws + WS_MRG)};
          pg8::gemm_phase<pg8::EpiGlu, pg8::StaticOrder, true, true>(F.lds, g, S, E); }
        GRID_BAR();
        { pg8::Gemm g{(const bf16_t*)(F.ws + WS_MRG), (const bf16_t*)(wl + W_O), Mrows, DM, DM}; pg8::ResSplitOrder S; S.init(DM, F.G, (int)blockIdx.x, !last, SPLIT_O, (DM / 64) / SPLIT_O);
          const float* pg_ = l == 0 ? (const float*)(F.ws + WS_IDAFF) : F.in[I_LNFG] + (l - 1) * DM; const float* pb_ = l == 0 ? (const float*)(F.ws + WS_IDAFF) + DM : F.in[I_LNFB] + (l - 1) * DM;
          pg8::EpiRes E{(const float*)(F.ws + WS_STATS), pg_, pb_, (float*)(F.ws + WS_T), modl + 2 * DM, modl + 12288 + 2 * DM, (float*)(F.ws + WS_SLAB)};
          pg8::gemm_phase<pg8::EpiRes, pg8::ResSplitOrder, true, true>(F.lds, g, S, E); }
        GRID_BAR();
        {
        for (int t = F.gw; t < NLAT; t += F.NGW)
            ln_row(F.lane, (const float*)(F.ws + WS_T) + (size_t)t * DM, (float*)nullptr, (bf16_t*)(F.ws + WS_H) + (size_t)t * DM,
                   F.in[I_LNMG] + l * DM, F.in[I_LNMB] + l * DM, modl + 3 * DM, modl + 4 * DM, (unsigned char*)nullptr, (float*)(F.ws + WS_STATS) + 2 * t);
        if (!last) for (int r = (int)blockIdx.x; r < NCTX; r += F.G) { const float* md = modl + 12288;
            ln_ctx_row(F, r, (const float*)(F.ws + WS_SLAB), SPLIT_O, md + 2 * DM, F.in[I_LNMG] + l * DM, F.in[I_LNMB] + l * DM, md + 3 * DM, md + 4 * DM, false); }
        }
        GRID_BAR();
        { pg8::Gemm g{(const bf16_t*)(F.ws + WS_H), (const bf16_t*)(wl + W_GU), Mrows, 2 * FF, DM}; pg8::StaticOrder S; S.init(Mrows, 2 * FF, F.G, (int)blockIdx.x);
          pg8::EpiSwi E{(bf16_t*)(F.ws + WS_ACT)};
          pg8::gemm_phase<pg8::EpiSwi, pg8::StaticOrder, true, true>(F.lds, g, S, E); }
        GRID_BAR();
        { pg8::Gemm g{(const bf16_t*)(F.ws + WS_ACT), (const bf16_t*)(wl + W_DN), Mrows, DM, FF}; pg8::ResSplitOrder S; S.init(DM, F.G, (int)blockIdx.x, !last, SPLIT_D, (FF / 64) / SPLIT_D);
          pg8::EpiRes E{(const float*)(F.ws + WS_STATS), F.in[I_LNMG] + l * DM, F.in[I_LNMB] + l * DM, (float*)(F.ws + WS_T), modl + 5 * DM, modl + 12288 + 5 * DM, (float*)(F.ws + WS_SLAB)};
          pg8::gemm_phase<pg8::EpiRes, pg8::ResSplitOrder, true, true>(F.lds, g, S, E); }
        GRID_BAR();
        {
        for (int t = F.gw; t < NLAT; t += F.NGW) { const float* mdn = modl + 2 * 12288;
            float* dst = last ? (float*)(F.out + (size_t)t * DM) : (float*)nullptr;
            ln_row(F.lane, (const float*)(F.ws + WS_T) + (size_t)t * DM, dst, last ? (bf16_t*)nullptr : (bf16_t*)(F.ws + WS_H) + (size_t)t * DM,
                   F.in[I_LNFG] + l * DM, F.in[I_LNFB] + l * DM, mdn, mdn + DM, last ? (unsigned char*)nullptr : (unsigned char*)(F.ws + WS_H8) + (size_t)t * DM, (float*)(F.ws + WS_STATS) + 2 * t); }
        if (!last) for (int r = (int)blockIdx.x; r < NCTX; r += F.G) { const float* mdn = modl + 3 * 12288;
            ln_ctx_row(F, r, (const float*)(F.ws + WS_SLAB), SPLIT_D, modl + 12288 + 5 * DM, F.in[I_LNFG] + l * DM, F.in[I_LNFB] + l * DM, mdn, mdn + DM, true); }
        }
        if (!last) GRID_BAR();
    }
}

extern "C" void kernel_launch(void* const* d_in, const int* in_sizes, int n_in, void* d_out, int out_size, void* d_ws, size_t ws_size, hipStream_t stream) {
    static int grid = 0;
    if (grid == 0) {
        if (n_in != 33 || out_size != NLAT * DM || ws_size < WS_END) { fprintf(stderr, "kernel_launch: built for 33 inputs, out %d, ws >= %zu; got n_in %d out %d ws %zu\n", NLAT * DM, (size_t)WS_END, n_in, out_size, ws_size); grid = -1; return; }
        int dev = 0, cus = 0;
        if (hipGetDevice(&dev) != hipSuccess || hipDeviceGetAttribute(&cus, hipDeviceAttributeMultiprocessorCount, dev) != hipSuccess) { grid = -1; return; }
        if (hipFuncSetAttribute((const void*)hyb_fwd, hipFuncAttributeMaxDynamicSharedMemorySize, LDS_BYTES) != hipSuccess) { fprintf(stderr, "kernel_launch: hipFuncSetAttribute failed\n"); grid = -1; return; }
        int per_cu = 0;
        if (hipOccupancyMaxActiveBlocksPerMultiprocessor(&per_cu, (const void*)hyb_fwd, NTHR, LDS_BYTES) != hipSuccess || per_cu < 1) { fprintf(stderr, "kernel_launch: occupancy query says %d\n", per_cu); }
        (void)hipGetLastError();
        grid = cus;
    }
    if (grid < 0) return;
    (void)hipMemsetAsync((char*)d_ws + WS_CTL, 0, CTL_ZERO_BYTES, stream);
    Args a{};
    for (int i = 0; i < 33; ++i) a.in[i] = (const float*)d_in[i];
    a.out = (float*)d_out; a.ws = (unsigned char*)d_ws;
    hipLaunchKernelGGL(hyb_fwd, dim3(grid), dim3(NTHR), LDS_BYTES, stream, a);
}
```

```cpp
#include <hip/hip_runtime.h>
#include <cstdio>
#include <cstdint>

#define LAS __attribute__((address_space(3)))
#define GAS __attribute__((address_space(1)))
typedef unsigned short bf16_t;
typedef short bf16x8 __attribute__((ext_vector_type(8)));
typedef short s16x4 __attribute__((ext_vector_type(4)));
typedef float f32x4 __attribute__((ext_vector_type(4)));
typedef float f32x2 __attribute__((ext_vector_type(2)));
typedef float f32x16 __attribute__((ext_vector_type(16)));
typedef unsigned u32x4 __attribute__((ext_vector_type(4)));
typedef unsigned u32x2 __attribute__((ext_vector_type(2)));

constexpr int NT = 8448, NLAT = 8192, NCTX = 256, DM = 2048, NIN = 11776, FF = 5632, NL = 4;
constexpr int C_QA = 0, C_KA = 1024, C_VA = 2048, C_QB = 3072, C_KB = 4096, C_VB = 4352, C_U = 4608, C_G = 5632;
constexpr float DN_ALPHA = 1.6817928305074290f;
constexpr int NWAVES = 8, NTHR = 512;
constexpr int MOD_SLABS = 32;

constexpr size_t al256(size_t x) { return (x + 255) & ~(size_t)255; }
constexpr size_t WS_CTL = 0, CTL_ZERO_BYTES = 1u << 20;
constexpr size_t WS_MODP = CTL_ZERO_BYTES;
constexpr size_t WS_MOD = WS_MODP + al256((size_t)MOD_SLABS * NL * 2 * 12288 * 4);
constexpr size_t WS_LAMV = WS_MOD + al256((size_t)NL * 2 * 12288 * 4);
constexpr size_t WS_ROPE_DA = WS_LAMV + 256;
constexpr size_t WS_ROPE_GQ = WS_ROPE_DA + 128 * 16 * 8;
constexpr size_t WS_LAM = WS_ROPE_GQ + 128 * 32 * 8;
constexpr size_t WS_BB = WS_LAM + (size_t)NL * 2 * 64 * 64 * 16;
constexpr size_t WS_CC = WS_BB + (size_t)NL * 2 * 64 * 128 * 16 * 2;
constexpr size_t WS_F = WS_CC + (size_t)NL * 64 * 16 * 256 * 2;
constexpr size_t WS_W = al256(WS_F + (size_t)2 * 66 * 64 * 64 * 8);
__host__ __device__ constexpr bool win_tile_fp8(int pt) { return !((pt >= 8 && pt < 12) || (pt >= 18 && pt < 22)); }
__host__ __device__ constexpr int win_tile_slot(int pt) { return pt < 8 ? pt : pt < 12 ? pt - 8 : pt < 18 ? pt - 4 : pt < 22 ? pt - 14 : pt - 8; }
__host__ __device__ constexpr int win_fp8_tile(int j) { return j < 8 ? j : j < 14 ? j + 4 : j + 8; }
__host__ __device__ constexpr int win_bf16_tile(int j) { return j < 4 ? j + 8 : j + 14; }
constexpr size_t W_IN = 0;
constexpr size_t W_PAB = W_IN + (size_t)2048 * DM * 2;
constexpr size_t W_GLU = W_PAB + (size_t)4096 * 1024 * 2;
constexpr size_t W_O = W_GLU + (size_t)4096 * 1024 * 2;
constexpr size_t W_GU = W_O + (size_t)DM * DM * 2;
constexpr size_t W_DN = W_GU + (size_t)2 * FF * DM * 2;
constexpr size_t W_IN8 = W_DN + (size_t)DM * FF * 2;
constexpr size_t W_LAYER = W_IN8 + (size_t)9728 * DM;
constexpr size_t WS_XRES = al256(WS_W + NL * W_LAYER);
constexpr size_t WS_H = WS_XRES + (size_t)NT * DM * 4;
constexpr size_t WS_Z = WS_H + (size_t)NT * DM * 2;
constexpr size_t WS_ODA = WS_Z + (size_t)NT * NIN * 2;
constexpr size_t WS_APB = WS_ODA + (size_t)NT * DM * 2;
constexpr size_t WS_AGLU = WS_APB + (size_t)2 * NT * 1024 * 2;
constexpr size_t WS_PG = WS_AGLU + (size_t)NT * 1024 * 2;
constexpr size_t WS_MRG = WS_PG + (size_t)2 * NT * DM * 2;
constexpr size_t WS_T = WS_MRG + (size_t)NT * DM * 2;
constexpr size_t WS_ACT = WS_T + (size_t)NT * DM * 4;
constexpr size_t WS_SLAB = WS_ACT + (size_t)NT * FF * 2;
constexpr int SPLIT_O = 16, SPLIT_D = 22;
constexpr size_t WS_POW = WS_SLAB + (size_t)SPLIT_D * NCTX * DM * 4;
constexpr size_t WS_BBF = WS_POW + (size_t)NL * 2 * 64 * 17 * 64 * 8;
constexpr size_t WS_KTAB = WS_BBF + (size_t)NL * 2 * 64 * 64 * 16 * 8;
constexpr size_t WS_ETAB = WS_KTAB + (size_t)NL * 64 * 2 * 16 * 256 * 4;
constexpr size_t WS_BTAB = WS_ETAB + (size_t)NL * 64 * 256 * 256 * 2;
constexpr size_t WS_AP = WS_BTAB + (size_t)NL * 64 * 256 * 512 * 2;
constexpr size_t WS_S = WS_AP + (size_t)64 * 768 * 512 * 2;
constexpr size_t WS_H8 = WS_S + (size_t)64 * 768 * 256 * 4;
constexpr size_t WS_QB8 = WS_H8 + (size_t)NT * DM;
constexpr size_t WS_KB8 = WS_QB8 + (size_t)NT * 1024;
constexpr size_t WS_QKA8 = WS_KB8 + (size_t)NT * 256;
constexpr size_t WS_VB8T = WS_QKA8 + (size_t)NT * 2048;
constexpr size_t WS_VA8T = WS_VB8T + (size_t)2 * 132 * 128 * 64;
constexpr size_t WS_STATS = WS_VA8T + (size_t)8 * 132 * 128 * 64;
constexpr size_t WS_IDAFF = WS_STATS + (size_t)NLAT * 8;
constexpr size_t WS_END = WS_IDAFF + (size_t)2 * DM * 4;

constexpr int CW_TMO = 0, CW_BAR = 4096, CW_FLOW = 16384;

__device__ __forceinline__ unsigned f2bf(float f) { unsigned u = __builtin_bit_cast(unsigned, f); return (u + 0x7fffu + ((u >> 16) & 1u)) >> 16; }
__device__ __forceinline__ unsigned pk2(float lo, float hi) { return f2bf(lo) | (f2bf(hi) << 16); }
typedef float f32x2_ __attribute__((ext_vector_type(2))); typedef __bf16 bf16x2_ __attribute__((ext_vector_type(2)));
__device__ __forceinline__ unsigned cvt_pk_bf16(float lo, float hi) { const f32x2_ v = {lo, hi}; return __builtin_bit_cast(unsigned, __builtin_convertvector(v, bf16x2_)); }
__device__ __forceinline__ float bflo(unsigned w) { return __builtin_bit_cast(float, w << 16); }
__device__ __forceinline__ float bfhi(unsigned w) { return __builtin_bit_cast(float, w & 0xffff0000u); }
__device__ __forceinline__ void unpack8(u32x4 w, float (&f)[8]) { f[0] = bflo(w.x); f[1] = bfhi(w.x); f[2] = bflo(w.y); f[3] = bfhi(w.y); f[4] = bflo(w.z); f[5] = bfhi(w.z); f[6] = bflo(w.w); f[7] = bfhi(w.w); }
__device__ __forceinline__ u32x4 pack8(const float (&f)[8]) { u32x4 w; w.x = cvt_pk_bf16(f[0], f[1]); w.y = cvt_pk_bf16(f[2], f[3]); w.z = cvt_pk_bf16(f[4], f[5]); w.w = cvt_pk_bf16(f[6], f[7]); return w; }
__device__ __forceinline__ unsigned pk4_fp8(float a, float b, float c, float d) { int w = __builtin_amdgcn_cvt_pk_fp8_f32(a, b, 0, false); w = __builtin_amdgcn_cvt_pk_fp8_f32(c, d, w, true); return (unsigned)w; }
__device__ __forceinline__ float sigmoidf_(float x) { return __builtin_amdgcn_rcpf(1.f + __builtin_amdgcn_exp2f(-1.4426950408889634f * x)); }
__device__ __forceinline__ float siluf_(float x) { return x * sigmoidf_(x); }
__device__ __forceinline__ float gelu_tanh(float x) { const float z = 0.7978845608028654f * (x + 0.044715f * x * x * x); return x * sigmoidf_(2.f * z); }
__device__ __forceinline__ float wave_sum(float v) {
#pragma unroll
    for (int o = 1; o < 64; o <<= 1) v += __shfl_xor(v, o);
    return v;
}
__device__ __forceinline__ int opaque_tid() { int t = threadIdx.x; asm volatile("" : "+v"(t)); return t; }
#define LDS_WAIT() asm volatile("s_waitcnt lgkmcnt(0)" ::: "memory")
#define VM_WAIT() asm volatile("s_waitcnt vmcnt(0)" ::: "memory")

__device__ __forceinline__ void dsincos(double x, double& s, double& c) {
    const double inv2pi = 0.15915494309189533577, twopi = 6.283185307179586476925;
    double r = x * inv2pi; r = r - __builtin_rint(r); r *= twopi;
    double sg = 1.0;
    if (r > 1.5707963267948966) { r = 3.141592653589793 - r; sg = -1.0; } else if (r < -1.5707963267948966) { r = -3.141592653589793 - r; sg = -1.0; }
    const double r2 = r * r;
    double ss = 1.0, cc = 1.0, ts = 1.0, tc = 1.0;
#pragma unroll
    for (int k = 1; k <= 12; ++k) { tc *= -r2 / (double)((2 * k - 1) * (2 * k)); ts *= -r2 / (double)((2 * k) * (2 * k + 1)); cc += tc; ss += ts; }
    s = ss * r; c = sg * cc;
}
__device__ __forceinline__ double dexp(double x) {
    const double n = __builtin_rint(x * 1.4426950408889634);
    const double r = x - n * 0.6931471805599453094;
    double t = 1.0, sum = 1.0;
#pragma unroll
    for (int k = 1; k <= 14; ++k) { t *= r / (double)k; sum += t; }
    return __builtin_ldexp(sum, (int)n);
}

namespace pg8 {
constexpr int BM = 256, BK = 64, HALF = 128, HTB = HALF * BK * 2, STAGE_BYTES = 8 * HTB, NXCD = 8, WGM = 8;
__host__ __device__ __forceinline__ int lds_byte(int r, int c) { const int st = (r >> 4) * 2 + (c >> 5), rr = r & 15, cc = c & 31, ob = rr * 64 + cc * 2; return st * 1024 + (ob ^ (((ob >> 9) & 1) << 5)); }
__host__ __device__ __forceinline__ void stage_rc(int b, int& R, int& C) { const int st = b / 1024, sb = b % 1024, swz = sb ^ (((sb >> 9) & 1) << 5); R = (st >> 1) * 16 + swz / 64; C = (st & 1) * 32 + (swz % 64) / 2; }
__host__ __device__ __forceinline__ int perm32(int rho) { const int n = rho >> 4, i = rho & 15; return 8 * (i >> 2) + 4 * n + (i & 3); }
struct Unit { int pm, pn, kt0, nt; };
struct Gemm { const bf16_t* A; const bf16_t* Bt; int M, N, K, lda, ldb; };
__device__ __forceinline__ void unit_signal(unsigned* cnt) {
    asm volatile("s_waitcnt vmcnt(0)" ::: "memory"); __builtin_amdgcn_s_barrier();
    if (threadIdx.x == 0) { __builtin_amdgcn_fence(__ATOMIC_RELEASE, "agent"); asm volatile("s_waitcnt vmcnt(0)" ::: "memory"); (void)__hip_atomic_fetch_add(cnt, 1u, __ATOMIC_RELAXED, __HIP_MEMORY_SCOPE_AGENT); }
}
__device__ __forceinline__ void unit_wait(unsigned* cnt, unsigned target) {
    if (threadIdx.x == 0) { unsigned sp = 0u; while (__hip_atomic_load(cnt, __ATOMIC_RELAXED, __HIP_MEMORY_SCOPE_AGENT) < target) { __builtin_amdgcn_s_sleep(1); if (++sp > (1u << 22)) break; }
        __builtin_amdgcn_fence(__ATOMIC_ACQUIRE, "agent"); asm volatile("s_waitcnt vmcnt(0)" ::: "memory"); }
    __builtin_amdgcn_s_barrier();
}
struct StaticOrder {
    int nM, nN, nwg, G, c;
    __host__ __device__ void init(int M, int N, int G_, int c_) { nM = M / BM; nN = N / BM; nwg = nM * nN; G = G_; c = c_; }
    __host__ __device__ bool next(int i, Unit& u) const { const long L = (long)i * G + c; if (L >= nwg) return false; unit((int)L, u); return true; }
    __host__ __device__ void unit(int L, Unit& u) const {
        int wgid = L; { const int q = nwg / NXCD, r = nwg % NXCD, xcd = wgid % NXCD, off = wgid / NXCD; wgid = (xcd < r ? xcd * (q + 1) : r * (q + 1) + (xcd - r) * q) + off; }
        const int nig = WGM * nN, gid = wgid / nig, fm = gid * WGM, gsz = (nM - fm) < WGM ? (nM - fm) : WGM;
        u.pm = fm + ((wgid % nig) % gsz); u.pn = (wgid % nig) / gsz; u.kt0 = 0; u.nt = 0;
    }
    __device__ __forceinline__ void a_ready(const Unit&) const {}
    __device__ __forceinline__ void done(const Unit&) const {}
};
struct WinOrder {
    StaticOrder b;
    __host__ __device__ void init(int M, int N, int G_, int c_) { b.init(M, N, G_, c_); }
    __host__ __device__ bool next(int i, Unit& u) const {
        if (b.G != 256) return b.next(i, u);
        const int c = b.c; int L;
        if (i < 3) L = i * 256 + c;
        else if (i == 3) { if (c >= 240 && c < 248) return false; L = 768 + c; }
        else if (i == 4) { if (c < 230) L = 1024 + c; else if (c < 238) L = 768 + c + 10; else return false; }
        else return false;
        b.unit(L, u); return true;
    }
    __device__ __forceinline__ void a_ready(const Unit&) const {}
    __device__ __forceinline__ void done(const Unit&) const {}
};
struct PairOrder {
    int nM, nwg, G, c; unsigned* sig;
    __host__ __device__ void init(int nM_, int G_, int c_, unsigned* sig_ = nullptr) { nM = nM_; nwg = 2 * nM_ * 8; G = G_; c = c_; sig = sig_; }
    __host__ __device__ bool next(int i, Unit& u) const {
        if (nM == 33 && G == 256) {
            const int j = c < 16 ? i - 1 : i;
            if (j < 0) { const int which = c >> 3; u.pm = 33 * which + 32; u.pn = 8 * which + (c & 7); u.kt0 = 0; u.nt = 0; return true; }
            if (j < 2) { const int L = j * 256 + c, which = L >> 8, r = L & 255; u.pm = 33 * which + (r & 31); u.pn = 8 * which + (r >> 5); u.kt0 = 0; u.nt = 0; return true; }
            return false;
        }
        const long L = (long)i * G + c; if (L >= nwg) return false;
        const int per = nM * 8, which = (int)L / per, r = (int)L % per;
        u.pm = 33 * which + (r % nM); u.pn = 8 * which + (r / nM); u.kt0 = 0; u.nt = 0; return true;
    }
    __device__ __forceinline__ void a_ready(const Unit&) const {}
    __device__ __forceinline__ void done(const Unit& u) const { if (sig && (u.pm == 32 || u.pm == 65)) unit_signal(sig); }
};

struct ResSplitOrder {
    StaticOrder lat; int G, c, S, ntS; bool ctx;
    __host__ __device__ void init(int N, int G_, int c_, bool ctx_, int S_, int ntS_) { lat.init(8192, N, G_, c_); G = G_; c = c_; ctx = ctx_; S = S_; ntS = ntS_; }
    __host__ __device__ bool next(int i, Unit& u) const {
        const long L = (long)i * G + c;
        if (L < lat.nwg) return lat.next(i, u);
        const int j = (int)(L - lat.nwg); if (!ctx || j >= 8 * S) return false;
        u.pm = 32; u.pn = j & 7; u.kt0 = (j >> 3) * ntS; u.nt = ntS; return true;
    }
    __device__ __forceinline__ void a_ready(const Unit&) const {}
    __device__ __forceinline__ void done(const Unit&) const {}
};
struct S5Order {
    int nmt, G, c; unsigned* sig;
    __host__ __device__ void init(int nmt_, int G_, int c_, unsigned* sig_ = nullptr) { nmt = nmt_; G = G_; c = c_; sig = sig_; }
    __host__ __device__ bool next(int i, Unit& u) const {
        const long L = (long)i * G + c; if (c < 0 || L >= 64 * nmt) return false;
        const int g = (int)L / nmt, mt = (int)L % nmt; u.pm = 3 * g + mt; u.pn = g; u.kt0 = 0; u.nt = 0; return true;
    }
    __device__ __forceinline__ void a_ready(const Unit&) const {}
    __device__ __forceinline__ void done(const Unit& u) const { if (sig && u.pm - 3 * u.pn == 2) unit_signal(sig); }
};
struct CtxGluOrder {
    int c; unsigned* w1; unsigned* w2;
    __host__ __device__ void init(int c_, unsigned* w1_, unsigned* w2_) { c = c_; w1 = w1_; w2 = w2_; }
    __host__ __device__ bool next(int i, Unit& u) const { if (i != 0 || c < 0 || c >= 16) return false; u.pm = 32; u.pn = c; u.kt0 = 0; u.nt = 0; return true; }
    __device__ __forceinline__ void a_ready(const Unit&) const { unit_wait(w1, 16u); unit_wait(w2, 64u); }
    __device__ __forceinline__ void done(const Unit&) const {}
};
template <class Epi, class Sched, bool ALIGN_EPI = false, bool SP2 = false, bool FP8 = false>
__device__ __forceinline__ void gemm_phase(LAS unsigned char* lds, const Gemm g, const Sched& S, const Epi& E) {
    const int tid = opaque_tid(), wid = __builtin_amdgcn_readfirstlane(tid >> 6), lane = tid & 63, wr = wid >> 2, wc = wid & 3, fr = lane & 15, fq = lane >> 4;
    const int K = g.K, nt = K / BK, lda = g.lda ? g.lda : K, ldb = g.ldb ? g.ldb : K;
    unsigned voffA[2], voffB[2];
#pragma unroll
    for (int i = 0; i < 2; ++i) { int R, C; stage_rc(tid * 16 + i * 8192, R, C); const int Rb = Epi::PERM ? ((R & ~31) + perm32(R & 31)) : R;
        voffA[i] = (unsigned)(R * lda + C) * 2u; voffB[i] = (unsigned)(Rb * ldb + C) * 2u; }
    const size_t kstep = (size_t)(BK * 2);
    const size_t hstepA = (size_t)HALF * lda * 2, hstepB = (size_t)HALF * ldb * 2;
    const size_t tstepA = 2 * hstepA, tstepB = 2 * hstepB;
    const unsigned ldsw = (unsigned)wid * 1024u;
    const int aoff = lds_byte(wr * 64 + fr, fq * 8), boff = lds_byte(wc * 32 + fr, fq * 8);
#define PG8_SA(b, h) (((b) * 2 + (h)) * HTB)
#define PG8_SB(b, h) ((4 + (b) * 2 + (h)) * HTB)
#define PG8_STAGE(bufoff, gbase, voff) do { _Pragma("unroll") for (int _i = 0; _i < 2; ++_i) \
        __builtin_amdgcn_global_load_lds((const unsigned*)((const char*)(gbase) + (voff)[_i]), (LAS unsigned*)(lds + (bufoff) + ldsw + _i * 8192), 16, 0, 0); } while (0)
    typedef int v8i_ __attribute__((ext_vector_type(8))); typedef int v4i_ __attribute__((ext_vector_type(4)));
#define PG8_LDA(dst, b, h) do { _Pragma("unroll") for (int m = 0; m < 4; ++m) { const v4i_ lo_ = *(const LAS v4i_*)(lds + PG8_SA(b, h) + aoff + m * 2048), hi_ = *(const LAS v4i_*)(lds + PG8_SA(b, h) + aoff + m * 2048 + 1024); \
        dst[m] = __builtin_shufflevector(lo_, hi_, 0, 1, 2, 3, 4, 5, 6, 7); } } while (0)
#define PG8_LDB(dst, b, h) do { _Pragma("unroll") for (int n = 0; n < 2; ++n) { const v4i_ lo_ = *(const LAS v4i_*)(lds + PG8_SB(b, h) + boff + n * 2048), hi_ = *(const LAS v4i_*)(lds + PG8_SB(b, h) + boff + n * 2048 + 1024); \
        dst[n] = __builtin_shufflevector(lo_, hi_, 0, 1, 2, 3, 4, 5, 6, 7); } } while (0)
#define PG8_HALF(v, k) __builtin_bit_cast(bf16x8, (k) == 0 ? __builtin_shufflevector(v, v, 0, 1, 2, 3) : __builtin_shufflevector(v, v, 4, 5, 6, 7))
#define PG8_MMA(ai, bj, At, Bt) do { __builtin_amdgcn_s_setprio(1); _Pragma("unroll") for (int m = 0; m < 4; ++m) _Pragma("unroll") for (int n = 0; n < 2; ++n) { \
        if constexpr (FP8) asm volatile("v_mfma_scale_f32_16x16x128_f8f6f4 %0, %1, %2, %0, %3, %3 op_sel_hi:[0,0,0]" : "+v"(acc[ai][bj][m][n]) : "v"(Bt[n]), "v"(At[m]), "v"(one_scale));   \
        else { acc[ai][bj][m][n] = __builtin_amdgcn_mfma_f32_16x16x32_bf16(PG8_HALF(Bt[n], 0), PG8_HALF(At[m], 0), acc[ai][bj][m][n], 0, 0, 0); \
               acc[ai][bj][m][n] = __builtin_amdgcn_mfma_f32_16x16x32_bf16(PG8_HALF(Bt[n], 1), PG8_HALF(At[m], 1), acc[ai][bj][m][n], 0, 0, 0); } } \
        __builtin_amdgcn_s_setprio(0); } while (0)
#define PG8_WAIT_V(n) asm volatile("s_waitcnt vmcnt(" #n ")" ::: "memory")
#define PG8_WAIT_L(n) asm volatile("s_waitcnt lgkmcnt(" #n ")" ::: "memory")
#define PG8_BAR __builtin_amdgcn_s_barrier()
#define PG8_SCHED __builtin_amdgcn_sched_barrier(0)
    Unit cur, nxt; int ui = 0;
    if (!S.next(0, cur)) return;
    f32x4 acc[2][2][4][2];
#pragma unroll
    for (int a = 0; a < 2; ++a)
#pragma unroll
        for (int b = 0; b < 2; ++b)
#pragma unroll
            for (int m = 0; m < 4; ++m)
#pragma unroll
                for (int n = 0; n < 2; ++n) acc[a][b][m][n] = (f32x4){0.f, 0.f, 0.f, 0.f};
    v8i_ At[4], B0[2], B1[2]; const int one_scale = 0x7f7f7f7f; (void)one_scale;
    const char* cA = (const char*)g.A + (size_t)cur.pm * tstepA + (size_t)cur.kt0 * kstep; const char* cB = (const char*)g.Bt + (size_t)cur.pn * tstepB + (size_t)cur.kt0 * kstep;
    S.a_ready(cur);
    if constexpr (SP2) {
        PG8_STAGE(PG8_SB(0, 0), cB, voffB); PG8_STAGE(PG8_SB(0, 1), cB + hstepB, voffB); PG8_STAGE(PG8_SA(0, 0), cA, voffA); PG8_STAGE(PG8_SA(0, 1), cA + hstepA, voffA);
        if (wr == 1) PG8_BAR;
        PG8_WAIT_V(2); PG8_BAR;
        PG8_STAGE(PG8_SB(1, 0), cB + kstep, voffB); PG8_STAGE(PG8_SA(1, 0), cA + kstep, voffA); PG8_STAGE(PG8_SB(1, 1), cB + hstepB + kstep, voffB);
        PG8_WAIT_V(6); PG8_BAR;
    } else {
        PG8_STAGE(PG8_SB(0, 0), cB, voffB); PG8_STAGE(PG8_SA(0, 0), cA, voffA); PG8_STAGE(PG8_SB(0, 1), cB + hstepB, voffB); PG8_STAGE(PG8_SA(0, 1), cA + hstepA, voffA);
        if (wr == 1) PG8_BAR;
        PG8_WAIT_V(4); PG8_BAR;
        PG8_STAGE(PG8_SB(1, 0), cB + kstep, voffB); PG8_STAGE(PG8_SA(1, 0), cA + kstep, voffA); PG8_STAGE(PG8_SB(1, 1), cB + hstepB + kstep, voffB);
        PG8_WAIT_V(6); PG8_BAR;
    }
    for (;;) {
        const bool has_next = S.next(ui + 1, nxt);
        const char* nA = has_next ? (const char*)g.A + (size_t)nxt.pm * tstepA + (size_t)nxt.kt0 * kstep : cA; const char* nB = has_next ? (const char*)g.Bt + (size_t)nxt.pn * tstepB + (size_t)nxt.kt0 * kstep : cB;
        const int ntu = cur.nt ? cur.nt : nt;
        for (int t = 0; t < ntu; t += 2) {
            const bool last = (t == ntu - 2);
            const char* a1 = cA + (size_t)(t + 1) * kstep;
            const char* a2 = last ? nA : cA + (size_t)(t + 2) * kstep; const char* b2 = last ? nB : cB + (size_t)(t + 2) * kstep;
            const char* a3 = a2 + kstep; const char* b3 = b2 + kstep;
            if (last && has_next) S.a_ready(nxt);
            if constexpr (SP2) {
            PG8_LDB(B0, 0, 0); PG8_LDB(B1, 0, 1); PG8_SCHED; PG8_LDA(At, 0, 0); PG8_STAGE(PG8_SA(1, 1), a1 + hstepA, voffA);
            PG8_WAIT_V(8); PG8_WAIT_L(0); PG8_BAR; PG8_MMA(0, 0, At, B0); PG8_MMA(0, 1, At, B1); PG8_BAR; PG8_SCHED;
            PG8_LDA(At, 0, 1); PG8_STAGE(PG8_SB(0, 0), b2, voffB); PG8_STAGE(PG8_SB(0, 1), b2 + hstepB, voffB); PG8_STAGE(PG8_SA(0, 0), a2, voffA);
            PG8_WAIT_V(8); PG8_WAIT_L(0); PG8_BAR; PG8_MMA(1, 0, At, B0); PG8_MMA(1, 1, At, B1); PG8_BAR; PG8_SCHED;
            PG8_LDB(B0, 1, 0); PG8_LDB(B1, 1, 1); PG8_SCHED; PG8_LDA(At, 1, 0); PG8_STAGE(PG8_SA(0, 1), a2 + hstepA, voffA);
            PG8_WAIT_V(8); PG8_WAIT_L(0); PG8_BAR; PG8_MMA(0, 0, At, B0); PG8_MMA(0, 1, At, B1); PG8_BAR; PG8_SCHED;
            PG8_LDA(At, 1, 1); PG8_STAGE(PG8_SB(1, 0), b3, voffB); PG8_STAGE(PG8_SB(1, 1), b3 + hstepB, voffB); PG8_STAGE(PG8_SA(1, 0), a3, voffA);
            PG8_WAIT_V(8); PG8_WAIT_L(0); PG8_BAR; PG8_MMA(1, 0, At, B0); PG8_MMA(1, 1, At, B1); PG8_BAR; PG8_SCHED;
            } else {
            PG8_LDB(B0, 0, 0); PG8_SCHED; PG8_LDA(At, 0, 0); PG8_STAGE(PG8_SA(1, 1), a1 + hstepA, voffA);
            PG8_WAIT_L(8); PG8_BAR; PG8_WAIT_L(0); PG8_MMA(0, 0, At, B0); PG8_BAR; PG8_SCHED;
            PG8_LDB(B1, 0, 1); PG8_STAGE(PG8_SB(0, 0), b2, voffB);
            PG8_BAR; PG8_WAIT_L(0); PG8_MMA(0, 1, At, B1); PG8_BAR;
            PG8_LDA(At, 0, 1); PG8_STAGE(PG8_SA(0, 0), a2, voffA);
            PG8_BAR; PG8_WAIT_L(0); PG8_MMA(1, 0, At, B0); PG8_BAR; PG8_SCHED;
            PG8_STAGE(PG8_SB(0, 1), b2 + hstepB, voffB);
            PG8_WAIT_V(6); PG8_BAR; PG8_MMA(1, 1, At, B1); PG8_BAR;
            PG8_LDB(B0, 1, 0); PG8_SCHED; PG8_LDA(At, 1, 0); PG8_STAGE(PG8_SA(0, 1), a2 + hstepA, voffA);
            PG8_WAIT_L(8); PG8_BAR; PG8_WAIT_L(0); PG8_MMA(0, 0, At, B0); PG8_BAR; PG8_SCHED;
            PG8_LDB(B1, 1, 1); PG8_STAGE(PG8_SB(1, 0), b3, voffB);
            PG8_BAR; PG8_WAIT_L(0); PG8_MMA(0, 1, At, B1); PG8_BAR;
            PG8_LDA(At, 1, 1); PG8_STAGE(PG8_SA(1, 0), a3, voffA);
            PG8_BAR; PG8_WAIT_L(0); PG8_MMA(1, 0, At, B0); PG8_BAR; PG8_SCHED;
            PG8_STAGE(PG8_SB(1, 1), b3 + hstepB, voffB);
            PG8_WAIT_V(6); PG8_BAR; PG8_MMA(1, 1, At, B1); PG8_BAR;
            }
        }
        if constexpr (FP8) asm volatile("s_nop 15\n\ts_nop 15" ::: "memory");
        if constexpr (ALIGN_EPI) { if (wr == 0) PG8_BAR; }
        E(acc, cur, wr, wc, fr, fq); S.done(cur);
        if (!has_next) break;
#pragma unroll
        for (int a = 0; a < 2; ++a)
#pragma unroll
            for (int b = 0; b < 2; ++b)
#pragma unroll
                for (int m = 0; m < 4; ++m)
#pragma unroll
                    for (int n = 0; n < 2; ++n) acc[a][b][m][n] = (f32x4){0.f, 0.f, 0.f, 0.f};
        cur = nxt; cA = nA; cB = nB; ++ui;
        if constexpr (ALIGN_EPI) { if (wr == 1) PG8_BAR; }
    }
    PG8_WAIT_V(0);
    if constexpr (!ALIGN_EPI) { if (wr == 0) PG8_BAR; }
    PG8_BAR;
#undef PG8_SA
#undef PG8_SB
#undef PG8_STAGE
#undef PG8_LDA
#undef PG8_LDB
#undef PG8_MMA
#undef PG8_WAIT_V
#undef PG8_WAIT_L
#undef PG8_BAR
#undef PG8_SCHED
}

typedef f32x4 Acc[2][2][4][2];
struct EpiIn {
    static constexpr bool PERM = true;
    bf16_t* Z; bf16_t* AP; int f8; float scale;
    __device__ __forceinline__ void operator()(const Acc& acc, const Unit& u, int wr, int wc, int fr, int fq) const {
        const int pt = f8 ? win_fp8_tile(u.pn) : win_bf16_tile(u.pn), row0 = u.pm * BM + wr * 64 + fr, col0 = pt * BM + wc * 32 + 8 * fq; const bool sg = pt >= 22, s5 = pt >= 18 && pt < 22;
#pragma unroll
        for (int ai = 0; ai < 2; ++ai)
#pragma unroll
            for (int m = 0; m < 4; ++m) { const int row = row0 + ai * HALF + m * 16; bf16_t* rowp = Z + (size_t)row * NIN + col0;
#pragma unroll
                for (int bj = 0; bj < 2; ++bj) { f32x4 v0 = acc[ai][bj][m][0], v1 = acc[ai][bj][m][1];
                    if (sg) {
#pragma unroll
                        for (int j = 0; j < 4; ++j) { v0[j] = sigmoidf_(v0[j] * scale); v1[j] = sigmoidf_(v1[j] * scale); } }
                    else { v0 *= scale; v1 *= scale; }
                    u32x4 w; w.x = cvt_pk_bf16(v0[0], v0[1]); w.y = cvt_pk_bf16(v0[2], v0[3]); w.z = cvt_pk_bf16(v1[0], v1[1]); w.w = cvt_pk_bf16(v1[2], v1[3]);
                    if (s5) { const int cu = col0 + bj * HALF - C_U, g = cu >> 4, h0 = cu & 15;
                        *(u32x4*)(AP + ((size_t)(g * 768 + (row >> 4)) * 512 + (row & 15) * 16 + h0)) = w; }
                    else *(u32x4*)(rowp + bj * HALF) = w; } }
    }
};
struct EpiS {
    static constexpr bool PERM = true;
    float* S;
    __device__ __forceinline__ void operator()(const Acc& acc, const Unit& u, int wr, int wc, int fr, int fq) const {
        const int row0 = u.pm * BM + wr * 64 + fr, col0 = wc * 32 + 8 * fq;
#pragma unroll
        for (int ai = 0; ai < 2; ++ai)
#pragma unroll
            for (int m = 0; m < 4; ++m) { float* p = S + (size_t)(row0 + ai * HALF + m * 16) * 256 + col0;
#pragma unroll
                for (int bj = 0; bj < 2; ++bj) { *(f32x4*)(p + bj * HALF) = acc[ai][bj][m][0]; *(f32x4*)(p + bj * HALF + 4) = acc[ai][bj][m][1]; } }
    }
};
struct EpiY {
    static constexpr bool PERM = true;
    bf16_t* AG; int nchunk;
    __device__ __forceinline__ void operator()(const Acc& acc, const Unit& u, int wr, int wc, int fr, int fq) const {
        const int g = u.pn, c0 = (u.pm - 3 * g) * BM + wr * 64 + fr, n0 = wc * 32 + 8 * fq;
#pragma unroll
        for (int ai = 0; ai < 2; ++ai)
#pragma unroll
            for (int m = 0; m < 4; ++m) { const int c = c0 + ai * HALF + m * 16;
                if (c < nchunk) {
#pragma unroll
                    for (int bj = 0; bj < 2; ++bj) { const int n = n0 + bj * HALF, tt = n >> 4, h0 = n & 15; const f32x4 v0 = acc[ai][bj][m][0], v1 = acc[ai][bj][m][1];
                        u32x4 w; w.x = cvt_pk_bf16(gelu_tanh(v0[0]), gelu_tanh(v0[1])); w.y = cvt_pk_bf16(gelu_tanh(v0[2]), gelu_tanh(v0[3]));
                        w.z = cvt_pk_bf16(gelu_tanh(v1[0]), gelu_tanh(v1[1])); w.w = cvt_pk_bf16(gelu_tanh(v1[2]), gelu_tanh(v1[3]));
                        *(u32x4*)(AG + (size_t)(16 * c + tt) * 1024 + g * 16 + h0) = w; } } }
    }
};
struct EpiGate {
    static constexpr bool PERM = true;
    const bf16_t* Z; bf16_t* PG;
    __device__ __forceinline__ void operator()(const Acc& acc, const Unit& u, int wr, int wc, int fr, int fq) const {
        const int which = u.pm >= 33 ? 1 : 0, pm = u.pm - 33 * which, pn = u.pn - 8 * which;
        const int row0 = pm * BM + wr * 64 + fr, col0 = pn * BM + wc * 32 + 8 * fq;
        const bf16_t* gz = Z + C_G + which * DM + col0; bf16_t* out = PG + (size_t)which * NT * DM + col0;
#pragma unroll
        for (int ai = 0; ai < 2; ++ai)
#pragma unroll
            for (int m = 0; m < 4; ++m) { const size_t row = (size_t)(row0 + ai * HALF + m * 16);
#pragma unroll
                for (int bj = 0; bj < 2; ++bj) { float gt[8]; unpack8(*(const u32x4*)(gz + row * NIN + bj * HALF), gt);
                    const f32x4 v0 = acc[ai][bj][m][0], v1 = acc[ai][bj][m][1];
                    u32x4 w; w.x = cvt_pk_bf16(v0[0] * gt[0], v0[1] * gt[1]); w.y = cvt_pk_bf16(v0[2] * gt[2], v0[3] * gt[3]); w.z = cvt_pk_bf16(v1[0] * gt[4], v1[1] * gt[5]); w.w = cvt_pk_bf16(v1[2] * gt[6], v1[3] * gt[7]);
                    *(u32x4*)(out + row * DM + bj * HALF) = w; } }
    }
};
struct EpiGlu {
    static constexpr bool PERM = true;
    const bf16_t* Z; const bf16_t* PG; bf16_t* MRG;
    __device__ __forceinline__ void operator()(const Acc& acc, const Unit& u, int wr, int wc, int fr, int fq) const {
        const int row0 = u.pm * BM + wr * 64 + fr, mc0 = u.pn * HALF + wc * 32 + 8 * fq;
#pragma unroll
        for (int ai = 0; ai < 2; ++ai)
#pragma unroll
            for (int m = 0; m < 4; ++m) { const size_t row = (size_t)(row0 + ai * HALF + m * 16);
                float g2[8], pa[8], pb[8], o[8];
                unpack8(*(const u32x4*)(Z + row * NIN + C_G + 2 * DM + mc0), g2);
                unpack8(*(const u32x4*)(PG + row * DM + mc0), pa);
                unpack8(*(const u32x4*)(PG + (size_t)NT * DM + row * DM + mc0), pb);
                const f32x4 a0 = acc[ai][0][m][0], a1 = acc[ai][0][m][1], q0 = acc[ai][1][m][0], q1 = acc[ai][1][m][1];
#pragma unroll
                for (int j = 0; j < 4; ++j) { o[j] = pa[j] + pb[j] + g2[j] * a0[j] * sigmoidf_(q0[j]); o[4 + j] = pa[4 + j] + pb[4 + j] + g2[4 + j] * a1[j] * sigmoidf_(q1[j]); }
                *(u32x4*)(MRG + row * DM + mc0) = pack8(o); }
    }
};
struct EpiRes {
    static constexpr bool PERM = true;
    const float* ST; const float* lg; const float* lb; float* T; const float* gv_lat; const float* gv_ctx; float* SLAB;
    __device__ __forceinline__ void operator()(const Acc& acc, const Unit& u, int wr, int wc, int fr, int fq) const {
        const int row0 = u.pm * BM + wr * 64 + fr, col0 = u.pn * BM + wc * 32 + 8 * fq;
        if (u.nt != 0) {
            float* sl = SLAB + ((size_t)(u.kt0 / u.nt) * NCTX + (row0 - NLAT)) * DM + col0;
#pragma unroll
            for (int ai = 0; ai < 2; ++ai)
#pragma unroll
                for (int m = 0; m < 4; ++m) { const size_t off = (size_t)(ai * HALF + m * 16) * DM;
#pragma unroll
                    for (int bj = 0; bj < 2; ++bj) { *(f32x4*)(sl + off + bj * HALF) = acc[ai][bj][m][0]; *(f32x4*)(sl + off + bj * HALF + 4) = acc[ai][bj][m][1]; } }
            return;
        }
        const float* gv = (u.pm == 32 ? gv_ctx : gv_lat) + col0;
#pragma unroll
        for (int bj = 0; bj < 2; ++bj) {
            const f32x4 g0 = *(const f32x4*)(gv + bj * HALF), g1 = *(const f32x4*)(gv + bj * HALF + 4);
            const f32x4 a0 = *(const f32x4*)(lg + col0 + bj * HALF) * DN_ALPHA, a1 = *(const f32x4*)(lg + col0 + bj * HALF + 4) * DN_ALPHA;
            const f32x4 b0 = *(const f32x4*)(lb + col0 + bj * HALF) * DN_ALPHA, b1 = *(const f32x4*)(lb + col0 + bj * HALF + 4) * DN_ALPHA;
#pragma unroll
            for (int ai = 0; ai < 2; ++ai)
#pragma unroll
                for (int m = 0; m < 4; ++m) { const int row = row0 + ai * HALF + m * 16; const size_t off = (size_t)row * DM + col0 + bj * HALF;
                    const f32x2 st = *(const f32x2*)(ST + 2 * row);
                    const f32x4 x0 = *(const f32x4*)(T + off), x1 = *(const f32x4*)(T + off + 4);
                    *(f32x4*)(T + off) = ((x0 - st[0]) * st[1]) * a0 + b0 + g0 * acc[ai][bj][m][0];
                    *(f32x4*)(T + off + 4) = ((x1 - st[0]) * st[1]) * a1 + b1 + g1 * acc[ai][bj][m][1]; } }
    }
};
struct EpiSwi {
    static constexpr bool PERM = true;
    bf16_t* ACT;
    __device__ __forceinline__ void operator()(const Acc& acc, const Unit& u, int wr, int wc, int fr, int fq) const {
        const int row0 = u.pm * BM + wr * 64 + fr, c0 = u.pn * HALF + wc * 32 + 8 * fq;
#pragma unroll
        for (int ai = 0; ai < 2; ++ai)
#pragma unroll
            for (int m = 0; m < 4; ++m) { const size_t row = (size_t)(row0 + ai * HALF + m * 16);
                const f32x4 a0 = acc[ai][0][m][0], a1 = acc[ai][0][m][1], q0 = acc[ai][1][m][0], q1 = acc[ai][1][m][1]; float o[8];
#pragma unroll
                for (int j = 0; j < 4; ++j) { o[j] = siluf_(a0[j]) * q0[j]; o[4 + j] = siluf_(a1[j]) * q1[j]; }
                *(u32x4*)(ACT + row * FF + c0) = pack8(o); }
    }
};
}

namespace att {
constexpr int NW = 8, QBLK = 32, KVBLK = 64;
constexpr int LDQK = NIN;
constexpr size_t SHM_V = KVBLK * 128 * 2, SHM_K = KVBLK * 128 * 2, SHM_ATTN = 2 * SHM_V + 2 * SHM_K + NW * 64 * 4;
#define KSWZ(row, colB) ((row) * 256 + ((colB) ^ (((row) & 7) << 4)))
#define SBAR() __builtin_amdgcn_sched_barrier(0)
__device__ __forceinline__ int crow(int r, int hi) { return (r & 3) + 8 * (r >> 2) + 4 * hi; }
__device__ __forceinline__ unsigned cvtpk(float lo, float hi) { return cvt_pk_bf16(lo, hi); }

__device__ __forceinline__ float max3f(float a, float b, float c) { return __builtin_fmaxf(__builtin_fmaxf(a, b), c); }
template <bool FIRST>
__device__ __forceinline__ void partialSM(f32x16& p0, f32x16& p1, float& m_reg, f32x16& nb, float& alpha, const float thr) {
  float pmax;
  { float a0 = max3f(p0[0], p0[1], p0[2]), a1 = max3f(p0[3], p0[4], p0[5]), a2 = max3f(p0[6], p0[7], p0[8]), a3 = max3f(p0[9], p0[10], p0[11]);
    float a4 = max3f(p0[12], p0[13], p0[14]), a5 = max3f(p0[15], p1[0], p1[1]), a6 = max3f(p1[2], p1[3], p1[4]), a7 = max3f(p1[5], p1[6], p1[7]);
    float a8 = max3f(p1[8], p1[9], p1[10]), a9 = max3f(p1[11], p1[12], p1[13]);
    a0 = max3f(a0, a1, a2); a3 = max3f(a3, a4, a5); a6 = max3f(a6, a7, a8); a9 = max3f(a9, p1[14], p1[15]);
    a0 = max3f(a0, a3, a6); pmax = fmaxf(a0, a9); }
  { auto rr = __builtin_amdgcn_permlane32_swap(__float_as_uint(pmax), __float_as_uint(pmax), false, false);
    pmax = fmaxf(__uint_as_float(rr[0]), __uint_as_float(rr[1])); }
  if (!FIRST && __builtin_expect(__all(pmax <= thr), 1)) { alpha = 1.f; }
  else { const float d = FIRST ? pmax : fmaxf(pmax, 0.f); alpha = FIRST ? 1.f : __builtin_amdgcn_exp2f(-d); m_reg += d;
#pragma unroll
    for (int r = 0; r < 16; ++r) { p0[r] -= d; p1[r] -= d; nb[r] = -m_reg; }
    asm volatile("" : "+v"(nb)); }
#pragma unroll
  for (int r = 0; r < 16; ++r) p0[r] = __builtin_amdgcn_exp2f(p0[r]);
}
template <bool PACK = true>
__device__ __forceinline__ void finishSM(f32x16& p0, f32x16& p1, float alpha, float& l_reg, bf16x8& pa0, bf16x8& pa1, bf16x8& pa2, bf16x8& pa3) {
#pragma unroll
  for (int r = 0; r < 16; ++r) p1[r] = __builtin_amdgcn_exp2f(p1[r]);
  float ps = 0;
#pragma unroll
  for (int r = 0; r < 16; ++r) ps += p0[r];
#pragma unroll
  for (int r = 0; r < 16; ++r) ps += p1[r];
  { auto rr = __builtin_amdgcn_permlane32_swap(__float_as_uint(ps), __float_as_uint(ps), false, false);
    ps = __uint_as_float(rr[0]) + __uint_as_float(rr[1]); }
  l_reg = l_reg * alpha + ps;
#define PK4(P, BASE, OUT) do { u32x4 w = {cvtpk(P[BASE + 0], P[BASE + 1]), cvtpk(P[BASE + 2], P[BASE + 3]), cvtpk(P[BASE + 4], P[BASE + 5]), cvtpk(P[BASE + 6], P[BASE + 7])}; \
    OUT = *reinterpret_cast<bf16x8*>(&w); } while (0)
  if constexpr (PACK) { PK4(p0, 0, pa0); PK4(p0, 8, pa1); PK4(p1, 0, pa2); PK4(p1, 8, pa3); }
#undef PK4
}
__device__ __forceinline__ float rowmax32(const f32x16& p0, const f32x16& p1) {
  float a0 = max3f(p0[0], p0[1], p0[2]), a1 = max3f(p0[3], p0[4], p0[5]), a2 = max3f(p0[6], p0[7], p0[8]), a3 = max3f(p0[9], p0[10], p0[11]);
  float a4 = max3f(p0[12], p0[13], p0[14]), a5 = max3f(p0[15], p1[0], p1[1]), a6 = max3f(p1[2], p1[3], p1[4]), a7 = max3f(p1[5], p1[6], p1[7]);
  float a8 = max3f(p1[8], p1[9], p1[10]), a9 = max3f(p1[11], p1[12], p1[13]);
  a0 = max3f(a0, a1, a2); a3 = max3f(a3, a4, a5); a6 = max3f(a6, a7, a8); a9 = max3f(a9, p1[14], p1[15]);
  a0 = max3f(a0, a3, a6); float pmax = fmaxf(a0, a9);
  auto rr = __builtin_amdgcn_permlane32_swap(__float_as_uint(pmax), __float_as_uint(pmax), false, false);
  return fmaxf(__uint_as_float(rr[0]), __uint_as_float(rr[1]));
}
__device__ __forceinline__ void packP(const f32x16& p0, const f32x16& p1, bf16x8& pa0, bf16x8& pa1, bf16x8& pa2, bf16x8& pa3) {
#define PK4(P, BASE, OUT) do { u32x4 w = {cvtpk(P[BASE + 0], P[BASE + 1]), cvtpk(P[BASE + 2], P[BASE + 3]), cvtpk(P[BASE + 4], P[BASE + 5]), cvtpk(P[BASE + 6], P[BASE + 7])}; \
    OUT = *reinterpret_cast<bf16x8*>(&w); } while (0)
  PK4(p0, 0, pa0); PK4(p0, 8, pa1); PK4(p1, 0, pa2); PK4(p1, 8, pa3);
#undef PK4
}
constexpr float PS_BIG = 4096.f;
__device__ __forceinline__ void halfexp(f32x16& p0) {
#pragma unroll
  for (int r = 0; r < 16; ++r) p0[r] = __builtin_amdgcn_exp2f(p0[r]);
}
template <bool PACK = true>
__device__ __forceinline__ void finishFast(f32x16& p0, f32x16& p1, float& l_reg, float& psmax, bf16x8& pa0, bf16x8& pa1, bf16x8& pa2, bf16x8& pa3) {
  float dummy = 0.f; finishSM<PACK>(p0, p1, 0.f, dummy, pa0, pa1, pa2, pa3);
  l_reg += dummy; psmax = fmaxf(psmax, dummy);
}
typedef int v8i_att __attribute__((ext_vector_type(8)));
typedef int v4i_att __attribute__((ext_vector_type(4)));
__device__ __forceinline__ void packP8(const f32x16& p0, const f32x16& p1, v8i_att& p8) {
#pragma unroll
  for (int w = 0; w < 4; ++w) { p8[w] = (int)pk4_fp8(p0[4 * w], p0[4 * w + 1], p0[4 * w + 2], p0[4 * w + 3]); p8[4 + w] = (int)pk4_fp8(p1[4 * w], p1[4 * w + 1], p1[4 * w + 2], p1[4 * w + 3]); }
}
template <int D0> __device__ __forceinline__ void pv8_one(f32x16& od, const char* Vs, const v8i_att& p8, int r32, int hi) {
  const char* p = Vs + (D0 * 32 + r32) * 80 + 32 * hi;
  const v4i_att a = *reinterpret_cast<const v4i_att*>(p), b = *reinterpret_cast<const v4i_att*>(p + 16);
  od = __builtin_amdgcn_mfma_scale_f32_32x32x64_f8f6f4(p8, __builtin_shufflevector(a, b, 0, 1, 2, 3, 4, 5, 6, 7), od, 0, 0, 0, 0x7f7f7f7f, 0, 0x7f7f7f7f);
}
__device__ __forceinline__ void pv8(f32x16* o, const char* Vs, const v8i_att& p8, int r32, int hi) {
  pv8_one<0>(o[0], Vs, p8, r32, hi); pv8_one<1>(o[1], Vs, p8, r32, hi); pv8_one<2>(o[2], Vs, p8, r32, hi); pv8_one<3>(o[3], Vs, p8, r32, hi);
}
template <bool FULL>
__device__ __forceinline__ void qkt(f32x16& p0, f32x16& p1, const char* Ks, const bf16x8* qr, int r32, int hi, int kd0) {
  p0 = f32x16{}; p1 = f32x16{};
#pragma unroll
  for (int d0 = 0; d0 < (FULL ? 8 : 4); ++d0) { int cb = ((kd0 + d0) * 16 + hi * 8) * 2;
    bf16x8 b0 = *reinterpret_cast<const bf16x8*>(Ks + KSWZ(r32, cb));
    bf16x8 b1 = *reinterpret_cast<const bf16x8*>(Ks + KSWZ(32 + r32, cb));
    p0 = __builtin_amdgcn_mfma_f32_32x32x16_bf16(b0, qr[d0], p0, 0, 0, 0);
    p1 = __builtin_amdgcn_mfma_f32_32x32x16_bf16(b1, qr[d0], p1, 0, 0, 0); }
}
constexpr int QSC8 = 0x7c7c7c7c;
__device__ __forceinline__ void qkt8(f32x16& p0, f32x16& p1, const f32x16& nb, const char* Ks, const v8i_att* q8, int r32, int hi) {
#pragma unroll
  for (int s_ = 0; s_ < 2; ++s_) { const char* k0p = Ks + r32 * 144 + 64 * s_ + 32 * hi; const char* k1p = k0p + 32 * 144;
    const v4i_att a0 = *reinterpret_cast<const v4i_att*>(k0p), a1 = *reinterpret_cast<const v4i_att*>(k0p + 16), b0 = *reinterpret_cast<const v4i_att*>(k1p), b1 = *reinterpret_cast<const v4i_att*>(k1p + 16);
    p0 = __builtin_amdgcn_mfma_scale_f32_32x32x64_f8f6f4(__builtin_shufflevector(a0, a1, 0, 1, 2, 3, 4, 5, 6, 7), q8[s_], s_ == 0 ? nb : p0, 0, 0, 0, 0x7f7f7f7f, 0, QSC8);
    p1 = __builtin_amdgcn_mfma_scale_f32_32x32x64_f8f6f4(__builtin_shufflevector(b0, b1, 0, 1, 2, 3, 4, 5, 6, 7), q8[s_], s_ == 0 ? nb : p1, 0, 0, 0, 0x7f7f7f7f, 0, QSC8); }
}
__device__ __forceinline__ void qkt8d(f32x16& p0, f32x16& p1, const f32x16& nb, const char* Ks, const v8i_att& q8, int r32, int hi) {
  const char* k0p = Ks + r32 * 80 + 32 * hi; const char* k1p = k0p + 32 * 80;
  const v4i_att a0 = *reinterpret_cast<const v4i_att*>(k0p), a1 = *reinterpret_cast<const v4i_att*>(k0p + 16), b0 = *reinterpret_cast<const v4i_att*>(k1p), b1 = *reinterpret_cast<const v4i_att*>(k1p + 16);
  p0 = __builtin_amdgcn_mfma_scale_f32_32x32x64_f8f6f4(__builtin_shufflevector(a0, a1, 0, 1, 2, 3, 4, 5, 6, 7), q8, nb, 0, 0, 0, 0x7f7f7f7f, 0, QSC8);
  p1 = __builtin_amdgcn_mfma_scale_f32_32x32x64_f8f6f4(__builtin_shufflevector(b0, b1, 0, 1, 2, 3, 4, 5, 6, 7), q8, nb, 0, 0, 0, 0x7f7f7f7f, 0, QSC8);
}
__device__ __forceinline__ int v_st(int k, int c) { const int kk = k; return ((kk >> 3) * 4 + (c >> 5)) * 512 + ((kk & 7) * 32 + (c & 31)) * 2; }
__device__ __forceinline__ int v_rd_base(int lane) { return ((lane & 3) << 3) | (((lane >> 2) & 3) << 6) | (((lane >> 4) & 1) << 5) | (((lane >> 5) & 1) << 8); }
constexpr int v_rd_off(int d0, int ks, int half) { return d0 * 512 + ks * 4096 + half * 2048; }
template <int OFF> __device__ __forceinline__ s16x4 tr_read(int vb) {
  s16x4 r; asm volatile("ds_read_b64_tr_b16 %0, %1 offset:%2" : "=&v"(r) : "v"(vb), "i"(OFF) : "memory"); return r;
}
template <int D0> __device__ __forceinline__ void pv_one(f32x16& od, int vb, bf16x8 pa0, bf16x8 pa1, bf16x8 pa2, bf16x8 pa3) {
  const s16x4 l0 = tr_read<v_rd_off(D0, 0, 0)>(vb), h0 = tr_read<v_rd_off(D0, 0, 1)>(vb), l1 = tr_read<v_rd_off(D0, 1, 0)>(vb), h1 = tr_read<v_rd_off(D0, 1, 1)>(vb);
  const s16x4 l2 = tr_read<v_rd_off(D0, 2, 0)>(vb), h2 = tr_read<v_rd_off(D0, 2, 1)>(vb), l3 = tr_read<v_rd_off(D0, 3, 0)>(vb), h3 = tr_read<v_rd_off(D0, 3, 1)>(vb);
  asm volatile("s_waitcnt lgkmcnt(0)" ::: "memory"); SBAR();
#define PK(L, H) (bf16x8){L[0], L[1], L[2], L[3], H[0], H[1], H[2], H[3]}
  od = __builtin_amdgcn_mfma_f32_32x32x16_bf16(pa0, PK(l0, h0), od, 0, 0, 0);
  od = __builtin_amdgcn_mfma_f32_32x32x16_bf16(pa1, PK(l1, h1), od, 0, 0, 0);
  od = __builtin_amdgcn_mfma_f32_32x32x16_bf16(pa2, PK(l2, h2), od, 0, 0, 0);
  od = __builtin_amdgcn_mfma_f32_32x32x16_bf16(pa3, PK(l3, h3), od, 0, 0, 0);
#undef PK
}
__device__ __forceinline__ void pv_d0(f32x16* o, int vb, bf16x8 pa0, bf16x8 pa1, bf16x8 pa2, bf16x8 pa3) {
  pv_one<0>(o[0], vb, pa0, pa1, pa2, pa3); pv_one<1>(o[1], vb, pa0, pa1, pa2, pa3); pv_one<2>(o[2], vb, pa0, pa1, pa2, pa3); pv_one<3>(o[3], vb, pa0, pa1, pa2, pa3);
}


template <bool FULL, bool FAST>
__device__ __forceinline__ bool attn_dense_body(const bf16_t* __restrict__ Qb, const bf16_t* __restrict__ Kh, const bf16_t* __restrict__ Vh,
                                                bf16_t* __restrict__ Ob, const int ldo, const int seq, const int kd0, const float C, const float thr_s, char* lds) {
  const int tid = opaque_tid(), wid = tid >> 6, lane = tid & 63, r32 = lane & 31, hi = lane >> 5;
  char* V_lds = lds; char* K_lds = lds + 2 * SHM_V;
  float* ws = (float*)(lds + 2 * SHM_V + 2 * SHM_K) + wid * 64; float* li_l = ws; float* al_l = ws + 32;
  float m_reg = 0.f, l_reg = 0, psmax = 0.f; f32x16 o[4] = {}; f32x16 nb = {}; v8i_att q8[2]; (void)psmax; (void)l_reg;
  f32x16 lacc = {};
  if constexpr (FULL) {
    const char* Q8w = (const char*)Qb + (long)(wid * QBLK + r32) * 1024 + 32 * hi;
#pragma unroll
    for (int s_ = 0; s_ < 2; ++s_) { const v4i_att x0 = *reinterpret_cast<const v4i_att*>(Q8w + 64 * s_), x1 = *reinterpret_cast<const v4i_att*>(Q8w + 64 * s_ + 16); q8[s_] = __builtin_shufflevector(x0, x1, 0, 1, 2, 3, 4, 5, 6, 7); }
  } else {
    const char* Q8w = (const char*)Qb + (long)(wid * QBLK + r32) * 2048 + 32 * hi;
    const v4i_att x0 = *reinterpret_cast<const v4i_att*>(Q8w), x1 = *reinterpret_cast<const v4i_att*>(Q8w + 16); q8[0] = __builtin_shufflevector(x0, x1, 0, 1, 2, 3, 4, 5, 6, 7);
  }
  const int sr = tid >> 4, sc = (tid & 15) * 8, vst0 = v_st(sr, sc), vst1 = v_st(32 + sr, sc);
  const int vb0 = (int)(uintptr_t)V_lds + v_rd_base(lane);
  constexpr int SDEPTH = 1;
  struct { bf16x8 vs0, vs1, ks0; } sr_[SDEPTH]; u32x2 kd8 = {0u, 0u}; v8i_att p8 = {}; (void)p8;
  const unsigned goff0 = (unsigned)(sr * LDQK + sc) * 2u, goff1 = goff0 + 32u * LDQK * 2u;
  const unsigned goffk = (unsigned)((tid >> 3) * LDQK + (tid & 7) * 8) * 2u;
#define SLOAD(i, k0) do { sr_[i].vs0 = *reinterpret_cast<const bf16x8*>((const char*)Vh + (size_t)((k0) >> 6) * 8192 + tid * 16); \
    if constexpr (FULL) sr_[i].ks0 = *reinterpret_cast<const bf16x8*>((const char*)Kh + (size_t)((k0) + (tid >> 3)) * 256 + (tid & 7) * 16); \
    else kd8 = *reinterpret_cast<const u32x2*>((const char*)Kh + (size_t)((k0) + (tid >> 3)) * 2048 + (tid & 7) * 8); } while (0)
#define SWRITE(b, i) do { *(bf16x8*)(V_lds + (b) * SHM_V + (tid >> 2) * 80 + (tid & 3) * 16) = sr_[i].vs0; \
    if constexpr (FULL) *(bf16x8*)(K_lds + (b) * SHM_K + (tid >> 3) * 144 + (tid & 7) * 16) = sr_[i].ks0; \
    else *(u32x2*)(K_lds + (b) * SHM_K + (tid >> 3) * 80 + (tid & 7) * 8) = kd8; } while (0)
#define PV(b) do { pv8(o, V_lds + (b) * SHM_V, p8, r32, hi); } while (0)
#define QKT(P0, P1, KS) do { if constexpr (FULL) qkt8(P0, P1, nb, KS, q8, r32, hi); else qkt8d(P0, P1, nb, KS, q8[0], r32, hi); } while (0)
#define SWAIT() do { if constexpr (SDEPTH == 2) asm volatile("s_waitcnt vmcnt(4)" ::: "memory"); else asm volatile("s_waitcnt vmcnt(0)" ::: "memory"); } while (0)
#define RESC(a) do { if constexpr (!FAST) if (__any((a) < 1.f)) { if (hi == 0) al_l[r32] = (a); asm volatile("s_waitcnt lgkmcnt(0)" ::: "memory"); \
    _Pragma("unroll") for (int d = 0; d < 4; ++d) _Pragma("unroll") for (int r = 0; r < 16; ++r) o[d][r] *= al_l[crow(r, hi)]; } } while (0)
#define PSM(P0, P1, AL) do { if constexpr (FAST) halfexp(P0); else partialSM<false>(P0, P1, m_reg, nb, AL, thr_s); } while (0)
#define FSM(P0, P1, AL) do { if constexpr (FAST) finishFast<false>(P0, P1, l_reg, psmax, pa0, pa1, pa2, pa3); else finishSM<false>(P0, P1, AL, l_reg, pa0, pa1, pa2, pa3); \
    packP8(P0, P1, p8); } while (0)
  f32x16 pA0, pA1, pB0, pB1; float alA = 1.f, alB = 1.f; bf16x8 pa0, pa1, pa2, pa3; const int NT_ = seq / KVBLK; (void)C;
  constexpr int SE = 0, SO = SDEPTH - 1;
  if constexpr (FAST) {
    constexpr bool LM = true;
    v8i_att ones8 = {0x38383838, 0x38383838, 0x38383838, 0x38383838, 0x38383838, 0x38383838, 0x38383838, 0x38383838}; if constexpr (LM) asm volatile("" : "+v"(ones8));
    float psA = 0.f, psB = 0.f; (void)psA; (void)psB;
#define SOFTQ(N0, N1, PSN, q) do { _Pragma("unroll") for (int r = 0; r < 8; ++r) { if constexpr ((q) < 2) { N0[8 * (q) + r] = __builtin_amdgcn_exp2f(N0[8 * (q) + r]); if constexpr (!LM) PSN += N0[8 * (q) + r]; } \
      else { N1[8 * ((q) - 2) + r] = __builtin_amdgcn_exp2f(N1[8 * ((q) - 2) + r]); if constexpr (!LM) PSN += N1[8 * ((q) - 2) + r]; } } } while (0)
#define PVQ(b, D) do { pv8_one<D>(o[D], V_lds + (b) * SHM_V, p8, r32, hi); } while (0)
#define LSUM() do { if constexpr (LM) lacc = __builtin_amdgcn_mfma_scale_f32_32x32x64_f8f6f4(p8, ones8, lacc, 0, 0, 0, 0x7f7f7f7f, 0, 0x7f7f7f7f); } while (0)
#define PVS(b, N0, N1, PSN) do { if constexpr (!LM) PSN = 0.f; LSUM(); SOFTQ(N0, N1, PSN, 0); PVQ(b, 0); SOFTQ(N0, N1, PSN, 1); PVQ(b, 1); SOFTQ(N0, N1, PSN, 2); PVQ(b, 2); SOFTQ(N0, N1, PSN, 3); PVQ(b, 3); } while (0)
#define FIN(P0, P1, PS) do { if constexpr (!LM) { { auto rr_ = __builtin_amdgcn_permlane32_swap(__float_as_uint(PS), __float_as_uint(PS), false, false); PS = __uint_as_float(rr_[0]) + __uint_as_float(rr_[1]); } \
      l_reg += PS; psmax = fmaxf(psmax, PS); } packP8(P0, P1, p8); } while (0)
    constexpr int FS_K = 8192, FS_STAGE = 16384;
    const int wv_ = __builtin_amdgcn_readfirstlane(wid);
    const unsigned gV = (unsigned)((tid >> 2) * 64 + (((tid & 3) ^ ((tid >> 4) & 3)) * 16));
    const unsigned gK = FULL ? (unsigned)((tid >> 3) * 256 + (((tid & 7) ^ ((tid >> 4) & 7)) * 16))
                             : (unsigned)((tid >> 2) * 2048 + (((tid & 3) ^ ((tid >> 4) & 3)) * 16));
    const int swv = (r32 >> 2) & 3, vA = r32 * 64 + ((2 * hi) ^ swv) * 16, vB = r32 * 64 + ((2 * hi + 1) ^ swv) * 16;
    const int swk = FULL ? (r32 >> 1) & 7 : (r32 >> 2) & 3;
    const int kA0 = FULL ? r32 * 128 + ((2 * hi) ^ swk) * 16 : r32 * 64 + ((2 * hi) ^ swk) * 16, kB0 = FULL ? r32 * 128 + ((2 * hi + 1) ^ swk) * 16 : r32 * 64 + ((2 * hi + 1) ^ swk) * 16;
    const int kA1 = r32 * 128 + ((4 + 2 * hi) ^ swk) * 16, kB1 = r32 * 128 + ((5 + 2 * hi) ^ swk) * 16;
#define DMA(st, k0) do { __builtin_amdgcn_global_load_lds((const unsigned*)((const char*)Vh + (size_t)((k0) >> 6) * 8192 + gV), (LAS unsigned*)((LAS char*)(uintptr_t)(unsigned)(uintptr_t)lds + (st) + wv_ * 1024), 16, 0, 0); \
      if constexpr (FULL) __builtin_amdgcn_global_load_lds((const unsigned*)((const char*)Kh + (size_t)(k0) * 256 + gK), (LAS unsigned*)((LAS char*)(uintptr_t)(unsigned)(uintptr_t)lds + (st) + FS_K + wv_ * 1024), 16, 0, 0); \
      else if (wv_ < 4) __builtin_amdgcn_global_load_lds((const unsigned*)((const char*)Kh + (size_t)(k0) * 2048 + gK), (LAS unsigned*)((LAS char*)(uintptr_t)(unsigned)(uintptr_t)lds + (st) + FS_K + wv_ * 1024), 16, 0, 0); } while (0)
#define LDV4(off) (*reinterpret_cast<const v4i_att*>(lds + (off)))
#define QKTS(P0, P1, st) do { const int kb_ = (st) + FS_K; \
      if constexpr (FULL) { { const v4i_att a0 = LDV4(kb_ + kA0), a1 = LDV4(kb_ + kB0), b0 = LDV4(kb_ + 4096 + kA0), b1 = LDV4(kb_ + 4096 + kB0); \
        P0 = __builtin_amdgcn_mfma_scale_f32_32x32x64_f8f6f4(__builtin_shufflevector(a0, a1, 0, 1, 2, 3, 4, 5, 6, 7), q8[0], nb, 0, 0, 0, 0x7f7f7f7f, 0, QSC8); \
        P1 = __builtin_amdgcn_mfma_scale_f32_32x32x64_f8f6f4(__builtin_shufflevector(b0, b1, 0, 1, 2, 3, 4, 5, 6, 7), q8[0], nb, 0, 0, 0, 0x7f7f7f7f, 0, QSC8); } SBAR(); \
        { const v4i_att c0 = LDV4(kb_ + kA1), c1 = LDV4(kb_ + kB1), d0 = LDV4(kb_ + 4096 + kA1), d1 = LDV4(kb_ + 4096 + kB1); \
        P0 = __builtin_amdgcn_mfma_scale_f32_32x32x64_f8f6f4(__builtin_shufflevector(c0, c1, 0, 1, 2, 3, 4, 5, 6, 7), q8[1], P0, 0, 0, 0, 0x7f7f7f7f, 0, QSC8); \
        P1 = __builtin_amdgcn_mfma_scale_f32_32x32x64_f8f6f4(__builtin_shufflevector(d0, d1, 0, 1, 2, 3, 4, 5, 6, 7), q8[1], P1, 0, 0, 0, 0x7f7f7f7f, 0, QSC8); } } \
      else { const v4i_att a0 = LDV4(kb_ + kA0), a1 = LDV4(kb_ + kB0), b0 = LDV4(kb_ + 2048 + kA0), b1 = LDV4(kb_ + 2048 + kB0); \
        P0 = __builtin_amdgcn_mfma_scale_f32_32x32x64_f8f6f4(__builtin_shufflevector(a0, a1, 0, 1, 2, 3, 4, 5, 6, 7), q8[0], nb, 0, 0, 0, 0x7f7f7f7f, 0, QSC8); \
        P1 = __builtin_amdgcn_mfma_scale_f32_32x32x64_f8f6f4(__builtin_shufflevector(b0, b1, 0, 1, 2, 3, 4, 5, 6, 7), q8[0], nb, 0, 0, 0, 0x7f7f7f7f, 0, QSC8); } } while (0)
#undef PVQ
#define PVQ(st, D) do { const v4i_att a_ = LDV4((st) + (D) * 2048 + vA), b_ = LDV4((st) + (D) * 2048 + vB); \
      o[D] = __builtin_amdgcn_mfma_scale_f32_32x32x64_f8f6f4(p8, __builtin_shufflevector(a_, b_, 0, 1, 2, 3, 4, 5, 6, 7), o[D], 0, 0, 0, 0x7f7f7f7f, 0, 0x7f7f7f7f); } while (0)
#define STEP_END() do { asm volatile("s_waitcnt vmcnt(0)" ::: "memory"); __syncthreads(); { const int t_ = oC; oC = oN; oN = oW; oW = t_; } } while (0)
    int oC = 0, oN = FS_STAGE, oW = 2 * FS_STAGE;
    DMA(0, 0); DMA(FS_STAGE, KVBLK); asm volatile("s_waitcnt vmcnt(0)" ::: "memory"); __syncthreads();
    QKTS(pA0, pA1, oC);
    { const float d = rowmax32(pA0, pA1); m_reg = d;
#pragma unroll
      for (int r = 0; r < 16; ++r) { pA0[r] = __builtin_amdgcn_exp2f(pA0[r] - d); pA1[r] = __builtin_amdgcn_exp2f(pA1[r] - d); nb[r] = -d; }
      asm volatile("" : "+v"(nb));
    }
    for (int j = 0; j + 2 < NT_; j += 2) {
      DMA(oW, (j + 2) * KVBLK); SBAR(); QKTS(pB0, pB1, oN);
      FIN(pA0, pA1, psA); SBAR();
      PVS(oC, pB0, pB1, psB);
      STEP_END();
      DMA(oW, (j + 3) * KVBLK); SBAR(); QKTS(pA0, pA1, oN);
      FIN(pB0, pB1, psB); SBAR();
      PVS(oC, pA0, pA1, psA);
      STEP_END();
    }
    SBAR(); QKTS(pB0, pB1, oN);
    FIN(pA0, pA1, psA); SBAR();
    PVS(oC, pB0, pB1, psB);
    FIN(pB0, pB1, psB); SBAR();
    LSUM(); PVQ(oN, 0); PVQ(oN, 1); PVQ(oN, 2); PVQ(oN, 3);
#undef DMA
#undef LDV4
#undef QKTS
#undef STEP_END
#undef LSUM
#undef SOFTQ
#undef PVQ
#undef PVS
#undef FIN
  } else {
  SLOAD(SE, 0); asm volatile("s_waitcnt vmcnt(0)" ::: "memory"); SWRITE(0, SE); __syncthreads();
  QKT(pA0, pA1, K_lds); partialSM<true>(pA0, pA1, m_reg, nb, alA, thr_s);
  SLOAD(SO, KVBLK); if constexpr (SDEPTH == 2) { if (2 < NT_) SLOAD(SE, 2 * KVBLK); }
  SWAIT(); SWRITE(1, SO); __syncthreads();
  for (int j = 1; j + 1 < NT_; j += 2) {
    SBAR(); QKT(pB0, pB1, K_lds + SHM_K);
    FSM(pA0, pA1, alA); SBAR();
    SLOAD(SO, (j + SDEPTH) * KVBLK); SBAR();
    PV(0); PSM(pB0, pB1, alB);
    __syncthreads(); SWAIT(); SWRITE(0, SE);
    RESC(alB); __syncthreads();
    SBAR(); QKT(pA0, pA1, K_lds);
    FSM(pB0, pB1, alB); SBAR();
    if (SDEPTH == 1 || j + 3 < NT_) SLOAD(SE, (j + 1 + SDEPTH) * KVBLK); SBAR();
    PV(1); PSM(pA0, pA1, alA);
    __syncthreads(); SWAIT(); SWRITE(1, SO);
    RESC(alA); __syncthreads();
  }
  SBAR(); QKT(pB0, pB1, K_lds + SHM_K);
  FSM(pA0, pA1, alA); SBAR();
  PV(0); PSM(pB0, pB1, alB);
  __syncthreads(); RESC(alB);
  FSM(pB0, pB1, alB); SBAR();
  PV(1);
  }
  if constexpr (FAST) {
    float lt_ = 0.f;
    {
#pragma unroll
      for (int r = 0; r < 16; ++r) lt_ += lacc[r]; }
    int* badf = (int*)(lds + SHM_ATTN); const bool wbad = !__all(lt_ <= 3.0e38f);
    if (lane == 0) badf[wid] = wbad ? 1 : 0;
    __syncthreads();
    int anyb = 0;
#pragma unroll
    for (int w = 0; w < NW; ++w) anyb |= badf[w];
    if (__builtin_amdgcn_readfirstlane(anyb)) return true;
  }
  float rli[16];
  if constexpr (FAST) {
#pragma unroll
    for (int r = 0; r < 16; ++r) rli[r] = __builtin_amdgcn_rcpf(lacc[r]);
  } else {
    if (hi == 0) li_l[r32] = l_reg; asm volatile("s_waitcnt lgkmcnt(0)" ::: "memory");
#pragma unroll
    for (int r = 0; r < 16; ++r) rli[r] = __builtin_amdgcn_rcpf(li_l[crow(r, hi)]);
  }
  bf16_t* Ow = Ob + (long)(wid * QBLK) * ldo;
#pragma unroll
  for (int r = 0; r < 16; ++r) { int orow = crow(r, hi);
#pragma unroll
    for (int d0 = 0; d0 < 4; ++d0) Ow[(long)orow * ldo + d0 * 32 + r32] = (bf16_t)f2bf(o[d0][r] * rli[r]); }
#undef SLOAD
#undef SWRITE
#undef SWAIT
#undef QKT
#undef RESC
#undef PSM
#undef FSM
#undef PV
  return false;
}
}

#define XB_TMO      128
#define XB_XCNT(j)  (256  + 64 * (j))
#define XB_XSUB(j)  (1280 + 64 * (j))
#define XB_XGEN(j)  (2304 + 64 * (j))
#define XB_TOP      3328
#define XB_TOPGEN   3392
#define XCD_BAR_WORDS 3456
#define XB_SPIN_CAP (1u << 21)
__device__ __forceinline__ unsigned xb_ld(unsigned* p)              { return __hip_atomic_load(p, __ATOMIC_RELAXED, __HIP_MEMORY_SCOPE_AGENT); }
__device__ __forceinline__ unsigned xb_add(unsigned* p, unsigned v) { return __hip_atomic_fetch_add(p, v, __ATOMIC_RELAXED, __HIP_MEMORY_SCOPE_AGENT); }
__device__ __forceinline__ unsigned xb_xcc_id() { return (unsigned)__builtin_amdgcn_s_getreg((3 << 11) | 20) & 0xFu; }
#define XB_SPIN(cond, bar) do { unsigned _sp = 0; while (cond) { __builtin_amdgcn_s_sleep(1); \
    if ((++_sp & 255u) == 0u) { if (xb_ld(&(bar)[XB_TMO])) break; if (_sp > XB_SPIN_CAP) { atomicAdd(&(bar)[XB_TMO], 1u); break; } } } } while (0)
struct XcdBarrier { unsigned* bar; unsigned x; volatile LAS unsigned* st; };
__device__ __forceinline__ XcdBarrier xcd_barrier_post(unsigned* bar, volatile LAS unsigned* st) {
    XcdBarrier b; b.bar = bar; b.x = (unsigned)__builtin_amdgcn_readfirstlane((int)xb_xcc_id()); b.st = st;
    if (threadIdx.x == 0) (void)xb_add(&bar[XB_XCNT(b.x)], 1u);
    return b;
}
__device__ __forceinline__ void xcd_barrier_complete(unsigned* bar, unsigned x, unsigned& nloc, unsigned& nx) {
    const unsigned G = gridDim.x * gridDim.y * gridDim.z;
    unsigned sum, cnt, mine, sp = 0u;
    for (;;) {
        sum = 0u; cnt = 0u; mine = 0u;
#pragma unroll
        for (unsigned j = 0; j < 16; ++j) { const unsigned c = xb_ld(&bar[XB_XCNT(j)]); sum += c; cnt += (c > 0u) ? 1u : 0u; mine = (j == x) ? c : mine; }
        if (sum == G) break;
        __builtin_amdgcn_s_sleep(1);
        if ((++sp & 255u) == 0u) { if (xb_ld(&bar[XB_TMO])) break; if (sp > XB_SPIN_CAP) { atomicAdd(&bar[XB_TMO], 1u); break; } }
    }
    nloc = mine > 0u ? mine : 1u; nx = cnt > 0u ? cnt : 1u;
}
__device__ __forceinline__ void xcd_barrier(const XcdBarrier& b) {
    asm volatile("s_waitcnt vmcnt(0)" ::: "memory");
    __syncthreads();
    if (threadIdx.x == 0) {
        unsigned* bar = b.bar;
        __builtin_amdgcn_s_waitcnt(0);
        unsigned nloc = b.st[0], nx = b.st[1];
        if (nloc == 0u) { xcd_barrier_complete(bar, b.x, nloc, nx); b.st[0] = nloc; b.st[1] = nx; }
        const unsigned old = xb_add(&bar[XB_XSUB(b.x)], 1u);
        const unsigned gen = old / nloc;
        if (old + 1u == (gen + 1u) * nloc) {
            __builtin_amdgcn_fence(__ATOMIC_RELEASE, "agent");
            asm volatile("s_waitcnt vmcnt(0)" ::: "memory");
            const unsigned og = xb_add(&bar[XB_TOP], 1u);
            const unsigned tg = og / nx;
            if (og + 1u == (tg + 1u) * nx) xb_add(&bar[XB_TOPGEN], 1u);
            else XB_SPIN(xb_ld(&bar[XB_TOPGEN]) == tg, bar);
            __builtin_amdgcn_fence(__ATOMIC_ACQUIRE, "agent");
            xb_add(&bar[XB_XGEN(b.x)], 1u);
            asm volatile("s_waitcnt vmcnt(0)" ::: "memory");
        } else {
            XB_SPIN(xb_ld(&bar[XB_XGEN(b.x)]) == gen, bar);
            __builtin_amdgcn_fence(__ATOMIC_ACQUIRE, "agent");
            asm volatile("s_waitcnt vmcnt(0)" ::: "memory");
        }
    }
    __syncthreads();
}

constexpr int RING_BYTES = 131072, MISC_OFF = RING_BYTES + 320, LDS_BYTES = 147456;

struct Args { const float* in[33]; float* out; unsigned char* ws; };
enum { I_X = 0, I_C, I_CTX, I_CCTX, I_WADA, I_BADA, I_WIN, I_LQ1, I_LK1, I_LQ2, I_LK2, I_SUBLN, I_WPA, I_QNORM, I_KNORM, I_WPB, I_ARE, I_AIM, I_LOGDT, I_BRE, I_BIM, I_CRE, I_CIM,
       I_S5D, I_WGLU, I_WO, I_LNMG, I_LNMB, I_WG, I_WU, I_WD, I_LNFG, I_LNFB };

typedef const float* cfp_t;
struct InTab {
    __device__ __forceinline__ cfp_t operator[](int i) const {
        const __attribute__((address_space(4))) unsigned char* k = (const __attribute__((address_space(4))) unsigned char*)__builtin_amdgcn_kernarg_segment_ptr();
        asm volatile("" : "+s"(k));
        return (cfp_t)(const GAS float*)(*(const __attribute__((address_space(4))) cfp_t*)(k + 8 * i));
    }
};
struct Frame {
    LAS unsigned char* lds; int tid, lane, wave, vcu, G, gw, NGW;
    InTab in; GAS float* out; GAS unsigned char* ws;
};

__device__ __forceinline__ void transpose_item(const float* W, int K, int N, bf16_t* WT, int k0, int n0, int out_row0, LAS float* scr, int lane, bool fp8 = false) {
    const float* src = W + (size_t)k0 * N + n0 + lane;
#pragma unroll
    for (int h = 0; h < 2; ++h) { float v[32];
#pragma unroll
        for (int i = 0; i < 32; ++i) v[i] = src[(size_t)(32 * h + i) * N];
#pragma unroll
        for (int i = 0; i < 32; ++i) scr[(32 * h + i) * 64 + (lane ^ (8 * ((32 * h + i) >> 3)))] = v[i]; }
    LDS_WAIT(); asm volatile("" ::: "memory");
    const int c = lane & 7;
#pragma unroll
    for (int j = 0; j < 8; ++j) { const int n = (lane >> 3) + 8 * j; const LAS float* s = scr + (8 * c) * 64 + (n ^ (8 * c));
        if (fp8) { u32x2 o8; o8.x = pk4_fp8(64.f * s[0 * 64], 64.f * s[1 * 64], 64.f * s[2 * 64], 64.f * s[3 * 64]); o8.y = pk4_fp8(64.f * s[4 * 64], 64.f * s[5 * 64], 64.f * s[6 * 64], 64.f * s[7 * 64]);
            *(u32x2*)((unsigned char*)WT + (size_t)(out_row0 + n) * K + k0 + 8 * c) = o8; }
        else { u32x4 o; o.x = pk2(s[0 * 64], s[1 * 64]); o.y = pk2(s[2 * 64], s[3 * 64]); o.z = pk2(s[4 * 64], s[5 * 64]); o.w = pk2(s[6 * 64], s[7 * 64]);
        *(u32x4*)(WT + (size_t)(out_row0 + n) * K + k0 + 8 * c) = o; } }
    LDS_WAIT(); asm volatile("" ::: "memory");
}
constexpr int IT_IN = (DM / 64) * (NIN / 64), IT_PA = (1024 / 64) * (DM / 64), IT_PB = IT_PA, IT_GLU = (1024 / 64) * (4096 / 64), IT_O = (DM / 64) * (DM / 64),
              IT_G = (DM / 64) * (FF / 64), IT_U = IT_G, IT_D = (FF / 64) * (DM / 64);
constexpr int IT_LAYER = IT_IN + IT_PA + IT_PB + IT_GLU + IT_O + IT_G + IT_U + IT_D;

__device__ __forceinline__ void convert_item(Frame& F, int it, LAS float* scr) {
    const int l = it / IT_LAYER; int r = it % IT_LAYER;
    GAS unsigned char* wl = F.ws + WS_W + (size_t)l * W_LAYER;
    const float* W; int K, N; bf16_t* WT; int mode;
    int rowoff = 0;
    if (r < IT_IN) { W = F.in[I_WIN] + (size_t)l * DM * NIN; K = DM; N = NIN; WT = (bf16_t*)(wl + W_IN); mode = 0; }
    else if ((r -= IT_IN) < IT_PA) { W = F.in[I_WPA] + (size_t)l * 1024 * DM; K = 1024; N = DM; WT = (bf16_t*)(wl + W_PAB); mode = 0; }
    else if ((r -= IT_PA) < IT_PB) { W = F.in[I_WPB] + (size_t)l * 1024 * DM; K = 1024; N = DM; WT = (bf16_t*)(wl + W_PAB); mode = 0; rowoff = 2048; }
    else if ((r -= IT_PB) < IT_GLU) { W = F.in[I_WGLU] + (size_t)l * 1024 * 4096; K = 1024; N = 4096; WT = (bf16_t*)(wl + W_GLU); mode = 1; }
    else if ((r -= IT_GLU) < IT_O) { W = F.in[I_WO] + (size_t)l * DM * DM; K = DM; N = DM; WT = (bf16_t*)(wl + W_O); mode = 0; }
    else if ((r -= IT_O) < IT_G) { W = F.in[I_WG] + (size_t)l * DM * FF; K = DM; N = FF; WT = (bf16_t*)(wl + W_GU); mode = 2; }
    else if ((r -= IT_G) < IT_U) { W = F.in[I_WU] + (size_t)l * DM * FF; K = DM; N = FF; WT = (bf16_t*)(wl + W_GU); mode = 3; }
    else { r -= IT_U; W = F.in[I_WD] + (size_t)l * FF * DM; K = FF; N = DM; WT = (bf16_t*)(wl + W_DN); mode = 0; }
    const int nblk = N / 64, kb = r / nblk, nb = r % nblk, k0 = 64 * kb, n0 = 64 * nb;
    int orow; bool fp8 = false;
    if (mode == 0 && N == NIN) { const int pt = n0 >> 8; orow = win_tile_slot(pt) * 256 + (n0 & 255);
        if (win_tile_fp8(pt)) { fp8 = true; WT = (bf16_t*)(wl + W_IN8); } }
    else if (mode == 0) orow = rowoff + n0;
    else if (mode == 1) orow = 256 * ((n0 % 2048) / 128) + 128 * (n0 / 2048) + (n0 % 128);
    else orow = 256 * (n0 / 128) + (mode == 3 ? 128 : 0) + (n0 % 128);
    transpose_item(W, K, N, WT, k0, n0, orow, scr, F.lane, fp8);
}

__device__ __forceinline__ void mod_item(Frame& F, int it) {
    const int cb = it % 48, slab = (it / 48) % MOD_SLABS, l = it / (48 * MOD_SLABS);
    const int col = cb * 256 + 4 * F.lane, k0 = slab * 64;
    const float* W = F.in[I_WADA] + ((size_t)l * DM + k0) * 12288 + col;
    const float* c = F.in[I_C] + k0; const float* cc = F.in[I_CCTX] + k0;
    f32x4 a0 = {0.f, 0.f, 0.f, 0.f}, a1 = a0;
#pragma unroll 8
    for (int k = 0; k < 64; ++k) { const f32x4 w = *(const f32x4*)(W + (size_t)k * 12288); const float s0 = siluf_(c[k]), s1 = siluf_(cc[k]); a0 += w * s0; a1 += w * s1; }
    float* P = (float*)(F.ws + WS_MODP) + (((size_t)slab * NL + l) * 2) * 12288 + col;
    *(f32x4*)P = a0; *(f32x4*)(P + 12288) = a1;
}

__device__ __forceinline__ void s5_param_item(Frame& F, int it) {
    const int p = it & 63, g = (it >> 6) & 63, dir = (it >> 12) & 1, l = it >> 13;
    const int gi = (l * 2 + dir) * 64 + g;
    double are = (double)F.in[I_ARE][gi * 64 + p]; if (are > -1e-4) are = (double)(-1e-4f);
    const double aim = (double)F.in[I_AIM][gi * 64 + p];
    const double dt = dexp((double)F.in[I_LOGDT][gi]);
    double s, c; dsincos(aim * dt, s, c);
    const double mag = dexp(are * dt), lr = mag * c, li = mag * s;
    const double den = are * are + aim * aim, nr = lr - 1.0;
    const double cr = (nr * are + li * aim) / den, ci = (li * are - nr * aim) / den;
    const float* bre = F.in[I_BRE] + ((size_t)gi * 64 + p) * 16; const float* bim = F.in[I_BIM] + ((size_t)gi * 64 + p) * 16;
    f32x2* BBF = (f32x2*)(F.ws + WS_BBF) + ((size_t)gi * 64 + p) * 16;
#pragma unroll
    for (int h = 0; h < 16; ++h) { const double br = bre[h], bi = bim[h];
        BBF[h] = (f32x2){(float)(cr * br - ci * bi), (float)(cr * bi + ci * br)}; }
    { f32x2* POW = (f32x2*)(F.ws + WS_POW) + (size_t)gi * 17 * 64 + p; double pr = 1.0, pi = 0.0;
      for (int k = 0; k <= 16; ++k) { POW[k * 64] = (f32x2){(float)pr, (float)pi}; const double nr = pr * lr - pi * li, ni = pr * li + pi * lr; pr = nr; pi = ni; } }
}

__device__ __forceinline__ void modulate_row(int lane, const float* xrow, float* xres, bf16_t* hrow, unsigned char* h8row, const float* sh, const float* sc) {
#pragma unroll
    for (int j = 0; j < 8; ++j) { const int c = 4 * lane + 256 * j; const f32x4 v = *(const f32x4*)(xrow + c), a = *(const f32x4*)(sc + c), b = *(const f32x4*)(sh + c);
        if (xres) *(f32x4*)(xres + c) = v;
        const f32x4 y = v * (a + 1.f) + b; u32x2 w; w.x = cvt_pk_bf16(y[0], y[1]); w.y = cvt_pk_bf16(y[2], y[3]); *(u32x2*)(hrow + c) = w;
        *(unsigned*)(h8row + c) = pk4_fp8(y[0], y[1], y[2], y[3]); }
}
__device__ __forceinline__ void ln_finish(int lane, f32x4 (&v)[8], float* xrow, bf16_t* hrow, const float* g, const float* b, const float* sh, const float* sc, unsigned char* h8row = nullptr, float* stats = nullptr) {
    float s = 0.f;
#pragma unroll
    for (int j = 0; j < 8; ++j) s += (v[j][0] + v[j][1]) + (v[j][2] + v[j][3]);
    const float mean = wave_sum(s) * (1.f / DM); float s2 = 0.f;
#pragma unroll
    for (int j = 0; j < 8; ++j) { v[j] = v[j] - mean; s2 += (v[j][0] * v[j][0] + v[j][1] * v[j][1]) + (v[j][2] * v[j][2] + v[j][3] * v[j][3]); }
    const float rstd = 1.f / sqrtf(wave_sum(s2) * (1.f / DM) + 1e-6f);
    if (stats && lane == 0) { f32x2 st = {mean, rstd}; *(f32x2*)stats = st; }
#pragma unroll
    for (int j = 0; j < 8; ++j) { const int c = 4 * lane + 256 * j; const f32x4 y = v[j] * rstd * *(const f32x4*)(g + c) + *(const f32x4*)(b + c);
        if (xrow) *(f32x4*)(xrow + c) = y;
        if (hrow) { const f32x4 z = y * (*(const f32x4*)(sc + c) + 1.f) + *(const f32x4*)(sh + c); u32x2 w; w.x = cvt_pk_bf16(z[0], z[1]); w.y = cvt_pk_bf16(z[2], z[3]); *(u32x2*)(hrow + c) = w;
            if (h8row) *(unsigned*)(h8row + c) = pk4_fp8(z[0], z[1], z[2], z[3]); } }
}
__device__ __forceinline__ void ln_row(int lane, const float* trow, float* xrow, bf16_t* hrow, const float* g, const float* b, const float* sh, const float* sc, unsigned char* h8row = nullptr, float* stats = nullptr) {
    f32x4 v[8];
#pragma unroll
    for (int j = 0; j < 8; ++j) v[j] = *(const f32x4*)(trow + 4 * lane + 256 * j);
    ln_finish(lane, v, xrow, hrow, g, b, sh, sc, h8row, stats);
}
__device__ __forceinline__ void ln_ctx_row(Frame& F, int r, const float* slab, int nslab, const float* gvec, const float* g, const float* b, const float* sh, const float* sc, bool h8) {
    const int lane = F.lane; LAS float* xb = (LAS float*)F.lds;
    f32x4 a[8];
#pragma unroll
    for (int j = 0; j < 8; ++j) a[j] = (f32x4){0.f, 0.f, 0.f, 0.f};
    for (int q = F.wave; q < nslab; q += NWAVES) { const float* sp = slab + ((size_t)q * NCTX + r) * DM + 4 * lane;
#pragma unroll
        for (int j = 0; j < 8; ++j) a[j] += *(const f32x4*)(sp + 256 * j); }
#pragma unroll
    for (int j = 0; j < 8; ++j) *(LAS f32x4*)(xb + F.wave * DM + 4 * lane + 256 * j) = a[j];
    __syncthreads();
    if (F.wave == 0) {
        float* xrow = (float*)(F.ws + WS_XRES) + (size_t)(NLAT + r) * DM; f32x4 v[8];
#pragma unroll
        for (int j = 0; j < 8; ++j) { const int c = 4 * lane + 256 * j; f32x4 t = *(const LAS f32x4*)(xb + c);
#pragma unroll
            for (int w = 1; w < NWAVES; ++w) t += *(const LAS f32x4*)(xb + w * DM + c);
            v[j] = *(const f32x4*)(xrow + c) * DN_ALPHA + *(const f32x4*)(gvec + c) * t; }
        ln_finish(lane, v, xrow, (bf16_t*)(F.ws + WS_H) + (size_t)(NLAT + r) * DM, g, b, sh, sc, h8 ? (unsigned char*)(F.ws + WS_H8) + (size_t)(NLAT + r) * DM : (unsigned char*)nullptr);
    }
    __syncthreads();
}

__device__ __forceinline__ void prep_row(Frame& F, int l, int t) {
    bf16_t* z = (bf16_t*)(F.ws + WS_Z) + (size_t)t * NIN;
    const bool lat = t < NLAT; const int prow = t >> 6, pcol = t & 63, lane = F.lane;
    const f32x2* RD = (const f32x2*)(F.ws + WS_ROPE_DA); const f32x2* RG = (const f32x2*)(F.ws + WS_ROPE_GQ);
    {
#pragma unroll
        for (int rep = 0; rep < 2; ++rep) { const int task = lane + 64 * rep, b = task >> 1, a = task & 1;
            const bf16_t* p = z + b * 32 + 8 * a; const int pos = (b & 1) ? pcol : prow;
            float x1[8], x2[8]; unpack8(*(const u32x4*)p, x1); unpack8(*(const u32x4*)(p + 16), x2);
            float o1[8], o2[8];
            if (lat) { const f32x2* cs = RD + pos * 16 + 8 * a;
#pragma unroll
                for (int j = 0; j < 8; ++j) { const f32x2 q = cs[j]; o1[j] = x1[j] * q[0] - x2[j] * q[1]; o2[j] = x2[j] * q[0] + x1[j] * q[1]; } }
            else {
#pragma unroll
                for (int j = 0; j < 8; ++j) { o1[j] = x1[j]; o2[j] = x2[j]; } }
            if (b < 32) {
#pragma unroll
                for (int j = 0; j < 8; ++j) { o1[j] *= 0.125f * 1.4426950408889634f * 8.f; o2[j] *= 0.125f * 1.4426950408889634f * 8.f; } }
            unsigned char* d8 = (unsigned char*)(F.ws + WS_QKA8) + (size_t)t * 2048 + b * 32 + 8 * a;
            u32x2 w1, w2; w1.x = pk4_fp8(o1[0], o1[1], o1[2], o1[3]); w1.y = pk4_fp8(o1[4], o1[5], o1[6], o1[7]); w2.x = pk4_fp8(o2[0], o2[1], o2[2], o2[3]); w2.y = pk4_fp8(o2[4], o2[5], o2[6], o2[7]);
            *(u32x2*)d8 = w1; *(u32x2*)(d8 + 16) = w2; }
    }
#pragma unroll
    for (int pass = 0; pass < 2; ++pass) {
        const int seg = lane >> 3, sub = lane & 7, axis = sub >> 2, a = sub & 3;
        const bool active = pass == 0 || seg < 2;
        bf16_t* p = z + (pass == 0 ? C_QB : C_KB) + (active ? seg : 0) * 128 + axis * 64 + 8 * a;
        const float* nw = F.in[pass == 0 ? I_QNORM : I_KNORM] + l * 128 + axis * 64 + 8 * a;
        float x1[8], x2[8]; unpack8(*(const u32x4*)p, x1); unpack8(*(const u32x4*)(p + 32), x2);
        float ss = 0.f;
#pragma unroll
        for (int j = 0; j < 8; ++j) ss += x1[j] * x1[j] + x2[j] * x2[j];
        ss += __shfl_xor(ss, 1); ss += __shfl_xor(ss, 2); ss += __shfl_xor(ss, 4);
        const float r = 1.f / sqrtf(ss * (1.f / 128.f) + 1e-6f);
        float o1[8], o2[8];
#pragma unroll
        for (int j = 0; j < 8; ++j) { x1[j] = x1[j] * r * nw[j]; x2[j] = x2[j] * r * nw[32 + j]; }
        if (lat) { const int pos = axis ? pcol : prow; const f32x2* cs = RG + pos * 32 + 8 * a;
#pragma unroll
            for (int j = 0; j < 8; ++j) { const f32x2 q = cs[j]; o1[j] = x1[j] * q[0] - x2[j] * q[1]; o2[j] = x2[j] * q[0] + x1[j] * q[1]; } }
        else {
#pragma unroll
            for (int j = 0; j < 8; ++j) { o1[j] = x1[j]; o2[j] = x2[j]; } }
        if (pass == 0) {
#pragma unroll
            for (int j = 0; j < 8; ++j) { o1[j] *= 0.088388347648318440f * 1.4426950408889634f * 8.f; o2[j] *= 0.088388347648318440f * 1.4426950408889634f * 8.f; } }
        if (active) { unsigned char* d8 = (pass == 0 ? (unsigned char*)(F.ws + WS_QB8) + (size_t)t * 1024 : (unsigned char*)(F.ws + WS_KB8) + (size_t)t * 256) + seg * 128 + axis * 64 + 8 * a;
            u32x2 w1, w2; w1.x = pk4_fp8(o1[0], o1[1], o1[2], o1[3]); w1.y = pk4_fp8(o1[4], o1[5], o1[6], o1[7]); w2.x = pk4_fp8(o2[0], o2[1], o2[2], o2[3]); w2.y = pk4_fp8(o2[4], o2[5], o2[6], o2[7]);
            *(u32x2*)d8 = w1; *(u32x2*)(d8 + 32) = w2; }
    }
}

__device__ __forceinline__ void vt8_task(Frame& F, int task, LAS unsigned char* scr) {
    const int dvq = task & 3, tile = (task >> 2) % 132, hh = task / (4 * 132), lane = F.lane; const bool da = hh >= 2; const int kvh = da ? hh - 2 : hh;
    const bf16_t* p = (const bf16_t*)(F.ws + WS_Z) + (size_t)(tile * 64 + lane) * NIN + (da ? C_VA : C_VB) + kvh * 128 + dvq * 32;
    const int kk = lane & 31, slot = ((kk >> 2) & 1) * 32 + (lane >> 5) * 16 + (kk & 3) + 4 * (kk >> 3);
#pragma unroll
    for (int q = 0; q < 4; ++q) { float x[8]; unpack8(*(const u32x4*)(p + 8 * q), x);
        const unsigned w0 = pk4_fp8(x[0], x[1], x[2], x[3]), w1 = pk4_fp8(x[4], x[5], x[6], x[7]);
#pragma unroll
        for (int j = 0; j < 4; ++j) { scr[(8 * q + j) * 80 + slot] = (unsigned char)(w0 >> (8 * j)); scr[(8 * q + 4 + j) * 80 + slot] = (unsigned char)(w1 >> (8 * j)); } }
    LDS_WAIT(); asm volatile("" ::: "memory");
    unsigned char* dst = (unsigned char*)(F.ws + (da ? WS_VA8T : WS_VB8T)) + ((size_t)(kvh * 132 + tile) * 128 + dvq * 32) * 64;
#pragma unroll
    for (int rep = 0; rep < 2; ++rep) { const int piece = lane + 64 * rep, row = piece >> 2, part = piece & 3;
        *(u32x4*)(dst + row * 64 + part * 16) = *(const LAS u32x4*)(scr + row * 80 + part * 16); }
    LDS_WAIT(); asm volatile("" ::: "memory");
}

__device__ __forceinline__ void da_combine_row(Frame& F, int l, int t, float lam, float one_m_li) {
    const int lane = F.lane, h = lane >> 3, d0 = (lane & 7) * 16;
    const bf16_t* o1p = (const bf16_t*)(F.ws + WS_ODA) + (size_t)t * DM + (2 * h) * 128 + d0; const bf16_t* o2p = o1p + 128;
    const float* w = F.in[I_SUBLN] + l * 128 + d0;
    float a[16], b[16]; unpack8(*(const u32x4*)o1p, *(float(*)[8])a); unpack8(*(const u32x4*)(o1p + 8), *(float(*)[8])(a + 8));
    unpack8(*(const u32x4*)o2p, *(float(*)[8])b); unpack8(*(const u32x4*)(o2p + 8), *(float(*)[8])(b + 8));
    float ss = 0.f;
#pragma unroll
    for (int j = 0; j < 16; ++j) { a[j] = a[j] - lam * b[j]; ss += a[j] * a[j]; }
    ss += __shfl_xor(ss, 1); ss += __shfl_xor(ss, 2); ss += __shfl_xor(ss, 4);
    const float r = one_m_li / sqrtf(ss * (1.f / 128.f) + 1e-5f);
#pragma unroll
    for (int j = 0; j < 16; ++j) a[j] = a[j] * r * w[j];
    bf16_t* out = (bf16_t*)(F.ws + WS_APB) + (size_t)t * 1024 + h * 128 + d0;
    *(u32x4*)out = pack8(*(float(*)[8])a); *(u32x4*)(out + 8) = pack8(*(float(*)[8])(a + 8));
}


__device__ __forceinline__ void s5_ktab_item(Frame& F, int idx) {
    const int hp = idx & 15, h = (idx >> 4) & 15, dir = (idx >> 8) & 1, g = (idx >> 9) & 63, l = idx >> 15;
    const int gi = (l * 2 + dir) * 64 + g;
    const float* cre = F.in[I_CRE] + ((size_t)gi * 16 + h) * 64; const float* cim = F.in[I_CIM] + ((size_t)gi * 16 + h) * 64;
    const f32x2* L1 = (const f32x2*)(F.ws + WS_POW) + ((size_t)gi * 17 + 1) * 64; const f32x2* BBF = (const f32x2*)(F.ws + WS_BBF) + (size_t)gi * 64 * 16 + hp;
    float acc[16];
#pragma unroll
    for (int k = 0; k < 16; ++k) acc[k] = 0.f;
#pragma unroll 4
    for (int p = 0; p < 64; ++p) { const float cr = cre[p], ci = cim[p]; const f32x2 L = L1[p], B = BBF[p * 16];
        float wr = cr * B[0] - ci * B[1], wi = cr * B[1] + ci * B[0];
#pragma unroll
        for (int k = 0; k < 16; ++k) { acc[k] += wr; const float nr = wr * L[0] - wi * L[1], ni = wr * L[1] + wi * L[0]; wr = nr; wi = ni; } }
    float* KT = (float*)(F.ws + WS_KTAB) + (size_t)((l * 64 + g) * 2 + dir) * 16 * 256 + h * 16 + hp;
#pragma unroll
    for (int k = 0; k < 16; ++k) KT[k * 256] = acc[k];
}
template <int NB>
__device__ __forceinline__ void s5_etab_items(Frame& F, int idx0, int stride, int nitems) {
    f32x2 L[NB], B[NB][8]; int im_[NB]; size_t dst[NB]; bool ok[NB];
#pragma unroll
    for (int b = 0; b < NB; ++b) { const int idx = idx0 + b * stride; ok[b] = idx < nitems; const int id = ok[b] ? idx : 0;
        const int k0 = (id & 31) * 8, n = (id >> 5) & 255, g = (id >> 13) & 63, l = id >> 19;
        const int dir = n >> 7, p = n & 63, tt = k0 >> 4, h0 = k0 & 15, e = dir == 0 ? 15 - tt : tt, gi = (l * 2 + dir) * 64 + g; im_[b] = (n >> 6) & 1;
        L[b] = ((const f32x2*)(F.ws + WS_POW))[((size_t)gi * 17 + e) * 64 + p]; const f32x2* BBF = (const f32x2*)(F.ws + WS_BBF) + ((size_t)gi * 64 + p) * 16 + h0;
#pragma unroll
        for (int j = 0; j < 8; ++j) B[b][j] = BBF[j];
        dst[b] = ((size_t)(l * 64 + g) * 256 + n) * 256 + k0; }
#pragma unroll
    for (int b = 0; b < NB; ++b) { float o[8];
#pragma unroll
        for (int j = 0; j < 8; ++j) o[j] = im_[b] ? L[b][0] * B[b][j][1] + L[b][1] * B[b][j][0] : L[b][0] * B[b][j][0] - L[b][1] * B[b][j][1];
        if (ok[b]) *(u32x4*)((bf16_t*)(F.ws + WS_ETAB) + dst[b]) = pack8(o); }
}
template <int NB>
__device__ __forceinline__ void s5_gtab_items(Frame& F, int idx0, int stride, int nitems) {
    f32x2 L[NB][8]; float cr[NB][8], ci[NB][8]; int im_[NB]; size_t dst[NB]; bool ok[NB];
#pragma unroll
    for (int b = 0; b < NB; ++b) { const int idx = idx0 + b * stride; ok[b] = idx < nitems; const int id = ok[b] ? idx : 0;
        const int k8 = id & 31, n = (id >> 5) & 255, g = (id >> 13) & 63, l = id >> 19;
        const int dir = k8 >> 4, comp0 = (k8 & 15) * 8, p0 = comp0 & 63, tt = n >> 4, h = n & 15, e = dir == 0 ? tt + 1 : 16 - tt, gi = (l * 2 + dir) * 64 + g; im_[b] = comp0 >> 6;
        const f32x2* POW = (const f32x2*)(F.ws + WS_POW) + ((size_t)gi * 17 + e) * 64 + p0;
        const float* cre = F.in[I_CRE] + ((size_t)gi * 16 + h) * 64 + p0; const float* cim = F.in[I_CIM] + ((size_t)gi * 16 + h) * 64 + p0;
#pragma unroll
        for (int j = 0; j < 8; ++j) { L[b][j] = POW[j]; cr[b][j] = cre[j]; ci[b][j] = cim[j]; }
        dst[b] = ((size_t)(l * 64 + g) * 256 + n) * 512 + 256 + 8 * k8; }
#pragma unroll
    for (int b = 0; b < NB; ++b) { float o[8];
#pragma unroll
        for (int j = 0; j < 8; ++j) o[j] = im_[b] ? -(cr[b][j] * L[b][j][1] + ci[b][j] * L[b][j][0]) : cr[b][j] * L[b][j][0] - ci[b][j] * L[b][j][1];
        if (ok[b]) *(u32x4*)((bf16_t*)(F.ws + WS_BTAB) + dst[b]) = pack8(o); }
}
template <int NB>
__device__ __forceinline__ void s5_ttab_items(Frame& F, int idx0, int stride, int nitems) {
    float o[NB][8]; size_t dst[NB]; bool ok[NB];
#pragma unroll
    for (int b = 0; b < NB; ++b) { const int idx = idx0 + b * stride; ok[b] = idx < nitems; const int id = ok[b] ? idx : 0;
        const int k0 = (id & 31) * 8, n = (id >> 5) & 255, g = (id >> 13) & 63, l = id >> 19;
        const int tp = k0 >> 4, hp0 = k0 & 15, tt = n >> 4, h = n & 15;
        const float* KT = (const float*)(F.ws + WS_KTAB) + (size_t)(l * 64 + g) * 2 * 16 * 256;
        const bool f = tp <= tt, r = tp >= tt;
        const float* kf = KT + (size_t)(f ? tt - tp : 0) * 256 + h * 16 + hp0; const float* kr = KT + (size_t)(16 + (r ? tp - tt : 0)) * 256 + h * 16 + hp0;
        const float dsk = F.in[I_S5D][l * 1024 + g * 16 + h];
#pragma unroll
        for (int j = 0; j < 8; ++j) o[b][j] = (f ? kf[j] : 0.f) + (r ? kr[j] : 0.f);
        if (tp == tt && (h >> 3) == (hp0 >> 3)) o[b][h & 7] += dsk;
        dst[b] = ((size_t)(l * 64 + g) * 256 + n) * 512 + k0; }
#pragma unroll
    for (int b = 0; b < NB; ++b) if (ok[b]) *(u32x4*)((bf16_t*)(F.ws + WS_BTAB) + dst[b]) = pack8(o[b]);
}
template <int PASS>
__device__ __forceinline__ void s5_scan_task(Frame& F, int l, int task) {
    const int run = task % 33, gd = task / 33, dir = gd & 1, g = gd >> 1, p = F.lane, gi = (l * 2 + dir) * 64 + g;
    const f32x2 L16 = ((const f32x2*)(F.ws + WS_POW))[((size_t)gi * 17 + 16) * 64 + p];
    const float* S = (const float*)(F.ws + WS_S) + (size_t)g * 768 * 256 + dir * 128 + p;
    f32x2* GF = (f32x2*)(F.ws + WS_F) + ((size_t)gd * 33) * 64 + p;
    float sr[16], si[16];
#pragma unroll
    for (int q = 0; q < 16; ++q) { const int s_ = run * 16 + q, c = dir == 0 ? (s_ < 16 ? 512 + s_ : s_ - 16) : 527 - s_; sr[q] = S[(size_t)c * 256]; si[q] = S[(size_t)c * 256 + 64]; }
    float xr = 0.f, xi = 0.f;
    if (PASS == 2) {
        float ar = L16[0], ai = L16[1];
#pragma unroll
        for (int q = 0; q < 4; ++q) { const float nr = ar * ar - ai * ai, ni = 2.f * ar * ai; ar = nr; ai = ni; }
        for (int r = 0; r < run; ++r) { const f32x2 f = GF[(size_t)r * 64]; const float nr = ar * xr - ai * xi + f[0], ni = ar * xi + ai * xr + f[1]; xr = nr; xi = ni; }
    }
    bf16_t* X = (bf16_t*)(F.ws + WS_AP) + (size_t)g * 768 * 512 + 256 + dir * 128 + p;
#pragma unroll
    for (int q = 0; q < 16; ++q) { const int s_ = run * 16 + q, c = dir == 0 ? (s_ < 16 ? 512 + s_ : s_ - 16) : 527 - s_;
        if (PASS == 2) { X[(size_t)c * 512] = (bf16_t)f2bf(xr); X[(size_t)c * 512 + 64] = (bf16_t)f2bf(xi); }
        const float nr = L16[0] * xr - L16[1] * xi + sr[q], ni = L16[0] * xi + L16[1] * xr + si[q]; xr = nr; xi = ni; }
    if (PASS == 1) GF[(size_t)run * 64] = (f32x2){xr, xi};
}

__global__ void __launch_bounds__(NTHR, 2) hyb_fwd(Args args) {
    extern __shared__ __attribute__((aligned(16))) unsigned char lds_raw[];
    Frame F;
    F.lds = (LAS unsigned char*)lds_raw;
    F.tid = threadIdx.x; F.lane = F.tid & 63; F.wave = __builtin_amdgcn_readfirstlane(F.tid >> 6);
    F.G = gridDim.x; { const int bx = blockIdx.x; F.vcu = (F.G % 8 == 0) ? (bx % 8) * (F.G / 8) + bx / 8 : bx; }
    F.gw = F.vcu * NWAVES + F.wave; F.NGW = F.G * NWAVES;
    F.out = (GAS float*)args.out; F.ws = (GAS unsigned char*)args.ws;
    volatile LAS unsigned* MISC = (volatile LAS unsigned*)(F.lds + MISC_OFF);
    for (int u = F.tid; u < (LDS_BYTES - RING_BYTES) / 4; u += NTHR) ((LAS unsigned*)(F.lds + RING_BYTES))[u] = 0u;
    __syncthreads();
    unsigned* ctl = (unsigned*)(F.ws + WS_CTL);
    XcdBarrier bar = xcd_barrier_post(ctl + CW_BAR, MISC + 8);
#define GRID_BAR() do { asm volatile("" : "+s"(bar.bar), "+s"(bar.x)); xcd_barrier(bar); F.tid = opaque_tid(); F.lane = F.tid & 63; asm volatile("" : "+s"(F.ws)); } while (0)
    LAS float* wscr = (LAS float*)(F.lds + F.wave * 16384);

    {
        for (int it = F.gw; it < NL * MOD_SLABS * 48; it += F.NGW) mod_item(F, it);
        for (int it = F.gw * 64 + F.lane; it < NL * 2 * 64 * 64; it += F.NGW * 64) s5_param_item(F, it);
        for (int it = F.gw * 64 + F.lane; it < 128 * 16 + 128 * 32; it += F.NGW * 64) {
            const bool da = it < 128 * 16; const int r = da ? it : it - 128 * 16, nf = da ? 16 : 32, pos = r / nf, i = r % nf;
            const float invf = (float)dexp(-(double)(2 * i) / (double)(2 * nf) * 9.210340371976184);
            const float ang = (float)pos * invf; double s, c; dsincos((double)ang, s, c);
            ((f32x2*)(F.ws + (da ? WS_ROPE_DA : WS_ROPE_GQ)))[r] = (f32x2){(float)c, (float)s};
        }
        if (F.gw < NL) { const int l = F.gw;
            const float a = wave_sum(F.in[I_LQ1][l * 64 + F.lane] * F.in[I_LK1][l * 64 + F.lane]), b = wave_sum(F.in[I_LQ2][l * 64 + F.lane] * F.in[I_LK2][l * 64 + F.lane]);
            const float lam_init = 0.8f - 0.6f * (float)dexp(-0.3 * (double)l);
            if (F.lane == 0) ((float*)(F.ws + WS_LAMV))[l] = (float)(dexp((double)a) - dexp((double)b)) + lam_init; }
    }
    GRID_BAR();
    for (int it = F.gw * 64 + F.lane; it < NL * 2 * 12288; it += F.NGW * 64) { const int j = it % 12288, ls = it / 12288, l = ls >> 1;
        float s = F.in[I_BADA][l * 12288 + j]; const float* P = (const float*)(F.ws + WS_MODP) + (size_t)ls * 12288 + j;
        for (int sl = 0; sl < MOD_SLABS; ++sl) s += P[(size_t)sl * NL * 2 * 12288];
        ((float*)(F.ws + WS_MOD))[it] = s; }
#pragma nounroll
    for (int pass_ = 0; pass_ < 2; ++pass_) {
        if ((pass_ == 0) == ((F.wave & 1) != 0)) {
            for (int it = F.gw * 64 + F.lane; it < NL * 64 * 2 * 256; it += F.NGW * 64) s5_ktab_item(F, it);
            for (int it = F.gw * 64 + F.lane; it < NL * 64 * 256 * 32; it += 4 * F.NGW * 64) { s5_etab_items<4>(F, it, F.NGW * 64, NL * 64 * 256 * 32); s5_gtab_items<4>(F, it, F.NGW * 64, NL * 64 * 256 * 32); }
        } else {
            for (int it = F.gw; it < NL * IT_LAYER; it += F.NGW) convert_item(F, it, wscr);
        }
    }
    GRID_BAR();
    for (int c = F.gw * 64 + F.lane; c < 2 * DM; c += F.NGW * 64) ((float*)(F.ws + WS_IDAFF))[c] = c < DM ? 1.f : 0.f;
#pragma nounroll
    for (int pass_ = 0; pass_ < 2; ++pass_) {
        if ((pass_ == 0) == ((F.wave & 1) != 0)) {
            for (int it = F.gw * 64 + F.lane; it < NL * 64 * 256 * 32; it += 4 * F.NGW * 64) s5_ttab_items<4>(F, it, F.NGW * 64, NL * 64 * 256 * 32);
        } else {
        for (int t = F.gw; t < NT; t += F.NGW) { const bool lat = t < NLAT; const float* md = (const float*)(F.ws + WS_MOD) + (lat ? 0 : 12288);
            const float* xr = lat ? F.in[I_X] + (size_t)t * DM : F.in[I_CTX] + (size_t)(t - NLAT) * DM;
            modulate_row(F.lane, xr, (lat ? (float*)(F.ws + WS_T) : (float*)(F.ws + WS_XRES)) + (size_t)t * DM, (bf16_t*)(F.ws + WS_H) + (size_t)t * DM, (unsigned char*)(F.ws + WS_H8) + (size_t)t * DM, md, md + DM);
            if (lat && F.lane == 0) { f32x2 st = {0.f, 1.f}; *(f32x2*)((float*)(F.ws + WS_STATS) + 2 * t) = st; } }
        }
    }
    GRID_BAR();

    for (int l = 0; l < NL; ++l) {
        GAS unsigned char* wl = F.ws + WS_W + (size_t)l * W_LAYER;
        const bool last = (l == NL - 1);
        const int Mrows = last ? NLAT : NT;
        const float* modl = (const float*)(F.ws + WS_MOD) + (size_t)l * 2 * 12288;
        { int k8_ = DM / 2; asm volatile("" : "+s"(k8_));
          pg8::Gemm g{(const bf16_t*)(F.ws + WS_H8), (const bf16_t*)(wl + W_IN8), NT, 9728, k8_, DM / 2, DM / 2}; pg8::WinOrder S; S.init(NT, 9728, F.G, (int)blockIdx.x);
          pg8::EpiIn E{(bf16_t*)(F.ws + WS_Z), (bf16_t*)(F.ws + WS_AP), 1, 1.f / 64.f};
          pg8::gemm_phase<pg8::EpiIn, pg8::WinOrder, true, true, true>(F.lds, g, S, E); }
        { pg8::Gemm g{(const bf16_t*)(F.ws + WS_H), (const bf16_t*)(wl + W_IN), NT, 2048, DM}; pg8::StaticOrder S; S.init(NT, 2048, F.G, ((int)blockIdx.x + 16) % F.G);
          pg8::EpiIn E{(bf16_t*)(F.ws + WS_Z), (bf16_t*)(F.ws + WS_AP), 0, 1.f};
          pg8::gemm_phase<pg8::EpiIn, pg8::StaticOrder, true, true, false>(F.lds, g, S, E); }
        GRID_BAR();
        for (int t = F.gw; t < NT; t += F.NGW) prep_row(F, l, t);
        for (int t = F.gw; t < 10 * 132 * 4; t += F.NGW) vt8_task(F, t, F.lds + F.wave * 16384);
        { __syncthreads(); int ks_ = 256; asm volatile("" : "+s"(ks_));
          pg8::Gemm g{(const bf16_t*)(F.ws + WS_AP), (const bf16_t*)(F.ws + WS_ETAB) + (size_t)l * 64 * 256 * 256, 64 * 768, 64 * 256, ks_, 512, 256}; pg8::S5Order S; S.init(3, F.G, (int)blockIdx.x);
          pg8::EpiS E{(float*)(F.ws + WS_S)};
          pg8::gemm_phase<pg8::EpiS, pg8::S5Order, true, true>(F.lds, g, S, E); }
        GRID_BAR();
        for (int t = F.gw; t < 128 * 33; t += F.NGW) s5_scan_task<1>(F, l, t);
        {
            const bf16_t* Z = (const bf16_t*)(F.ws + WS_Z);
#define GQ_UNIT(FAST_) att::attn_dense_body<true, FAST_>((const bf16_t*)((const unsigned char*)(F.ws + WS_QB8) + qrow * 1024 + h * 128), (const bf16_t*)((const unsigned char*)(F.ws + WS_KB8) + krow * 256 + (h >> 2) * 128), \
                (const bf16_t*)((const unsigned char*)(F.ws + WS_VB8T) + ((size_t)(h >> 2) * 132 + (krow >> 6)) * 8192), (bf16_t*)(F.ws + WS_APB) + ((size_t)NT + qrow) * 1024 + h * 128, 1024, seq, 0, 1.f, 8.f, (char*)lds_raw)
#define DA_UNIT(FAST_) att::attn_dense_body<false, FAST_>((const bf16_t*)((const unsigned char*)(F.ws + WS_QKA8) + qrow * 2048 + hs * 64), (const bf16_t*)((const unsigned char*)(F.ws + WS_QKA8) + krow * 2048 + 1024 + hs * 64), \
                (const bf16_t*)((const unsigned char*)(F.ws + WS_VA8T) + ((size_t)(hs >> 1) * 132 + (krow >> 6)) * 8192), (bf16_t*)(F.ws + WS_ODA) + qrow * DM + hs * 128, DM, seq, 0, 1.f, 8.f, (char*)lds_raw)
            unsigned redo = 0u, bit = 1u;
            for (int u = (int)blockIdx.x; u < 256 + (last ? 0 : 24); u += F.G, bit <<= 1) { if (u >= 256 && u < 272) continue;
                const bool cx = u >= 256; const int h = cx ? u - 272 : u >> 5, seq = cx ? NCTX : NT; const size_t qrow = cx ? (size_t)NLAT : (size_t)(u & 31) * 256, krow = cx ? (size_t)NLAT : 0;
                if (GQ_UNIT(true)) redo |= bit;
                __syncthreads();
            }
            bit = 1u << 8;
            for (int u = (int)blockIdx.x; u < 512 + (last ? 0 : 16); u += F.G, bit <<= 1) {
                const bool cx = u >= 512; const int hs = cx ? u - 512 : u >> 5, seq = cx ? NCTX : NT; const size_t qrow = cx ? (size_t)NLAT : (size_t)(u & 31) * 256, krow = cx ? (size_t)NLAT : 0;
                if (DA_UNIT(true)) redo |= bit;
                __syncthreads();
            }
            if (redo & 0xffu) { bit = 1u;
                for (int u = (int)blockIdx.x; u < 256 + (last ? 0 : 24); u += F.G, bit <<= 1) { if (!(redo & bit)) continue;
                    const bool cx = u >= 256; const int h = cx ? u - 272 : u >> 5, seq = cx ? NCTX : NT; const size_t qrow = cx ? (size_t)NLAT : (size_t)(u & 31) * 256, krow = cx ? (size_t)NLAT : 0;
                    GQ_UNIT(false); __syncthreads(); } }
            if (redo >> 8) { bit = 1u << 8;
                for (int u = (int)blockIdx.x; u < 512 + (last ? 0 : 16); u += F.G, bit <<= 1) { if (!(redo & bit)) continue;
                    const bool cx = u >= 512; const int hs = cx ? u - 512 : u >> 5, seq = cx ? NCTX : NT; const size_t qrow = cx ? (size_t)NLAT : (size_t)(u & 31) * 256, krow = cx ? (size_t)NLAT : 0;
                    DA_UNIT(false); __syncthreads(); } }
#undef GQ_UNIT
#undef DA_UNIT
        }
        GRID_BAR();
        { const float lam = ((const float*)(F.ws + WS_LAMV))[l]; const float lam_init = 0.8f - 0.6f * __expf(-0.3f * (float)l);
          for (int t = F.gw; t < 128 * 33; t += F.NGW) s5_scan_task<2>(F, l, t);
          for (int t = F.gw; t < Mrows; t += F.NGW) da_combine_row(F, l, t, lam, 1.f - lam_init); }
        GRID_BAR();
        { const bool dflow = !last && F.G == 256; unsigned* c1_ = ctl + CW_FLOW + 128 * l; unsigned* c2_ = c1_ + 64;
          { int ky_ = 512; asm volatile("" : "+s"(ky_));
            pg8::Gemm g{(const bf16_t*)(F.ws + WS_AP), (const bf16_t*)(F.ws + WS_BTAB) + (size_t)l * 64 * 256 * 512, 64 * 768, 64 * 256, ky_, 512, 512}; pg8::S5Order S;
            S.init(last ? 2 : 3, F.G, dflow ? (int)blockIdx.x - 16 : (int)blockIdx.x, dflow ? c2_ : (unsigned*)nullptr);
            pg8::EpiY E{(bf16_t*)(F.ws + WS_AGLU), last ? 512 : 528};
            pg8::gemm_phase<pg8::EpiY, pg8::S5Order, true, true>(F.lds, g, S, E); }
          { pg8::Gemm g{(const bf16_t*)(F.ws + WS_APB), (const bf16_t*)(wl + W_PAB), 2 * NT, 4096, 1024}; pg8::PairOrder S; S.init(Mrows / 256, F.G, (int)blockIdx.x, dflow ? c1_ : (unsigned*)nullptr);
            pg8::EpiGate E{(const bf16_t*)(F.ws + WS_Z), (bf16_t*)(F.ws + WS_PG)};
            pg8::gemm_phase<pg8::EpiGate, pg8::PairOrder, true, true>(F.lds, g, S, E); }
          if (dflow) { pg8::Gemm g{(const bf16_t*)(F.ws + WS_AGLU), (const bf16_t*)(wl + W_GLU), NT, 4096, 1024}; pg8::CtxGluOrder S; S.init((int)blockIdx.x - 208, c1_, c2_);
            pg8::EpiGlu E{(const bf16_t*)(F.ws + WS_Z), (const bf16_t*)(F.ws + WS_PG), (bf16_t*)(F.ws + WS_MRG)};
            pg8::gemm_phase<pg8::EpiGlu, pg8::CtxGluOrder, true, true>(F.lds, g, S, E); }
        }
        GRID_BAR();
        { const int Mg = (!last && F.G == 256) ? NLAT : Mrows;
          pg8::Gemm g{(const bf16_t*)(F.ws + WS_AGLU), (const bf16_t*)(wl + W_GLU), Mg, 4096, 1024}; pg8::StaticOrder S; S.init(Mg, 4096, F.G, (int)blockIdx.x);
          pg8::EpiGlu E{(const bf16_t*)(F.ws + WS_Z), (const bf16_t*)(F.ws + WS_PG), (bf16_t*)(F.ws + WS_MRG)};
          pg8::gemm_phase<pg8::EpiGlu, pg8::StaticOrder, true, true>(F.lds, g, S, E); }
        GRID_BAR();
        { pg8::Gemm g{(const bf16_t*)(F.ws + WS_MRG), (const bf16_t*)(wl + W_O), Mrows, DM, DM}; pg8::ResSplitOrder S; S.init(DM, F.G, (int)blockIdx.x, !last, SPLIT_O, (DM / 64) / SPLIT_O);
          const float* pg_ = l == 0 ? (const float*)(F.ws + WS_IDAFF) : F.in[I_LNFG] + (l - 1) * DM; const float* pb_ = l == 0 ? (const float*)(F.ws + WS_IDAFF) + DM : F.in[I_LNFB] + (l - 1) * DM;
          pg8::EpiRes E{(const float*)(F.ws + WS_STATS), pg_, pb_, (float*)(F.ws + WS_T), modl + 2 * DM, modl + 12288 + 2 * DM, (float*)(F.ws + WS_SLAB)};
          pg8::gemm_phase<pg8::EpiRes, pg8::ResSplitOrder, true, true>(F.lds, g, S, E); }
        GRID_BAR();
        {
        for (int t = F.gw; t < NLAT; t += F.NGW)
            ln_row(F.lane, (const float*)(F.ws + WS_T) + (size_t)t * DM, (float*)nullptr, (bf16_t*)(F.ws + WS_H) + (size_t)t * DM,
                   F.in[I_LNMG] + l * DM, F.in[I_LNMB] + l * DM, modl + 3 * DM, modl + 4 * DM, (unsigned char*)nullptr, (float*)(F.ws + WS_STATS) + 2 * t);
        if (!last) for (int r = (int)blockIdx.x; r < NCTX; r += F.G) { const float* md = modl + 12288;
            ln_ctx_row(F, r, (const float*)(F.ws + WS_SLAB), SPLIT_O, md + 2 * DM, F.in[I_LNMG] + l * DM, F.in[I_LNMB] + l * DM, md + 3 * DM, md + 4 * DM, false); }
        }
        GRID_BAR();
        { pg8::Gemm g{(const bf16_t*)(F.ws + WS_H), (const bf16_t*)(wl + W_GU), Mrows, 2 * FF, DM}; pg8::StaticOrder S; S.init(Mrows, 2 * FF, F.G, (int)blockIdx.x);
          pg8::EpiSwi E{(bf16_t*)(F.ws + WS_ACT)};
          pg8::gemm_phase<pg8::EpiSwi, pg8::StaticOrder, true, true>(F.lds, g, S, E); }
        GRID_BAR();
        { pg8::Gemm g{(const bf16_t*)(F.ws + WS_ACT), (const bf16_t*)(wl + W_DN), Mrows, DM, FF}; pg8::ResSplitOrder S; S.init(DM, F.G, (int)blockIdx.x, !last, SPLIT_D, (FF / 64) / SPLIT_D);
          pg8::EpiRes E{(const float*)(F.ws + WS_STATS), F.in[I_LNMG] + l * DM, F.in[I_LNMB] + l * DM, (float*)(F.ws + WS_T), modl + 5 * DM, modl + 12288 + 5 * DM, (float*)(F.ws + WS_SLAB)};
          pg8::gemm_phase<pg8::EpiRes, pg8::ResSplitOrder, true, true>(F.lds, g, S, E); }
        GRID_BAR();
        {
        for (int t = F.gw; t < NLAT; t += F.NGW) { const float* mdn = modl + 2 * 12288;
            float* dst = last ? (float*)(F.out + (size_t)t * DM) : (float*)nullptr;
            ln_row(F.lane, (const float*)(F.ws + WS_T) + (size_t)t * DM, dst, last ? (bf16_t*)nullptr : (bf16_t*)(F.ws + WS_H) + (size_t)t * DM,
                   F.in[I_LNFG] + l * DM, F.in[I_LNFB] + l * DM, mdn, mdn + DM, last ? (unsigned char*)nullptr : (unsigned char*)(F.ws + WS_H8) + (size_t)t * DM, (float*)(F.ws + WS_STATS) + 2 * t); }
        if (!last) for (int r = (int)blockIdx.x; r < NCTX; r += F.G) { const float* mdn = modl + 3 * 12288;
            ln_ctx_row(F, r, (const float*)(F.ws + WS_SLAB), SPLIT_D, modl + 12288 + 5 * DM, F.in[I_LNFG] + l * DM, F.in[I_LNFB] + l * DM, mdn, mdn + DM, true); }
        }
        if (!last) GRID_BAR();
    }
}

extern "C" void kernel_launch(void* const* d_in, const int* in_sizes, int n_in, void* d_out, int out_size, void* d_ws, size_t ws_size, hipStream_t stream) {
    static int grid = 0;
    if (grid == 0) {
        if (n_in != 33 || out_size != NLAT * DM || ws_size < WS_END) { fprintf(stderr, "kernel_launch: built for 33 inputs, out %d, ws >= %zu; got n_in %d out %d ws %zu\n", NLAT * DM, (size_t)WS_END, n_in, out_size, ws_size); grid = -1; return; }
        int dev = 0, cus = 0;
        if (hipGetDevice(&dev) != hipSuccess || hipDeviceGetAttribute(&cus, hipDeviceAttributeMultiprocessorCount, dev) != hipSuccess) { grid = -1; return; }
        if (hipFuncSetAttribute((const void*)hyb_fwd, hipFuncAttributeMaxDynamicSharedMemorySize, LDS_BYTES) != hipSuccess) { fprintf(stderr, "kernel_launch: hipFuncSetAttribute failed\n"); grid = -1; return; }
        int per_cu = 0;
        if (hipOccupancyMaxActiveBlocksPerMultiprocessor(&per_cu, (const void*)hyb_fwd, NTHR, LDS_BYTES) != hipSuccess || per_cu < 1) { fprintf(stderr, "kernel_launch: occupancy query says %d\n", per_cu); }
        (void)hipGetLastError();
        grid = cus;
    }
    if (grid < 0) return;
    (void)hipMemsetAsync((char*)d_ws + WS_CTL, 0, CTL_ZERO_BYTES, stream);
    Args a{};
    for (int i = 0; i < 33; ++i) a.in[i] = (const float*)d_in[i];
    a.out = (float*)d_out; a.ws = (unsigned char*)d_ws;
    hipLaunchKernelGGL(hyb_fwd, dim3(grid), dim3(NTHR), LDS_BYTES, stream, a);
}
```
